# Optimizing an MI355X kernel written in HIP

```python
import math
import jax
import jax.numpy as jnp
from jax import lax
import numpy as np

D_MODEL = 2048
BATCH = 4
SEQ = 2048
DEPTH = 2

CTX_LEN = 256
GRID_W = 64

N_EVEN = (DEPTH + 1) // 2
N_ODD = DEPTH // 2
LAST_ATTN_LAYER = ((DEPTH - 1) // 2) * 2
DEEPNORM_ALPHA = (2.0 * DEPTH) ** 0.25
DEEPNORM_BETA = (8.0 * DEPTH) ** -0.25
LN_EPS = 1e-6
NEG_INF = -1e30
Q_BLOCK = 128

MLA_HEADS = 8
MLA_NOPE = 128
MLA_ROPE = 64
MLA_QK = MLA_NOPE + MLA_ROPE
MLA_V = 128
MLA_KV_RANK = 512
ROPE_THETA = 10000.0

NA_HEADS = 8
NA_HEAD_DIM = 128
NA_KH = 8
NA_KW = 16
NA_QC = 16
NA_KC = NA_QC + NA_KW

OFF_CKV = MLA_HEADS * MLA_QK
OFF_KPE = OFF_CKV + MLA_KV_RANK
OFF_QNA = OFF_KPE + MLA_ROPE
OFF_KNA = OFF_QNA + NA_HEADS * NA_HEAD_DIM
OFF_VNA = OFF_KNA + NA_HEADS * NA_HEAD_DIM
IN_AB_W = OFF_VNA + NA_HEADS * NA_HEAD_DIM
MIX_AB_W = MLA_HEADS * MLA_V + NA_HEADS * NA_HEAD_DIM

HY_W = 1024
HY_ORDER = 2
HY_IN_W = (HY_ORDER + 1) * HY_W
HY_SHORT = 3
HY_BANDS = 16
HY_EMB = 1 + 2 * HY_BANDS
HY_FILT_HID = 64
HY_FILT_OUT = HY_ORDER * 2 * HY_W
HY_DECAY_TARGET = 1e-2
HY_FAST_DECAY_PCT = 0.3
HY_SLOW_DECAY_PCT = 1.5
HY_MIN_DECAY = math.log(HY_DECAY_TARGET) / HY_SLOW_DECAY_PCT
HY_MAX_DECAY = math.log(HY_DECAY_TARGET) / HY_FAST_DECAY_PCT

FN_W = 1024
FN_GROUPS = 4
FN_GROUP_W = FN_W // FN_GROUPS
IN_CD_W = HY_IN_W + FN_W
MIX_CD_W = HY_W + FN_W

N_EXPERTS = 16
EC_CAPACITY_FACTOR = 2
EXPERT_FF = 1408

kernel_name = 'hybrid_mla_natten_hyena_fnet_ecmoe_dit'


def layer_norm(x, g, b):
    xf = x.astype(jnp.float32)
    mu = jnp.mean(xf, -1, keepdims=True)
    var = jnp.mean(jnp.square(xf - mu), -1, keepdims=True)
    y = (xf - mu) * lax.rsqrt(var + LN_EPS) * g.astype(jnp.float32) + b.astype(jnp.float32)
    return y.astype(x.dtype)


def rms_norm(x, g):
    xf = x.astype(jnp.float32)
    y = xf * lax.rsqrt(jnp.mean(jnp.square(xf), -1, keepdims=True) + LN_EPS) * g.astype(jnp.float32)
    return y.astype(x.dtype)


def ada_params(cvec, w, b):
    return jax.nn.silu(cvec) @ w + b


def modulate(h, shift, scale):
    return h * (1 + scale) + shift


def post_norm(h, y, gate, g, b):
    return layer_norm(DEEPNORM_ALPHA * h + gate * y, g, b)


def axial_rope_tables(n_tok):
    t = np.arange(n_tok)
    row = (t // GRID_W).astype(np.float32)
    col = (t % GRID_W).astype(np.float32)
    n_freq = MLA_ROPE // 4
    inv = (ROPE_THETA ** (-np.arange(n_freq, dtype=np.float32) / n_freq)).astype(np.float32)
    ang = np.concatenate([row[:, None] * inv, col[:, None] * inv], axis=1)
    return np.cos(ang).astype(np.float32), np.sin(ang).astype(np.float32)


def apply_rope(t, cos, sin):
    cos = jnp.asarray(cos, t.dtype)
    sin = jnp.asarray(sin, t.dtype)
    t1, t2 = jnp.split(t, 2, axis=-1)
    return jnp.concatenate([t1 * cos - t2 * sin, t2 * cos + t1 * sin], axis=-1)


def mla_up(ckv, kv_norm, w_ukv):
    B, L, _ = ckv.shape
    kv = (rms_norm(ckv, kv_norm) @ w_ukv).reshape(B, L, MLA_HEADS, MLA_NOPE + MLA_V)
    return kv[..., :MLA_NOPE], kv[..., MLA_NOPE:]


def mla_attend_latent(q_nope, q_pe, k_nope, k_pe, v, kc_nope, kc_pe, vc):
    B, S, H, _ = q_nope.shape
    nb = S // Q_BLOCK
    scale = MLA_QK ** -0.5

    def to_blocks(t):
        return jnp.moveaxis(t.reshape(B, nb, Q_BLOCK, *t.shape[2:]), 1, 0)

    def one_block(qs):
        qn, qp = qs
        s_lat = jnp.einsum('bqhd,bkhd->bhqk', qn, k_nope) + jnp.einsum('bqhr,bkr->bhqk', qp, k_pe)
        s_ctx = jnp.einsum('bqhd,bkhd->bhqk', qn, kc_nope) + jnp.einsum('bqhr,bkr->bhqk', qp, kc_pe)
        logits = jnp.concatenate([s_lat, s_ctx], -1).astype(jnp.float32) * scale
        p = jax.nn.softmax(logits, axis=-1).astype(v.dtype)
        return (jnp.einsum('bhqk,bkhd->bqhd', p[..., :S], v)
                + jnp.einsum('bhqk,bkhd->bqhd', p[..., S:], vc))

    out = lax.map(one_block, (to_blocks(q_nope), to_blocks(q_pe)))
    return jnp.moveaxis(out, 0, 1).reshape(B, S, H * MLA_V)


def na_tables(rows, kh):
    r = np.arange(rows)
    rs = np.clip(r - kh // 2, 0, rows - kh)
    key_rows = rs[:, None] + np.arange(kh)[None, :]
    ncb = GRID_W // NA_QC
    m = np.arange(ncb)
    cb = np.clip(m * NA_QC - NA_KW // 2, 0, GRID_W - NA_KC)
    key_cols = cb[:, None] + np.arange(NA_KC)[None, :]
    idx = key_rows[:, None, :, None] * GRID_W + key_cols[None, :, None, :]
    qcol = m[:, None] * NA_QC + np.arange(NA_QC)[None, :]
    cs = np.clip(qcol - NA_KW // 2, 0, GRID_W - NA_KW)
    kcol = key_cols[:, None, :]
    col_ok = (kcol >= cs[..., None]) & (kcol < cs[..., None] + NA_KW)
    mask = np.broadcast_to(col_ok[:, :, None, :], (ncb, NA_QC, kh, NA_KC)).reshape(ncb, NA_QC, kh * NA_KC)
    dr = key_rows - r[:, None] + (NA_KH - 1)
    dc = np.clip(kcol - qcol[..., None], -(NA_KW - 1), NA_KW - 1) + (NA_KW - 1)
    return (idx.reshape(rows, ncb * kh * NA_KC).astype(np.int32), dr.astype(np.int32),
            dc.astype(np.int32), mask)


def na_attend_latent(q, k, v, kc, vc, rpb):
    B, S, H, d = q.shape
    rows = S // GRID_W
    kh = min(NA_KH, rows)
    ncb = GRID_W // NA_QC
    nk = kh * NA_KC
    idx, dr, dc, mask = na_tables(rows, kh)
    dc = jnp.asarray(dc)
    mask = jnp.asarray(mask)
    scale = d ** -0.5
    q_rows = jnp.moveaxis(q.reshape(B, rows, ncb, NA_QC, H, d), 1, 0)

    def one_row(args):
        q_r, idx_r, dr_r = args
        k_r = jnp.take(k, idx_r, axis=1).reshape(B, ncb, nk, H, d)
        v_r = jnp.take(v, idx_r, axis=1).reshape(B, ncb, nk, H, d)
        bias = rpb[:, dr_r[None, None, :, None], dc[:, :, None, :]].reshape(H, ncb, NA_QC, nk)
        s_win = jnp.einsum('bmqhd,bmkhd->bhmqk', q_r, k_r).astype(jnp.float32) * scale + bias.astype(jnp.float32)
        s_win = jnp.where(mask, s_win, NEG_INF)
        s_ctx = jnp.einsum('bmqhd,bchd->bhmqc', q_r, kc).astype(jnp.float32) * scale
        p = jax.nn.softmax(jnp.concatenate([s_win, s_ctx], -1), axis=-1).astype(v.dtype)
        return (jnp.einsum('bhmqk,bmkhd->bmqhd', p[..., :nk], v_r)
                + jnp.einsum('bhmqc,bchd->bmqhd', p[..., nk:], vc))

    out = lax.map(one_row, (q_rows, jnp.asarray(idx), jnp.asarray(dr)))
    return jnp.moveaxis(out, 0, 1).reshape(B, S, H * d)


def mixer_ab(u, uc, w_in, kv_norm, w_ukv, rpb, w_out, ctx_queries):
    B, S, _ = u.shape
    Lc = uc.shape[1]
    cos, sin = axial_rope_tables(S)
    p = u @ w_in
    q_mla = p[..., :OFF_CKV].reshape(B, S, MLA_HEADS, MLA_QK)
    q_nope = q_mla[..., :MLA_NOPE]
    q_pe = apply_rope(q_mla[..., MLA_NOPE:], cos[:, None, :], sin[:, None, :])
    k_nope, v_mla = mla_up(p[..., OFF_CKV:OFF_KPE], kv_norm, w_ukv)
    k_pe = apply_rope(p[..., OFF_KPE:OFF_QNA], cos, sin)
    q_na = p[..., OFF_QNA:OFF_KNA].reshape(B, S, NA_HEADS, NA_HEAD_DIM)
    k_na = p[..., OFF_KNA:OFF_VNA].reshape(B, S, NA_HEADS, NA_HEAD_DIM)
    v_na = p[..., OFF_VNA:].reshape(B, S, NA_HEADS, NA_HEAD_DIM)
    pc_mla = uc @ w_in[:, OFF_CKV:OFF_QNA]
    kc_nope, vc_mla = mla_up(pc_mla[..., :MLA_KV_RANK], kv_norm, w_ukv)
    kc_pe = pc_mla[..., MLA_KV_RANK:]
    pc_na = uc @ w_in[:, OFF_KNA:]
    kc_na = pc_na[..., :NA_HEADS * NA_HEAD_DIM].reshape(B, Lc, NA_HEADS, NA_HEAD_DIM)
    vc_na = pc_na[..., NA_HEADS * NA_HEAD_DIM:].reshape(B, Lc, NA_HEADS, NA_HEAD_DIM)

    a_out = mla_attend_latent(q_nope, q_pe, k_nope, k_pe, v_mla, kc_nope, kc_pe, vc_mla)
    b_out = na_attend_latent(q_na, k_na, v_na, kc_na, vc_na, rpb)
    y = jnp.concatenate([a_out, b_out], -1) @ w_out

    yc = None
    if ctx_queries:
        qc = (uc @ w_in[:, :OFF_CKV]).reshape(B, Lc, MLA_HEADS, MLA_QK)
        s = (jnp.einsum('bqhd,bkhd->bhqk', qc[..., :MLA_NOPE], kc_nope)
             + jnp.einsum('bqhr,bkr->bhqk', qc[..., MLA_NOPE:], kc_pe)).astype(jnp.float32) * MLA_QK ** -0.5
        ac = jnp.einsum('bhqk,bkhd->bqhd', jax.nn.softmax(s, -1).astype(vc_mla.dtype), vc_mla).reshape(B, Lc, -1)
        qn = (uc @ w_in[:, OFF_QNA:OFF_KNA]).reshape(B, Lc, NA_HEADS, NA_HEAD_DIM)
        s = jnp.einsum('bqhd,bkhd->bhqk', qn, kc_na).astype(jnp.float32) * NA_HEAD_DIM ** -0.5
        bc = jnp.einsum('bhqk,bkhd->bqhd', jax.nn.softmax(s, -1).astype(vc_na.dtype), vc_na).reshape(B, Lc, -1)
        yc = jnp.concatenate([ac, bc], -1) @ w_out
    return y, yc


def hyena_filters(L, fw1, fb1, ff1, fw2, fb2, ff2, fw3):
    f32 = jnp.float32
    t01 = jnp.linspace(0.0, 1.0, L, dtype=f32)
    w = 2.0 * math.pi * jnp.arange(L, dtype=f32) / L
    bands = jnp.linspace(1e-4, HY_BANDS - 1, HY_BANDS, dtype=f32)
    z = jnp.concatenate([t01[:, None], jnp.cos(w[:, None] * bands), -jnp.sin(w[:, None] * bands)], -1)
    hdn = jnp.sin(ff1.astype(f32) * (z @ fw1.astype(f32) + fb1.astype(f32)))
    hdn = jnp.sin(ff2.astype(f32) * (hdn @ fw2.astype(f32) + fb2.astype(f32)))
    filt = hdn @ fw3.astype(f32)
    deltas = jnp.abs(jnp.linspace(HY_MIN_DECAY, HY_MAX_DECAY, HY_W, dtype=f32))
    decay = jnp.exp(-t01[:, None] * deltas)
    return filt.reshape(L, HY_ORDER, 2, HY_W) * decay[:, None, None, :]


def bidir_fftconv(z, hf, hb, skip):
    L = z.shape[1]
    zf = z.astype(jnp.float32)
    h_circ = jnp.concatenate([hf, jnp.zeros_like(hf[:1]), hb[:0:-1]], axis=0)
    spec = jnp.fft.rfft(zf, n=2 * L, axis=1) * jnp.fft.rfft(h_circ, n=2 * L, axis=0)[None]
    y = jnp.fft.irfft(spec, n=2 * L, axis=1)[:, :L]
    return (y + zf * skip.astype(jnp.float32)).astype(z.dtype)


def hyena_mix(p, conv_w, conv_b, filt, skip):
    L = p.shape[1]
    half = HY_SHORT // 2
    pad = jnp.pad(p, ((0, 0), (half, half), (0, 0)))
    s = conv_b + sum(pad[:, k:k + L] * conv_w[k] for k in range(HY_SHORT))
    parts = jnp.split(s, HY_ORDER + 1, axis=-1)
    z = parts[0]
    for o in range(HY_ORDER):
        z = parts[o + 1] * bidir_fftconv(z, filt[:, o, 0], filt[:, o, 1], skip[o])
    return z


def fnet_mix(p):
    B, L, _ = p.shape
    g = p.astype(jnp.float32).reshape(B, L, FN_GROUPS, FN_GROUP_W)
    y = jnp.fft.fft2(g, axes=(1, 3), norm='ortho').real
    return y.reshape(B, L, FN_W).astype(p.dtype)


def mixer_cd(u, w_in, conv_w, conv_b, fw1, fb1, ff1, fw2, fb2, ff2, fw3, skip, w_out):
    p = u @ w_in
    filt = hyena_filters(u.shape[1], fw1, fb1, ff1, fw2, fb2, ff2, fw3)
    y_hy = hyena_mix(p[..., :HY_IN_W], conv_w, conv_b, filt, skip)
    y_fn = fnet_mix(p[..., HY_IN_W:])
    return jnp.concatenate([y_hy, y_fn], -1) @ w_out


def ec_moe(u, router, w1, w3, w2):
    B, L, D = u.shape
    cap = EC_CAPACITY_FACTOR * L // N_EXPERTS
    aff = jax.nn.softmax((u @ router).astype(jnp.float32), axis=-1)
    gate, idx = lax.top_k(jnp.swapaxes(aff, 1, 2), cap)
    xe = jax.vmap(lambda ub, ib: ub[ib])(u, idx)
    hdn = jax.nn.silu(jnp.einsum('becd,edf->becf', xe, w1)) * jnp.einsum('becd,edf->becf', xe, w3)
    ye = jnp.einsum('becf,efd->becd', hdn, w2) * gate[..., None].astype(u.dtype)
    return jax.vmap(lambda yb, ib: jnp.zeros((L, D), yb.dtype).at[ib.reshape(-1)].add(yb.reshape(-1, D)))(ye, idx)


def setup_inputs(seed: int = 0) -> dict:
    key = jax.random.key(seed)
    ks = iter(jax.random.split(key, 40))
    D = D_MODEL

    def nrm(shape, std):
        return std * jax.random.normal(next(ks), shape, jnp.float32)

    return {
        'x': nrm((BATCH, SEQ, D), 1.0),
        'c': nrm((BATCH, D), 1.0),
        'ctx': nrm((BATCH, CTX_LEN, D), 1.0),
        'c_ctx': nrm((D,), 1.0),
        'ada_w': nrm((DEPTH, D, 6 * D), D ** -0.5),
        'ada_b': nrm((DEPTH, 6 * D), 0.01),
        'ln1_g': 1.0 + nrm((DEPTH, D), 0.02),
        'ln1_b': nrm((DEPTH, D), 0.02),
        'ln2_g': 1.0 + nrm((DEPTH, D), 0.02),
        'ln2_b': nrm((DEPTH, D), 0.02),
        'router': nrm((DEPTH, D, N_EXPERTS), D ** -0.5),
        'exp_w1': nrm((DEPTH, N_EXPERTS, D, EXPERT_FF), D ** -0.5),
        'exp_w3': nrm((DEPTH, N_EXPERTS, D, EXPERT_FF), D ** -0.5),
        'exp_w2': nrm((DEPTH, N_EXPERTS, EXPERT_FF, D), EXPERT_FF ** -0.5 * DEEPNORM_BETA),
        'ab_w_in': nrm((N_EVEN, D, IN_AB_W), D ** -0.5),
        'ab_kv_norm': 1.0 + nrm((N_EVEN, MLA_KV_RANK), 0.02),
        'ab_w_ukv': nrm((N_EVEN, MLA_KV_RANK, MLA_HEADS * (MLA_NOPE + MLA_V)), MLA_KV_RANK ** -0.5),
        'ab_rpb': nrm((N_EVEN, NA_HEADS, 2 * NA_KH - 1, 2 * NA_KW - 1), 0.1),
        'ab_w_out': nrm((N_EVEN, MIX_AB_W, D), MIX_AB_W ** -0.5 * DEEPNORM_BETA),
        'cd_w_in': nrm((N_ODD, D, IN_CD_W), D ** -0.5),
        'cd_conv_w': nrm((N_ODD, HY_SHORT, HY_IN_W), HY_SHORT ** -0.5),
        'cd_conv_b': nrm((N_ODD, HY_IN_W), 0.02),
        'cd_filt_w1': nrm((N_ODD, HY_EMB, HY_FILT_HID), HY_EMB ** -0.5),
        'cd_filt_b1': nrm((N_ODD, HY_FILT_HID), 0.02),
        'cd_filt_freq1': 1.0 + nrm((N_ODD, HY_FILT_HID), 0.02),
        'cd_filt_w2': nrm((N_ODD, HY_FILT_HID, HY_FILT_HID), HY_FILT_HID ** -0.5),
        'cd_filt_b2': nrm((N_ODD, HY_FILT_HID), 0.02),
        'cd_filt_freq2': 1.0 + nrm((N_ODD, HY_FILT_HID), 0.02),
        'cd_filt_w3': nrm((N_ODD, HY_FILT_HID, HY_FILT_OUT), 0.01),
        'cd_skip': nrm((N_ODD, HY_ORDER, HY_W), 0.1),
        'cd_w_out': nrm((N_ODD, MIX_CD_W, D), MIX_CD_W ** -0.5 * DEEPNORM_BETA),
    }


def reference(x, c, ctx, c_ctx, ada_w, ada_b, ln1_g, ln1_b, ln2_g, ln2_b, router, exp_w1, exp_w3, exp_w2,
              ab_w_in, ab_kv_norm, ab_w_ukv, ab_rpb, ab_w_out,
              cd_w_in, cd_conv_w, cd_conv_b, cd_filt_w1, cd_filt_b1, cd_filt_freq1, cd_filt_w2, cd_filt_b2,
              cd_filt_freq2, cd_filt_w3, cd_skip, cd_w_out):
    h = x
    hc = ctx
    for i in range(DEPTH):
        j = i // 2
        attn_layer = (i % 2 == 0)
        ctx_continues = i < LAST_ATTN_LAYER
        m = ada_params(c, ada_w[i], ada_b[i])[:, None, :]
        sh1, sc1, g1, sh2, sc2, g2 = jnp.split(m, 6, axis=-1)
        if ctx_continues:
            mc = jnp.split(ada_params(c_ctx, ada_w[i], ada_b[i]), 6, axis=-1)
        elif attn_layer:
            mc = jnp.split(ada_params(c_ctx, ada_w[i][:, :2 * D_MODEL], ada_b[i][:2 * D_MODEL]), 2, axis=-1)
        if attn_layer or ctx_continues:
            uc = modulate(hc, mc[0], mc[1])
        u = modulate(h, sh1, sc1)
        if attn_layer:
            y, yc = mixer_ab(u, uc, ab_w_in[j], ab_kv_norm[j], ab_w_ukv[j], ab_rpb[j], ab_w_out[j], ctx_continues)
        else:
            cd_args = (cd_w_in[j], cd_conv_w[j], cd_conv_b[j], cd_filt_w1[j], cd_filt_b1[j], cd_filt_freq1[j],
                       cd_filt_w2[j], cd_filt_b2[j], cd_filt_freq2[j], cd_filt_w3[j], cd_skip[j], cd_w_out[j])
            y = mixer_cd(u, *cd_args)
            yc = mixer_cd(uc, *cd_args) if ctx_continues else None
        h = post_norm(h, y, g1, ln1_g[i], ln1_b[i])
        h = post_norm(h, ec_moe(modulate(h, sh2, sc2), router[i], exp_w1[i], exp_w3[i], exp_w2[i]),
                      g2, ln2_g[i], ln2_b[i])
        if ctx_continues:
            hc = post_norm(hc, yc, mc[2], ln1_g[i], ln1_b[i])
            hc = post_norm(hc, ec_moe(modulate(hc, mc[3], mc[4]), router[i], exp_w1[i], exp_w3[i], exp_w2[i]),
                           mc[5], ln2_g[i], ln2_b[i])
    return h
```

```cpp
#include <hip/hip_runtime.h>
#include <cstdio>
#include <cstdint>

#ifndef MK_LAUNCH_PER_PHASE
#define MK_LAUNCH_PER_PHASE 0
#endif

#define GAS __attribute__((address_space(1)))
#define LAS __attribute__((address_space(3)))
typedef unsigned short bf16;
typedef short bf16x8 __attribute__((ext_vector_type(8)));
typedef short s16x4 __attribute__((ext_vector_type(4)));
typedef float f32x4 __attribute__((ext_vector_type(4)));
typedef float f32x2 __attribute__((ext_vector_type(2)));
typedef float f32x16 __attribute__((ext_vector_type(16)));
typedef unsigned u32x4 __attribute__((ext_vector_type(4)));
typedef unsigned u32x2 __attribute__((ext_vector_type(2)));
#define RLX_AGENT __ATOMIC_RELAXED, __HIP_MEMORY_SCOPE_AGENT
#define LDS_WAIT() asm volatile("s_waitcnt lgkmcnt(0)" ::: "memory")
#define VM_WAIT() asm volatile("s_waitcnt vmcnt(0)" ::: "memory")

constexpr int D = 2048, NB = 4, SEQ = 2048, LC = 256, GW = 64;
constexpr int MLAT = NB * SEQ, MCTX = NB * LC, MALL = MLAT + MCTX;
constexpr int IN_AB = 5184, IN_AB_PAD = 5376;
constexpr int OFF_CKV = 1536, OFF_KPE = 2048, OFF_QNA = 2112, OFF_KNA = 3136, OFF_VNA = 4160;
constexpr int KVR = 512, NH = 8;
constexpr int FF = 1408, NE = 16, CAP = 256, NRT = NE * NB;
constexpr int IN_CD = 4096, HYW = 1024, HY3 = 3072;
constexpr float LN_EPS = 1e-6f;
constexpr float DN_ALPHA = 1.41421356237f;
constexpr int NWAVES = 8, NTHR = 512;

constexpr size_t MiB = 1u << 20;
constexpr size_t WS_CTL = 0, CTL_ZERO_BYTES = 1 * MiB;
constexpr size_t WS_ADA = 1 * MiB;
constexpr size_t WS_AFF = 2 * MiB;
constexpr size_t WS_IDX = 3 * MiB;
constexpr size_t WS_GATE = WS_IDX + 64 * 1024;
constexpr size_t WS_INV = 4 * MiB;
constexpr size_t WS_CS256 = 5 * MiB;
constexpr size_t WS_DBG = 6 * MiB;
constexpr size_t WS_WAB = 8 * MiB;
constexpr size_t WS_WUKV = 30 * MiB;
constexpr size_t WS_WABO = 32 * MiB;
constexpr size_t WS_WCD = 40 * MiB;
constexpr size_t WS_WCDO = 56 * MiB;
constexpr size_t WS_CSL = 64 * MiB;
constexpr size_t WS_HR = 80 * MiB;
constexpr size_t W13_E = (size_t)2 * FF * D * 2;
constexpr size_t W2_E = (size_t)D * FF * 2;
constexpr size_t WS_W13 = 96 * MiB;
constexpr size_t WS_W2 = WS_W13 + 32 * W13_E;
constexpr size_t WS_UALL = WS_W2 + 32 * W2_E;
constexpr size_t WS_P = WS_UALL + (size_t)MALL * D * 2;
constexpr size_t WS_CKVN = WS_P + (size_t)MALL * IN_AB_PAD * 2;
constexpr size_t WS_KPE = WS_CKVN + (size_t)MALL * KVR * 2;
constexpr size_t WS_KV = WS_KPE + (size_t)MALL * 64 * 2;
constexpr size_t WS_ST = WS_KV;
constexpr size_t WS_CAT = WS_KV + (size_t)NB * HY3 * SEQ * 2;
constexpr size_t WS_PRE = WS_CAT + (size_t)MLAT * D * 2;
constexpr size_t WS_H1 = WS_PRE + (size_t)MLAT * D * 4;
constexpr size_t WS_H2 = WS_H1 + (size_t)MLAT * D * 4;
constexpr size_t WS_U2 = WS_H2 + (size_t)MLAT * D * 4;
constexpr size_t WS_XE = WS_U2 + (size_t)MLAT * D * 2;
constexpr size_t WS_HDN = WS_XE + (size_t)NRT * CAP * D * 2;
constexpr size_t WS_YE = WS_HDN + (size_t)NRT * CAP * FF * 2;
constexpr size_t WS_T1 = WS_YE + (size_t)NRT * CAP * D * 2;
constexpr size_t WS_END = WS_T1 + (size_t)16 * 256 * 2 * 2048 * 2;
static_assert(WS_WAB + (size_t)IN_AB_PAD * D * 2 <= WS_WUKV && WS_HR + (size_t)2 * 1024 * 4096 * 2 <= WS_W13, "ws map");
static_assert(WS_END < (size_t)1400 * MiB, "ws map too large");

constexpr int LDS_MAIN = 151552;
constexpr int LDS_MISC = LDS_MAIN;
constexpr int LDS_BYTES = LDS_MAIN + 64;

__device__ __forceinline__ unsigned f2bf(float f) { unsigned u = __builtin_bit_cast(unsigned, f); return (u + 0x7fffu + ((u >> 16) & 1u)) >> 16; }
__device__ __forceinline__ unsigned pk2(float lo, float hi) { return f2bf(lo) | (f2bf(hi) << 16); }
__device__ __forceinline__ float bf2f(unsigned b) { return __builtin_bit_cast(float, b << 16); }
__device__ __forceinline__ float bflo(unsigned w) { return __builtin_bit_cast(float, w << 16); }
__device__ __forceinline__ float bfhi(unsigned w) { return __builtin_bit_cast(float, w & 0xffff0000u); }
__device__ __forceinline__ unsigned cvt_pk_bf16(float lo, float hi) { unsigned r; asm volatile("v_cvt_pk_bf16_f32 %0, %1, %2" : "=v"(r) : "v"(lo), "v"(hi)); return r; }
__device__ __forceinline__ float wave_sum(float v) {
#pragma unroll
    for (int o = 1; o < 64; o <<= 1) v += __shfl_xor(v, o);
    return v;
}
__device__ __forceinline__ int tid_opaque() { int t = threadIdx.x; asm volatile("" : "+v"(t)); return t; }
__device__ __forceinline__ float silu_f(float x) { return x / (1.f + __expf(-x)); }

#define XB_TMO      128
#define XB_XCNT(j)  (256  + 64 * (j))
#define XB_XSUB(j)  (1280 + 64 * (j))
#define XB_XGEN(j)  (2304 + 64 * (j))
#define XB_TOP      3328
#define XB_TOPGEN   3392
#define XCD_BAR_WORDS 3456
#define XB_SPIN_CAP (1u << 18)
__device__ __forceinline__ unsigned xb_ld(unsigned* p)              { return __hip_atomic_load(p, __ATOMIC_RELAXED, __HIP_MEMORY_SCOPE_AGENT); }
__device__ __forceinline__ unsigned xb_add(unsigned* p, unsigned v) { return __hip_atomic_fetch_add(p, v, __ATOMIC_RELAXED, __HIP_MEMORY_SCOPE_AGENT); }
__device__ __forceinline__ unsigned xb_xcc_id() { return (unsigned)__builtin_amdgcn_s_getreg((3 << 11) | 20) & 0xFu; }
#define XB_SPIN(cond, bar) do { unsigned _sp = 0; while (cond) { __builtin_amdgcn_s_sleep(1); \
    if ((++_sp & 255u) == 0u) { if (xb_ld(&(bar)[XB_TMO])) break; if (_sp > XB_SPIN_CAP) { atomicAdd(&(bar)[XB_TMO], 1u); break; } } } } while (0)
struct XcdBarrier { unsigned* bar; unsigned x; volatile LAS unsigned* st; };
__device__ __forceinline__ XcdBarrier xcd_barrier_post(unsigned* bar, volatile LAS unsigned* st) {
    XcdBarrier b; b.bar = bar; b.x = xb_xcc_id(); b.st = st;
    if (threadIdx.x == 0) (void)xb_add(&bar[XB_XCNT(b.x)], 1u);
    return b;
}
__device__ __forceinline__ void xcd_barrier_complete(unsigned* bar, unsigned x, unsigned& nloc, unsigned& nx) {
    const unsigned G = gridDim.x * gridDim.y * gridDim.z;
    unsigned sum, cnt, mine, sp = 0u;
    for (;;) {
        sum = 0u; cnt = 0u; mine = 0u;
#pragma unroll
        for (unsigned j = 0; j < 16; ++j) { const unsigned c = xb_ld(&bar[XB_XCNT(j)]); sum += c; cnt += (c > 0u) ? 1u : 0u; mine = (j == x) ? c : mine; }
        if (sum == G) break;
        __builtin_amdgcn_s_sleep(1);
        if ((++sp & 255u) == 0u) { if (xb_ld(&bar[XB_TMO])) break; if (sp > XB_SPIN_CAP) { atomicAdd(&bar[XB_TMO], 1u); break; } }
    }
    nloc = mine > 0u ? mine : 1u; nx = cnt > 0u ? cnt : 1u;
}
__device__ __forceinline__ void xcd_barrier(const XcdBarrier& b) {
    asm volatile("s_waitcnt vmcnt(0)" ::: "memory");
    __syncthreads();
    if (threadIdx.x == 0) {
        unsigned* bar = b.bar;
        __builtin_amdgcn_s_waitcnt(0);
        unsigned nloc = b.st[0], nx = b.st[1];
        if (nloc == 0u) { xcd_barrier_complete(bar, b.x, nloc, nx); b.st[0] = nloc; b.st[1] = nx; }
        const unsigned old = xb_add(&bar[XB_XSUB(b.x)], 1u);
        const unsigned gen = old / nloc;
        if (old + 1u == (gen + 1u) * nloc) {
            __builtin_amdgcn_fence(__ATOMIC_RELEASE, "agent");
            asm volatile("s_waitcnt vmcnt(0)" ::: "memory");
            const unsigned og = xb_add(&bar[XB_TOP], 1u);
            const unsigned tg = og / nx;
            if (og + 1u == (tg + 1u) * nx) xb_add(&bar[XB_TOPGEN], 1u);
            else XB_SPIN(xb_ld(&bar[XB_TOPGEN]) == tg, bar);
            __builtin_amdgcn_fence(__ATOMIC_ACQUIRE, "agent");
            xb_add(&bar[XB_XGEN(b.x)], 1u);
            asm volatile("s_waitcnt vmcnt(0)" ::: "memory");
        } else {
            XB_SPIN(xb_ld(&bar[XB_XGEN(b.x)]) == gen, bar);
            __builtin_amdgcn_fence(__ATOMIC_ACQUIRE, "agent");
            asm volatile("s_waitcnt vmcnt(0)" ::: "memory");
        }
    }
    __syncthreads();
}

namespace pg8 {
constexpr int BM = 256, BK = 64, HALF = 128, HTB = HALF * BK * 2, STAGE_BYTES = 8 * HTB;
__host__ __device__ __forceinline__ int lds_byte(int r, int c) { const int st = (r >> 4) * 2 + (c >> 5), rr = r & 15, cc = c & 31, ob = rr * 64 + cc * 2; return st * 1024 + (ob ^ (((ob >> 9) & 1) << 5)); }
__host__ __device__ __forceinline__ void stage_rc(int b, int& R, int& C) { const int st = b / 1024, sb = b % 1024, swz = sb ^ (((sb >> 9) & 1) << 5); R = (st >> 1) * 16 + swz / 64; C = (st & 1) * 32 + (swz % 64) / 2; }
__host__ __device__ __forceinline__ int perm32(int rho) { const int n = rho >> 4, i = rho & 15; return 8 * (i >> 2) + 4 * n + (i & 3); }

template <class Prob>
__device__ __forceinline__ void gemm_phase(LAS unsigned char* lds, const Prob& P, int u0, int ustride) {
    const int tid = tid_opaque(), wid = __builtin_amdgcn_readfirstlane(tid >> 6), lane = tid & 63, wr = wid >> 2, wc = wid & 3, fr = lane & 15, fq = lane >> 4;
    const int K = P.K, nt = K / BK;
    unsigned voffA[2], voffB[2];
#pragma unroll
    for (int i = 0; i < 2; ++i) { int R, C; stage_rc(tid * 16 + i * 8192, R, C); const int Rb = Prob::PERM ? ((R & ~31) + perm32(R & 31)) : R;
        voffA[i] = (unsigned)(R * P.lda + C) * 2u; voffB[i] = (unsigned)(Rb * P.ldb + C) * 2u; }
    const size_t kstep = (size_t)(BK * 2);
    const size_t hstepA = (size_t)HALF * P.lda * 2, hstepB = (size_t)HALF * P.ldb * 2;
    const unsigned ldsw = (unsigned)wid * 1024u;
    const int aoff = lds_byte(wr * 64 + fr, fq * 8), boff = lds_byte(wc * 32 + fr, fq * 8);
#define PG8_SA(b, h) (((b) * 2 + (h)) * HTB)
#define PG8_SB(b, h) ((4 + (b) * 2 + (h)) * HTB)
#define PG8_STAGE(bufoff, gbase, voff) do { _Pragma("unroll") for (int _i = 0; _i < 2; ++_i) \
        __builtin_amdgcn_global_load_lds((const unsigned*)((const char*)(gbase) + (voff)[_i]), (LAS unsigned*)(lds + (bufoff) + ldsw + _i * 8192), 16, 0, 0); } while (0)
#define PG8_LDA(dst, b, h) do { _Pragma("unroll") for (int m = 0; m < 4; ++m) _Pragma("unroll") for (int k = 0; k < 2; ++k) dst[m][k] = *(const LAS bf16x8*)(lds + PG8_SA(b, h) + aoff + m * 2048 + k * 1024); } while (0)
#define PG8_LDB(dst, b, h) do { _Pragma("unroll") for (int n = 0; n < 2; ++n) _Pragma("unroll") for (int k = 0; k < 2; ++k) dst[n][k] = *(const LAS bf16x8*)(lds + PG8_SB(b, h) + boff + n * 2048 + k * 1024); } while (0)
#define PG8_MMA(ai, bj, At, Bt) do { __builtin_amdgcn_s_setprio(1); _Pragma("unroll") for (int m = 0; m < 4; ++m) _Pragma("unroll") for (int n = 0; n < 2; ++n) _Pragma("unroll") for (int k = 0; k < 2; ++k) \
        acc[ai][bj][m][n] = __builtin_amdgcn_mfma_f32_16x16x32_bf16(Bt[n][k], At[m][k], acc[ai][bj][m][n], 0, 0, 0); __builtin_amdgcn_s_setprio(0); } while (0)
#define PG8_WAIT_V(n) asm volatile("s_waitcnt vmcnt(" #n ")" ::: "memory")
#define PG8_WAIT_L(n) asm volatile("s_waitcnt lgkmcnt(" #n ")" ::: "memory")
#define PG8_BAR __builtin_amdgcn_s_barrier()
#define PG8_SCHED __builtin_amdgcn_sched_barrier(0)
    int u = u0;
    if (u >= P.nunits) return;
    f32x4 acc[2][2][4][2];
#pragma unroll
    for (int a = 0; a < 2; ++a)
#pragma unroll
        for (int b = 0; b < 2; ++b)
#pragma unroll
            for (int m = 0; m < 4; ++m)
#pragma unroll
                for (int n = 0; n < 2; ++n) acc[a][b][m][n] = (f32x4){0.f, 0.f, 0.f, 0.f};
    bf16x8 At[4][2], B0[2][2], B1[2][2];
    const char* cA; const char* cB; P.locate(u, cA, cB);
    PG8_STAGE(PG8_SB(0, 0), cB, voffB); PG8_STAGE(PG8_SB(0, 1), cB + hstepB, voffB); PG8_STAGE(PG8_SA(0, 0), cA, voffA); PG8_STAGE(PG8_SA(0, 1), cA + hstepA, voffA);
    if (wr == 1) PG8_BAR;
    PG8_WAIT_V(2); PG8_BAR;
    PG8_STAGE(PG8_SB(1, 0), cB + kstep, voffB); PG8_STAGE(PG8_SA(1, 0), cA + kstep, voffA); PG8_STAGE(PG8_SB(1, 1), cB + hstepB + kstep, voffB);
    PG8_WAIT_V(6); PG8_BAR;
    for (;;) {
        const int un = u + ustride; const bool has_next = un < P.nunits;
        const char* nA = cA; const char* nB = cB; if (has_next) P.locate(un, nA, nB);
        for (int t = 0; t < nt; t += 2) {
            const bool last = (t == nt - 2);
            const char* a1 = cA + (size_t)(t + 1) * kstep;
            const char* a2 = last ? nA : cA + (size_t)(t + 2) * kstep; const char* b2 = last ? nB : cB + (size_t)(t + 2) * kstep;
            const char* a3 = a2 + kstep; const char* b3 = b2 + kstep;
            PG8_LDB(B0, 0, 0); PG8_LDB(B1, 0, 1); PG8_SCHED; PG8_LDA(At, 0, 0); PG8_STAGE(PG8_SA(1, 1), a1 + hstepA, voffA);
            PG8_WAIT_V(8); PG8_WAIT_L(0); PG8_BAR; PG8_MMA(0, 0, At, B0); PG8_MMA(0, 1, At, B1); PG8_BAR; PG8_SCHED;
            PG8_LDA(At, 0, 1); PG8_STAGE(PG8_SB(0, 0), b2, voffB); PG8_STAGE(PG8_SB(0, 1), b2 + hstepB, voffB); PG8_STAGE(PG8_SA(0, 0), a2, voffA);
            PG8_WAIT_V(8); PG8_WAIT_L(0); PG8_BAR; PG8_MMA(1, 0, At, B0); PG8_MMA(1, 1, At, B1); PG8_BAR; PG8_SCHED;
            PG8_LDB(B0, 1, 0); PG8_LDB(B1, 1, 1); PG8_SCHED; PG8_LDA(At, 1, 0); PG8_STAGE(PG8_SA(0, 1), a2 + hstepA, voffA);
            PG8_WAIT_V(8); PG8_WAIT_L(0); PG8_BAR; PG8_MMA(0, 0, At, B0); PG8_MMA(0, 1, At, B1); PG8_BAR; PG8_SCHED;
            PG8_LDA(At, 1, 1); PG8_STAGE(PG8_SB(1, 0), b3, voffB); PG8_STAGE(PG8_SB(1, 1), b3 + hstepB, voffB); PG8_STAGE(PG8_SA(1, 0), a3, voffA);
            PG8_WAIT_V(8); PG8_WAIT_L(0); PG8_BAR; PG8_MMA(1, 0, At, B0); PG8_MMA(1, 1, At, B1); PG8_BAR; PG8_SCHED;
        }
        if (wr == 0) PG8_BAR;
        P.epi(acc, u, wr, wc, fr, fq);
        if (!has_next) break;
#pragma unroll
        for (int a = 0; a < 2; ++a)
#pragma unroll
            for (int b = 0; b < 2; ++b)
#pragma unroll
                for (int m = 0; m < 4; ++m)
#pragma unroll
                    for (int n = 0; n < 2; ++n) acc[a][b][m][n] = (f32x4){0.f, 0.f, 0.f, 0.f};
        u = un; cA = nA; cB = nB;
        if (wr == 1) PG8_BAR;
    }
    PG8_WAIT_V(0);
    PG8_BAR;
#undef PG8_SA
#undef PG8_SB
#undef PG8_STAGE
#undef PG8_LDA
#undef PG8_LDB
#undef PG8_MMA
#undef PG8_WAIT_V
#undef PG8_WAIT_L
#undef PG8_BAR
#undef PG8_SCHED
}
__device__ __forceinline__ void tile_of(int u, int nM, int nN, int& pm, int& pn) {
    const int nig = 8 * nN, g = u / nig, r = u % nig, fm = g * 8, gsz = (nM - fm) < 8 ? (nM - fm) : 8;
    pm = fm + r % gsz; pn = r / gsz;
}
__device__ __forceinline__ void st8(bf16* p, f32x4 v0, f32x4 v1) {
    u32x4 w; w.x = cvt_pk_bf16(v0[0], v0[1]); w.y = cvt_pk_bf16(v0[2], v0[3]); w.z = cvt_pk_bf16(v1[0], v1[1]); w.w = cvt_pk_bf16(v1[2], v1[3]);
    *(u32x4*)p = w;
}
}

typedef __bf16 bf16x2_t __attribute__((ext_vector_type(2)));
__device__ __forceinline__ unsigned cvtpk(float lo, float hi) { f32x2 v = {lo, hi}; bf16x2_t b = __builtin_convertvector(v, bf16x2_t); return __builtin_bit_cast(unsigned, b); }

struct ProbPlain {
    static constexpr bool PERM = true;
    int K, lda, ldb, nunits; const bf16* A; const bf16* Bt; bf16* O; int ldc, nM, nN;
    __device__ __forceinline__ void locate(int u, const char*& a, const char*& b) const { int pm, pn; pg8::tile_of(u, nM, nN, pm, pn); a = (const char*)(A + (size_t)pm * 256 * lda); b = (const char*)(Bt + (size_t)pn * 256 * ldb); }
    __device__ __forceinline__ void epi(const f32x4 (&acc)[2][2][4][2], int u, int wr, int wc, int fr, int fq) const {
        int pm, pn; pg8::tile_of(u, nM, nN, pm, pn);
        const int row0 = pm * 256 + wr * 64 + fr, col0 = pn * 256 + wc * 32 + 8 * fq;
#pragma unroll
        for (int ai = 0; ai < 2; ++ai)
#pragma unroll
            for (int m = 0; m < 4; ++m) { bf16* rowp = O + (size_t)(row0 + ai * 128 + m * 16) * ldc + col0;
#pragma unroll
                for (int bj = 0; bj < 2; ++bj) pg8::st8(rowp + bj * 128, acc[ai][bj][m][0], acc[ai][bj][m][1]); }
    }
};
struct ProbOut {
    static constexpr bool PERM = false;
    int K, lda, ldb, nunits; const bf16* A; const bf16* Bt; const float* h; const float* gate; float* pre;
    __device__ __forceinline__ void locate(int u, const char*& a, const char*& b) const { int pm, pn; pg8::tile_of(u, 32, 8, pm, pn); a = (const char*)(A + (size_t)pm * 256 * lda); b = (const char*)(Bt + (size_t)pn * 256 * ldb); }
    __device__ __forceinline__ void epi(const f32x4 (&acc)[2][2][4][2], int u, int wr, int wc, int fr, int fq) const {
        int pm, pn; pg8::tile_of(u, 32, 8, pm, pn);
        const int row0 = pm * 256 + wr * 64 + fr, col0 = pn * 256 + wc * 32 + 4 * fq;
        const float* g = gate + (size_t)(pm >> 3) * (6 * D);
        f32x4 gv[2][2];
#pragma unroll
        for (int bj = 0; bj < 2; ++bj)
#pragma unroll
            for (int n = 0; n < 2; ++n) gv[bj][n] = *(const f32x4*)(g + col0 + bj * 128 + n * 16);
#pragma unroll
        for (int ai = 0; ai < 2; ++ai)
#pragma unroll
            for (int m = 0; m < 4; ++m) { const size_t off = (size_t)(row0 + ai * 128 + m * 16) * D + col0;
#pragma unroll
                for (int bj = 0; bj < 2; ++bj)
#pragma unroll
                    for (int n = 0; n < 2; ++n) { const f32x4 hv = *(const f32x4*)(h + off + bj * 128 + n * 16);
                        *(f32x4*)(pre + off + bj * 128 + n * 16) = hv * DN_ALPHA + gv[bj][n] * acc[ai][bj][m][n]; } }
    }
};
struct ProbMoe1 {
    static constexpr bool PERM = true;
    int K, lda, ldb, nunits; const bf16* XE; const bf16* W13; bf16* HDN;
    __device__ __forceinline__ void map(int u, int& rt, int& pn) const { const int b = u & 3, q = u >> 2; pn = q % 11; rt = (q / 11) * 4 + b; }
    __device__ __forceinline__ void locate(int u, const char*& a, const char*& b) const { int rt, pn; map(u, rt, pn); a = (const char*)(XE + (size_t)rt * 256 * D); b = (const char*)(W13 + (size_t)(rt >> 2) * (2 * FF * D) + (size_t)pn * 256 * D); }
    __device__ __forceinline__ void epi(const f32x4 (&acc)[2][2][4][2], int u, int wr, int wc, int fr, int fq) const {
        int rt, pn; map(u, rt, pn);
        const int row0 = rt * 256 + wr * 64 + fr, col0 = pn * 128 + wc * 32 + 8 * fq;
#pragma unroll
        for (int ai = 0; ai < 2; ++ai)
#pragma unroll
            for (int m = 0; m < 4; ++m) { bf16* rowp = HDN + (size_t)(row0 + ai * 128 + m * 16) * FF + col0;
                f32x4 v[2];
#pragma unroll
                for (int n = 0; n < 2; ++n) { const f32x4 a = acc[ai][0][m][n], g = acc[ai][1][m][n];
#pragma unroll
                    for (int j = 0; j < 4; ++j) v[n][j] = a[j] / (1.f + __expf(-a[j])) * g[j]; }
                pg8::st8(rowp, v[0], v[1]); }
    }
};
struct ProbMoe2 {
    static constexpr bool PERM = true;
    int K, lda, ldb, nunits; const bf16* HDN; const bf16* W2; const float* gate; bf16* YE;
    __device__ __forceinline__ void map(int u, int& rt, int& pn) const { const int b = u & 3, q = u >> 2; pn = q & 7; rt = (q >> 3) * 4 + b; }
    __device__ __forceinline__ void locate(int u, const char*& a, const char*& b) const { int rt, pn; map(u, rt, pn); a = (const char*)(HDN + (size_t)rt * 256 * FF); b = (const char*)(W2 + (size_t)(rt >> 2) * (D * FF) + (size_t)pn * 256 * FF); }
    __device__ __forceinline__ void epi(const f32x4 (&acc)[2][2][4][2], int u, int wr, int wc, int fr, int fq) const {
        int rt, pn; map(u, rt, pn);
        const int row0 = rt * 256 + wr * 64 + fr, col0 = pn * 256 + wc * 32 + 8 * fq;
#pragma unroll
        for (int ai = 0; ai < 2; ++ai)
#pragma unroll
            for (int m = 0; m < 4; ++m) { const int row = row0 + ai * 128 + m * 16; const float gt = gate[row]; bf16* rowp = YE + (size_t)row * D + col0;
#pragma unroll
                for (int bj = 0; bj < 2; ++bj) pg8::st8(rowp + bj * 128, acc[ai][bj][m][0] * gt, acc[ai][bj][m][1] * gt); }
    }
};
struct ProbF1 {
    static constexpr bool PERM = true;
    int K, lda, ldb, nunits; const bf16* CS; const bf16* P1; bf16* T1;
    __device__ __forceinline__ void map(int u, int& bg, int& pm, int& pn) const { pn = u & 7; pm = (u >> 3) & 1; bg = u >> 4; }
    __device__ __forceinline__ void locate(int u, const char*& a, const char*& b) const { int bg, pm, pn; map(u, bg, pm, pn);
        a = (const char*)(CS + (size_t)pm * 256 * 256); b = (const char*)(P1 + ((size_t)(bg >> 2) * SEQ + (size_t)pn * 256) * IN_CD + HY3 + (bg & 3) * 256); }
    __device__ __forceinline__ void epi(const f32x4 (&acc)[2][2][4][2], int u, int wr, int wc, int fr, int fq) const {
        int bg, pm, pn; map(u, bg, pm, pn);
        const int k20 = wr * 64 + fr, col0 = pn * 256 + wc * 32 + 8 * fq;
#pragma unroll
        for (int ai = 0; ai < 2; ++ai)
#pragma unroll
            for (int m = 0; m < 4; ++m) { const int k2 = k20 + ai * 128 + m * 16; bf16* rowp = T1 + (((size_t)bg * 256 + k2) * 2 + pm) * SEQ + col0;
#pragma unroll
                for (int bj = 0; bj < 2; ++bj) pg8::st8(rowp + bj * 128, acc[ai][bj][m][0], acc[ai][bj][m][1]); }
    }
};
struct ProbF2 {
    static constexpr bool PERM = true;
    int K, lda, ldb, nunits; const bf16* CSL; const bf16* T1; bf16* CAT;
    __device__ __forceinline__ void locate(int u, const char*& a, const char*& b) const { const int pm = u & 7, bg = u >> 3; a = (const char*)(CSL + (size_t)pm * 256 * 4096); b = (const char*)(T1 + (size_t)bg * 256 * 4096); }
    __device__ __forceinline__ void epi(const f32x4 (&acc)[2][2][4][2], int u, int wr, int wc, int fr, int fq) const {
        const int pm = u & 7, bg = u >> 3;
        const int row0 = (bg >> 2) * SEQ + pm * 256 + wr * 64 + fr, col0 = 1024 + (bg & 3) * 256 + wc * 32 + 8 * fq;
#pragma unroll
        for (int ai = 0; ai < 2; ++ai)
#pragma unroll
            for (int m = 0; m < 4; ++m) { bf16* rowp = CAT + (size_t)(row0 + ai * 128 + m * 16) * D + col0;
#pragma unroll
                for (int bj = 0; bj < 2; ++bj) pg8::st8(rowp + bj * 128, acc[ai][bj][m][0], acc[ai][bj][m][1]); }
    }
};

namespace att {
typedef short v4i16_t __attribute__((ext_vector_type(4)));
__device__ __forceinline__ s16x4 vtr(const LAS unsigned char* p) { return __builtin_bit_cast(s16x4, __builtin_amdgcn_ds_read_tr16_b64_v4i16((LAS v4i16_t*)p)); }
constexpr int VS = 320;
struct Tensors { const bf16* P; const bf16* KV; const bf16* KPE; const float* rpb; bf16* CAT; };

template <int MODE>
__device__ __forceinline__ void attn_unit(LAS unsigned char* lds, const Tensors& T, int unit) {
    constexpr int DK = MODE == 0 ? 192 : 128, NS = DK / 16, KCH = DK / 8, KS = DK * 2 + 16;
    constexpr int KBYTES = 64 * KS, VBYTES = 64 * VS, BUF = KBYTES + VBYTES;
    constexpr int NKC = (64 * KCH) / NTHR;
    const int tid = tid_opaque(), wave = __builtin_amdgcn_readfirstlane(tid >> 6), lane = tid & 63, l32 = lane & 31, hf = lane >> 5;
    const int b = unit >> 6, h = (unit >> 3) & 7, sub = unit & 7;
    LAS float* rpb_l = (LAS float*)(lds + 2 * BUF);
    int qrow, r = 0, qc = 0, krlo = 0, nkt;
    if (MODE == 0) { qrow = b * SEQ + sub * 256 + wave * 32 + l32; nkt = 36; }
    else { r = sub * 4 + (wave >> 1); qc = (wave & 1) * 32 + l32; qrow = b * SEQ + r * GW + qc;
        const int r0 = sub * 4, r3 = r0 + 3; krlo = r0 - 4 < 0 ? 0 : (r0 - 4 > 24 ? 24 : r0 - 4); const int rs3 = r3 - 4 < 0 ? 0 : (r3 - 4 > 24 ? 24 : r3 - 4);
        nkt = 4 + (rs3 + 8 - krlo); }
    const int rs = r - 4 < 0 ? 0 : (r - 4 > 24 ? 24 : r - 4);
    const int cs = qc - 8 < 0 ? 0 : (qc - 8 > 48 ? 48 : qc - 8);
    bf16x8 qf[NS];
    { const bf16* qp = T.P + (size_t)qrow * IN_AB_PAD + (MODE == 0 ? h * 192 : OFF_QNA + h * 128) + 8 * hf;
#pragma unroll
      for (int s = 0; s < NS; ++s) qf[s] = *(const bf16x8*)(qp + 16 * s); }
    if (MODE == 1) { for (int i = tid; i < 15 * 31; i += NTHR) rpb_l[i] = T.rpb[h * 465 + i]; }
    u32x4 kreg[NKC], vreg[2];
    auto key_row = [&](int kt, int rr) -> int {
        if (MODE == 0) return kt < 32 ? b * SEQ + kt * 64 + rr : MLAT + b * LC + (kt - 32) * 64 + rr;
        return kt < 4 ? MLAT + b * LC + kt * 64 + rr : b * SEQ + (krlo + kt - 4) * GW + rr;
    };
    auto load_tile = [&](int kt) {
#pragma unroll
        for (int i = 0; i < NKC; ++i) { const int ci = tid + i * NTHR, rr = ci / KCH, c = ci % KCH; const int row = key_row(kt, rr);
            const bf16* src;
            if (MODE == 0) src = c < 16 ? T.KV + (size_t)row * D + h * 256 + c * 8 : T.KPE + (size_t)row * 64 + (c - 16) * 8;
            else src = T.P + (size_t)row * IN_AB_PAD + OFF_KNA + h * 128 + c * 8;
            kreg[i] = *(const u32x4*)src; }
#pragma unroll
        for (int i = 0; i < 2; ++i) { const int ci = tid + i * NTHR, rr = ci >> 4, c = ci & 15; const int row = key_row(kt, rr);
            const bf16* src = MODE == 0 ? T.KV + (size_t)row * D + h * 256 + 128 + c * 8 : T.P + (size_t)row * IN_AB_PAD + OFF_VNA + h * 128 + c * 8;
            vreg[i] = *(const u32x4*)src; }
    };
    auto store_tile = [&](int buf) {
        LAS unsigned char* kb = lds + buf * BUF; LAS unsigned char* vb = kb + KBYTES;
#pragma unroll
        for (int i = 0; i < NKC; ++i) { const int ci = tid + i * NTHR, rr = ci / KCH, c = ci % KCH; *(LAS u32x4*)(kb + rr * KS + c * 16) = kreg[i]; }
#pragma unroll
        for (int i = 0; i < 2; ++i) { const int ci = tid + i * NTHR, rr = ci >> 4, c = ci & 15; *(LAS u32x4*)(vb + rr * VS + c * 16) = vreg[i]; }
    };
    f32x16 o[4];
#pragma unroll
    for (int c = 0; c < 4; ++c)
#pragma unroll
        for (int i = 0; i < 16; ++i) o[c][i] = 0.f;
    float m_run = -1e30f, l_run = 0.f;
    const float sc2 = (MODE == 0 ? 0.07216878364870322f : 0.08838834764831845f) * 1.4426950408889634f;
    load_tile(0); store_tile(0); __syncthreads();
    for (int kt = 0; kt < nkt; ++kt) {
        if (kt + 1 < nkt) load_tile(kt + 1);
        const int kr = krlo + kt - 4;
        const bool active = MODE == 0 || kt < 4 || (kr >= rs && kr < rs + 8);
        if (active) {
            const LAS unsigned char* kb = lds + (kt & 1) * BUF; const LAS unsigned char* vb = kb + KBYTES;
#pragma unroll
            for (int kb2 = 0; kb2 < 2; ++kb2) {
                f32x16 sc;
#pragma unroll
                for (int i = 0; i < 16; ++i) sc[i] = 0.f;
#pragma unroll
                for (int s = 0; s < NS; ++s) { const bf16x8 kf = *(const LAS bf16x8*)(kb + (32 * kb2 + l32) * KS + (16 * s + 8 * hf) * 2);
                    sc = __builtin_amdgcn_mfma_f32_32x32x16_bf16(kf, qf[s], sc, 0, 0, 0); }
                float mx = -1e30f;
#pragma unroll
                for (int i = 0; i < 16; ++i) {
                    float v = sc[i] * sc2;
                    if (MODE == 1 && kt >= 4) { const int kc = 32 * kb2 + 8 * (i >> 2) + 4 * hf + (i & 3); const int dcl = kc - cs; const bool ok = (unsigned)dcl < 16u;
                        int bi = (kr - r + 7) * 31 + (kc - qc + 15); bi = ok ? bi : 0;
                        v = ok ? v + rpb_l[bi] * 1.4426950408889634f : -1e30f; }
                    sc[i] = v; mx = fmaxf(mx, v); }
                mx = fmaxf(mx, __shfl_xor(mx, 32));
                const float m_new = fmaxf(m_run, mx), alpha = __builtin_amdgcn_exp2f(m_run - m_new);
                m_run = m_new;
                float ps = 0.f;
#pragma unroll
                for (int i = 0; i < 16; ++i) { const float p = __builtin_amdgcn_exp2f(sc[i] - m_new); sc[i] = p; ps += p; }
                l_run = l_run * alpha + ps;
                if (__builtin_amdgcn_ballot_w64(alpha != 1.f) != 0ull) {
#pragma unroll
                    for (int c = 0; c < 4; ++c)
#pragma unroll
                        for (int i = 0; i < 16; ++i) o[c][i] *= alpha; }
#pragma unroll
                for (int s2 = 0; s2 < 2; ++s2) {
                    u32x4 pw; pw.x = cvtpk(sc[8 * s2 + 0], sc[8 * s2 + 1]); pw.y = cvtpk(sc[8 * s2 + 2], sc[8 * s2 + 3]);
                    pw.z = cvtpk(sc[8 * s2 + 4], sc[8 * s2 + 5]); pw.w = cvtpk(sc[8 * s2 + 6], sc[8 * s2 + 7]);
                    const bf16x8 pf = __builtin_bit_cast(bf16x8, pw);
                    const LAS unsigned char* vrow = vb + (32 * kb2 + 16 * s2 + 4 * hf + ((lane & 15) >> 2)) * VS + (16 * ((lane >> 4) & 1) + 4 * (lane & 3)) * 2;
#pragma unroll
                    for (int c = 0; c < 4; ++c) {
                        const s16x4 v0 = vtr(vrow + c * 64), v1 = vtr(vrow + 8 * VS + c * 64);
                        const bf16x8 vf = {v0[0], v0[1], v0[2], v0[3], v1[0], v1[1], v1[2], v1[3]};
                        o[c] = __builtin_amdgcn_mfma_f32_32x32x16_bf16(vf, pf, o[c], 0, 0, 0); }
                }
            }
        }
        if (kt + 1 < nkt) store_tile((kt + 1) & 1);
        __syncthreads();
    }
    const float linv = 1.f / (l_run + __shfl_xor(l_run, 32));
    bf16* op = T.CAT + (size_t)qrow * D + (MODE == 0 ? h * 128 : 1024 + h * 128) + 4 * hf;
#pragma unroll
    for (int c = 0; c < 4; ++c)
#pragma unroll
        for (int g = 0; g < 4; ++g) { u32x2 w; w.x = cvtpk(o[c][4 * g] * linv, o[c][4 * g + 1] * linv); w.y = cvtpk(o[c][4 * g + 2] * linv, o[c][4 * g + 3] * linv);
            *(u32x2*)(op + 32 * c + 8 * g) = w; }
}
}

namespace hy {
constexpr int ZROW = 32 * 144 + 16;
constexpr int Z_BYTES = 16 * ZROW;
constexpr int HR_OFF = 74240;
constexpr int HR_CH = 16384;
constexpr int XROW = 4096 + 16;
constexpr int HR_BYTES = 16 * XROW;
static_assert(HR_OFF + HR_BYTES <= LDS_MAIN && HR_OFF >= Z_BYTES && HR_BYTES >= 4 * HR_CH, "hyena LDS map");

__device__ __forceinline__ void load_rows(LAS unsigned char* lds, const bf16* ST, int part, int c0, bool zlayout) {
    const int tid = tid_opaque();
#pragma unroll
    for (int i = 0; i < 8; ++i) { const int ci = tid + i * NTHR, row = ci >> 8, cc = ci & 255, ch = row >> 2, b = row & 3;
        const u32x4 v = *(const u32x4*)(ST + ((size_t)(b * HY3 + part * HYW + c0 + ch) * SEQ + cc * 8));
        if (zlayout) *(LAS u32x4*)(lds + row * ZROW + (cc >> 3) * 144 + (cc & 7) * 16) = v;
        else *(LAS u32x4*)(lds + HR_OFF + row * XROW + cc * 16) = v; }
}
__device__ __forceinline__ void load_hr(LAS unsigned char* lds, const bf16* HRg, int o, int c0) {
    const int tid = tid_opaque();
#pragma unroll
    for (int i = 0; i < 4; ++i) { const int ci = tid + i * NTHR, ch = ci >> 9, cc = ci & 511;
        const unsigned* src = (const unsigned*)(HRg + ((size_t)(o * HYW + c0 + ch) * 4096 + cc * 8));
        const u32x4 v = *(const u32x4*)src; const unsigned nx = cc == 511 ? 0u : src[4];
        *(LAS u32x4*)(lds + HR_OFF + ch * HR_CH + cc * 16) = v;
        u32x4 s; s.x = (v.x >> 16) | (v.y << 16); s.y = (v.y >> 16) | (v.z << 16); s.z = (v.z >> 16) | (v.w << 16); s.w = (v.w >> 16) | (nx << 16);
        *(LAS u32x4*)(lds + HR_OFF + ch * HR_CH + 8192 + cc * 16) = s; }
}
__device__ __forceinline__ void conv_mma(LAS unsigned char* lds, f32x16 (&acc)[4], int wave, int lane) {
    const int ch = wave >> 1, a0 = (wave & 1) * 32, l32 = lane & 31, hf = lane >> 5, il = l32 >> 2, b = l32 & 3;
    const LAS unsigned char* hrc = lds + HR_OFF + ch * HR_CH;
    const LAS unsigned char* zl = lds + (ch * 4 + b) * ZROW + hf * 16;
#pragma unroll
    for (int n = 0; n < 4; ++n)
#pragma unroll
        for (int i = 0; i < 16; ++i) acc[n][i] = 0.f;
    for (int d = -31; d <= 31; ++d) {
        const int ilo = d > 0 ? d : 0, ihi = d < 0 ? 31 + d : 31;
#pragma unroll
        for (int k4 = 0; k4 < 4; ++k4) { const int k0 = 16 * k4;
            const int x0 = 2048 - 64 * d + k0 - a0 - l32 + 8 * hf;
            const LAS unsigned* ap = (const LAS unsigned*)(hrc + (x0 & 1) * 8192 + (x0 >> 1) * 4);
            u32x4 aw; aw.x = ap[0]; aw.y = ap[1]; aw.z = ap[2]; aw.w = ap[3];
            const bf16x8 af = __builtin_bit_cast(bf16x8, aw);
#pragma unroll
            for (int n = 0; n < 4; ++n) if (8 * n + 7 >= ilo && 8 * n <= ihi) {
                const int j = 8 * n + il - d; const bool ok = (unsigned)j < 32u; const int jc = ok ? j : 0;
                u32x4 bw = *(const LAS u32x4*)(zl + jc * 144 + k0 * 2);
                if (!ok) bw = (u32x4){0u, 0u, 0u, 0u};
                acc[n] = __builtin_amdgcn_mfma_f32_32x32x16_bf16(af, __builtin_bit_cast(bf16x8, bw), acc[n], 0, 0, 0); }
        }
    }
}
__device__ __forceinline__ void gate_epi(LAS unsigned char* lds, f32x16 (&acc)[4], float skip, int wave, int lane) {
    const int ch = wave >> 1, a0 = (wave & 1) * 32, l32 = lane & 31, hf = lane >> 5, il = l32 >> 2, b = l32 & 3;
#pragma unroll
    for (int n = 0; n < 4; ++n)
#pragma unroll
        for (int g = 0; g < 4; ++g) { const int i = 8 * n + il, ao = a0 + 8 * g + 4 * hf;
            const u32x2 zw = *(const LAS u32x2*)(lds + (ch * 4 + b) * ZROW + i * 144 + ao * 2);
            const u32x2 xw = *(const LAS u32x2*)(lds + HR_OFF + (ch * 4 + b) * XROW + (64 * i + ao) * 2);
            acc[n][4 * g + 0] = bflo(xw.x) * (acc[n][4 * g + 0] + skip * bflo(zw.x));
            acc[n][4 * g + 1] = bfhi(xw.x) * (acc[n][4 * g + 1] + skip * bfhi(zw.x));
            acc[n][4 * g + 2] = bflo(xw.y) * (acc[n][4 * g + 2] + skip * bflo(zw.y));
            acc[n][4 * g + 3] = bfhi(xw.y) * (acc[n][4 * g + 3] + skip * bfhi(zw.y)); }
}
__device__ __forceinline__ void hyena_unit(LAS unsigned char* lds, const bf16* ST, const bf16* HRg, const float* skip, bf16* CAT, int unit) {
    const int tid = tid_opaque(), wave = __builtin_amdgcn_readfirstlane(tid >> 6), lane = tid & 63;
    const int c0 = unit * 4, ch = wave >> 1, a0 = (wave & 1) * 32, l32 = lane & 31, hf = lane >> 5, il = l32 >> 2, b = l32 & 3;
    f32x16 acc[4];
    load_rows(lds, ST, 0, c0, true); load_hr(lds, HRg, 0, c0);
    __syncthreads();
    conv_mma(lds, acc, wave, lane);
    __syncthreads();
    load_rows(lds, ST, 1, c0, false);
    __syncthreads();
    gate_epi(lds, acc, skip[c0 + ch], wave, lane);
    __syncthreads();
#pragma unroll
    for (int n = 0; n < 4; ++n)
#pragma unroll
        for (int g = 0; g < 4; ++g) { const int i = 8 * n + il, ao = a0 + 8 * g + 4 * hf;
            u32x2 w; w.x = cvtpk(acc[n][4 * g], acc[n][4 * g + 1]); w.y = cvtpk(acc[n][4 * g + 2], acc[n][4 * g + 3]);
            *(LAS u32x2*)(lds + (ch * 4 + b) * ZROW + i * 144 + ao * 2) = w; }
    load_hr(lds, HRg, 1, c0);
    __syncthreads();
    conv_mma(lds, acc, wave, lane);
    __syncthreads();
    load_rows(lds, ST, 2, c0, false);
    __syncthreads();
    gate_epi(lds, acc, skip[HYW + c0 + ch], wave, lane);
    __syncthreads();
    LAS bf16* Y = (LAS bf16*)lds;
#pragma unroll
    for (int n = 0; n < 4; ++n)
#pragma unroll
        for (int e = 0; e < 16; ++e) { const int t = 64 * (8 * n + il) + a0 + 8 * (e >> 2) + 4 * hf + (e & 3);
            Y[(b * SEQ + t) * 4 + ch] = (bf16)f2bf(acc[n][e]); }
    __syncthreads();
#pragma unroll 4
    for (int i = 0; i < 16; ++i) { const int it = tid + i * NTHR; const u32x2 v = *(const LAS u32x2*)(lds + it * 8);
        *(u32x2*)(CAT + (size_t)it * D + c0) = v; }
    __syncthreads();
}
}

__device__ __forceinline__ void prep_item(LAS unsigned char* scr, const bf16* P1, const float* cw, const float* cb, bf16* ST, int item, int lane) {
    const int ct = item % 48, tt = (item / 48) & 31, b = item / (48 * 32), t0 = tt * 64, c30 = ct * 64;
#pragma unroll
    for (int i = 0; i < 9; ++i) { const int ci = lane + i * 64; if (ci < 66 * 8) { const int rr = ci >> 3, cc = ci & 7, t = t0 - 1 + rr;
        u32x4 v = (u32x4){0u, 0u, 0u, 0u};
        if (t >= 0 && t < SEQ) v = *(const u32x4*)(P1 + ((size_t)(b * SEQ + t) * IN_CD + c30 + cc * 8));
        *(LAS u32x4*)(scr + rr * 144 + cc * 16) = v; } }
    LDS_WAIT(); asm volatile("" ::: "memory");
    const LAS bf16* tile = (const LAS bf16*)scr;
    for (int c = 0; c < 64; ++c) { const int c3 = c30 + c;
        const float w0 = cw[c3], w1 = cw[HY3 + c3], w2 = cw[2 * HY3 + c3], bb = cb[c3];
        const float v = bb + w0 * bf2f(tile[lane * 72 + c]) + w1 * bf2f(tile[(lane + 1) * 72 + c]) + w2 * bf2f(tile[(lane + 2) * 72 + c]);
        ST[(size_t)(b * HY3 + c3) * SEQ + t0 + lane] = (bf16)f2bf(v); }
    LDS_WAIT(); asm volatile("" ::: "memory");
}

__device__ __forceinline__ void transpose_item(const float* W, int N, bf16* WT, int ldt, int k0, int n0, int drow0, LAS float* scr, int lane) {
#pragma unroll 8
    for (int i = 0; i < 32; ++i) { const int kk = 2 * i + (lane >> 5); scr[kk * 33 + (lane & 31)] = W[(size_t)(k0 + kk) * N + n0 + (lane & 31)]; }
    LDS_WAIT(); asm volatile("" ::: "memory");
    const int c = lane & 7;
#pragma unroll
    for (int j = 0; j < 4; ++j) { const int n = (lane >> 3) + 8 * j; const LAS float* s = scr + (8 * c) * 33 + n;
        u32x4 o; o.x = pk2(s[0 * 33], s[1 * 33]); o.y = pk2(s[2 * 33], s[3 * 33]); o.z = pk2(s[4 * 33], s[5 * 33]); o.w = pk2(s[6 * 33], s[7 * 33]);
        *(u32x4*)(WT + (size_t)(drow0 + n) * ldt + k0 + 8 * c) = o; }
    LDS_WAIT(); asm volatile("" ::: "memory");
}

struct Args { const float* in[31]; float* out; unsigned char* ws; int ph_lo, ph_hi; };
enum { I_X = 0, I_C, I_CTX, I_CCTX, I_ADAW, I_ADAB, I_LN1G, I_LN1B, I_LN2G, I_LN2B, I_ROUTER, I_W1, I_W3, I_W2, I_ABIN, I_KVNORM, I_UKV, I_RPB, I_ABOUT,
       I_CDIN, I_CONVW, I_CONVB, I_FW1, I_FB1, I_FF1, I_FW2, I_FB2, I_FF2, I_FW3, I_SKIP, I_CDOUT };
constexpr int NPHASE = 21;
typedef const char __attribute__((address_space(4)))* kptr_t;
__device__ __forceinline__ const float* kin(int i) { kptr_t ka = (kptr_t)__builtin_amdgcn_kernarg_segment_ptr(); int off = i * 8; asm volatile("" : "+s"(off)); return *(const float* const __attribute__((address_space(4)))*)(ka + off); }
__device__ __forceinline__ float* kout() { kptr_t ka = (kptr_t)__builtin_amdgcn_kernarg_segment_ptr(); int off = 31 * 8; asm volatile("" : "+s"(off)); return *(float* const __attribute__((address_space(4)))*)(ka + off); }
__device__ __forceinline__ unsigned char* kws() { kptr_t ka = (kptr_t)__builtin_amdgcn_kernarg_segment_ptr(); int off = 32 * 8; asm volatile("" : "+s"(off)); return *(unsigned char* const __attribute__((address_space(4)))*)(ka + off); }
static_assert(sizeof(Args) == 33 * 8 + 8, "Args layout");

__device__ __forceinline__ void ada_phase(LAS unsigned char* lds, const Args& A, int vcu, int G) {
    const int tid = tid_opaque();
    LAS float* sil = (LAS float*)lds; LAS float* part = sil + 5 * D;
    float* ADA = (float*)(kws() + WS_ADA);
    for (int i = tid; i < 5 * D; i += NTHR) { const int r = i / D, k = i % D; const float x = r < 4 ? kin(I_C)[r * D + k] : kin(I_CCTX)[k]; sil[i] = x / (1.f + expf(-x)); }
    __syncthreads();
    const int kg = tid >> 4, c4 = tid & 15;
    for (int unit = vcu; unit < 384; unit += G) {
        const int l = unit / 192, col0 = (unit % 192) * 64;
        f32x4 acc[5];
#pragma unroll
        for (int r = 0; r < 5; ++r) acc[r] = (f32x4){0.f, 0.f, 0.f, 0.f};
        const float* W = kin(I_ADAW) + (size_t)l * D * (6 * D) + col0 + 4 * c4;
#pragma unroll 8
        for (int i = 0; i < 64; ++i) { const int row = kg * 64 + i; const f32x4 w = *(const f32x4*)(W + (size_t)row * (6 * D));
#pragma unroll
            for (int r = 0; r < 5; ++r) acc[r] += w * sil[r * D + row]; }
#pragma unroll
        for (int r = 0; r < 5; ++r) *(LAS f32x4*)(part + ((kg * 16 + c4) * 5 + r) * 4) = acc[r];
        __syncthreads();
        if (tid < 320) { const int r = tid >> 6, col = tid & 63; float s = 0.f;
            for (int g = 0; g < 32; ++g) s += part[((g * 16 + (col >> 2)) * 5 + r) * 4 + (col & 3)];
            ADA[(size_t)(l * 5 + r) * (6 * D) + col0 + col] = s + kin(I_ADAB)[l * 6 * D + col0 + col]; }
        __syncthreads();
    }
}
__device__ __forceinline__ void filt_phase(LAS unsigned char* lds, const Args& A, int vcu, int G) {
    const int tid = tid_opaque(), wave = __builtin_amdgcn_readfirstlane(tid >> 6), lane = tid & 63;
    LAS float* zf = (LAS float*)lds;
    LAS float* h1 = zf + 64 * 33;
    LAS float* h2 = h1 + 64 * 65;
    bf16* HRg = (bf16*)(kws() + WS_HR);
    const float* fw1 = kin(I_FW1); const float* fb1 = kin(I_FB1); const float* ff1 = kin(I_FF1);
    const float* fw2 = kin(I_FW2); const float* fb2 = kin(I_FB2); const float* ff2 = kin(I_FF2); const float* fw3 = kin(I_FW3);
    for (int unit = vcu; unit < 256; unit += G) {
        const int lb = unit >> 3, cbk = unit & 7, l = lb * 64 + lane;
        const float t01 = (float)l / 2047.f, w = 6.283185307179586f * (float)l / 2048.f;
        for (int f = wave; f < 33; f += 8) { float v;
            if (f == 0) v = t01; else { const int j = (f - 1) & 15; const float band = 1e-4f + (float)j * ((15.f - 1e-4f) / 15.f); v = f <= 16 ? cosf(w * band) : -sinf(w * band); }
            zf[lane * 33 + f] = v; }
        __syncthreads();
        { float a[8];
#pragma unroll
          for (int i = 0; i < 8; ++i) a[i] = fb1[wave * 8 + i];
#pragma unroll 1
          for (int f = 0; f < 33; ++f) { const float z = zf[lane * 33 + f];
#pragma unroll
              for (int i = 0; i < 8; ++i) a[i] += z * fw1[f * 64 + wave * 8 + i]; }
#pragma unroll
          for (int i = 0; i < 8; ++i) h1[lane * 65 + wave * 8 + i] = sinf(ff1[wave * 8 + i] * a[i]); }
        __syncthreads();
        { float a[8];
#pragma unroll
          for (int i = 0; i < 8; ++i) a[i] = fb2[wave * 8 + i];
#pragma unroll 1
          for (int f = 0; f < 64; ++f) { const float z = h1[lane * 65 + f];
#pragma unroll
              for (int i = 0; i < 8; ++i) a[i] += z * fw2[f * 64 + wave * 8 + i]; }
#pragma unroll
          for (int i = 0; i < 8; ++i) h2[lane * 65 + wave * 8 + i] = sinf(ff2[wave * 8 + i] * a[i]); }
        __syncthreads();
        for (int cg = 0; cg < 4; ++cg) {
            const int col0 = cbk * 512 + wave * 64 + cg * 16;
            float acc[16];
#pragma unroll
            for (int i = 0; i < 16; ++i) acc[i] = 0.f;
#pragma unroll 1
            for (int j = 0; j < 64; ++j) { const float hv = h2[lane * 65 + j]; const float* wr = fw3 + (size_t)j * 4096 + col0;
#pragma unroll
                for (int i = 0; i < 16; ++i) acc[i] += hv * wr[i]; }
            const int o = col0 >> 11, dir = (col0 >> 10) & 1, cbase = col0 & 1023;
#pragma unroll
            for (int i = 0; i < 16; ++i) { const int c = cbase + i;
                const float delta = fabsf(-3.0701134573253946f + (float)c * ((-15.350567286626973f + 3.0701134573253946f) / 1023.f));
                const float v = acc[i] * expf(-t01 * delta);
                bf16* row = HRg + (size_t)(o * HYW + c) * 4096;
                if (dir == 0) row[2048 - l] = (bf16)f2bf(v); else row[l == 0 ? 0 : 2048 + l] = l == 0 ? (bf16)0 : (bf16)f2bf(v); }
        }
        __syncthreads();
    }
}
__device__ __forceinline__ void convert_phase(LAS unsigned char* lds, const Args& A, int vcu, int G) {
    const int tid = tid_opaque(), wave = __builtin_amdgcn_readfirstlane(tid >> 6), lane = tid & 63;
    LAS float* scr = (LAS float*)(lds + wave * 16384);
    const int gw = vcu * NWAVES + wave, NGW = G * NWAVES;
    unsigned char* ws = kws();
    constexpr int N0 = 32 * 162, N1 = 8 * 64, N2 = 32 * 64, N3 = 32 * 128, N4 = 32 * 64, NEI = 32 * 44, N5 = 32 * NEI, N6 = N5, N7 = 32 * (22 * 64);
    constexpr int NIT = N0 + N1 + N2 + N3 + N4 + N5 + N6 + N7;
    for (int it = gw; it < NIT; it += NGW) {
        int r = it;
        if (r < N5) { const int le = r / NEI, q = r % NEI, kb = q / 44, nb = q % 44, f0 = nb * 32;
            transpose_item(kin(I_W1) + (size_t)le * D * FF, FF, (bf16*)(ws + WS_W13) + (size_t)le * (2 * FF * D), D, kb * 64, f0, (f0 >> 7) * 256 + (f0 & 127), scr, lane); continue; } r -= N5;
        if (r < N6) { const int le = r / NEI, q = r % NEI, kb = q / 44, nb = q % 44, f0 = nb * 32;
            transpose_item(kin(I_W3) + (size_t)le * D * FF, FF, (bf16*)(ws + WS_W13) + (size_t)le * (2 * FF * D), D, kb * 64, f0, (f0 >> 7) * 256 + 128 + (f0 & 127), scr, lane); continue; } r -= N6;
        if (r < N7) { const int le = r / NEI, q = r % NEI, kb = q / 64, nb = q % 64;
            transpose_item(kin(I_W2) + (size_t)le * FF * D, D, (bf16*)(ws + WS_W2) + (size_t)le * (D * FF), FF, kb * 64, nb * 32, nb * 32, scr, lane); continue; } r -= N7;
        if (r < N0) { transpose_item(kin(I_ABIN), IN_AB, (bf16*)(ws + WS_WAB), D, (r / 162) * 64, (r % 162) * 32, (r % 162) * 32, scr, lane); continue; } r -= N0;
        if (r < N1) { transpose_item(kin(I_UKV), D, (bf16*)(ws + WS_WUKV), KVR, (r / 64) * 64, (r % 64) * 32, (r % 64) * 32, scr, lane); continue; } r -= N1;
        if (r < N2) { transpose_item(kin(I_ABOUT), D, (bf16*)(ws + WS_WABO), D, (r / 64) * 64, (r % 64) * 32, (r % 64) * 32, scr, lane); continue; } r -= N2;
        if (r < N3) { transpose_item(kin(I_CDIN), IN_CD, (bf16*)(ws + WS_WCD), D, (r / 128) * 64, (r % 128) * 32, (r % 128) * 32, scr, lane); continue; } r -= N3;
        transpose_item(kin(I_CDOUT), D, (bf16*)(ws + WS_WCDO), D, (r / 64) * 64, (r % 64) * 32, (r % 64) * 32, scr, lane);
    }
    const size_t gt = (size_t)vcu * NTHR + tid, NGT = (size_t)G * NTHR;
    { u32x4* z = (u32x4*)(ws + WS_WAB + (size_t)IN_AB * D * 2); for (size_t i = gt; i < (size_t)(IN_AB_PAD - IN_AB) * D * 2 / 16; i += NGT) z[i] = (u32x4){0u, 0u, 0u, 0u}; }
    { unsigned* cs = (unsigned*)(ws + WS_CS256);
      for (size_t i = gt; i < 512 * 128; i += NGT) { const int row = (int)(i >> 7), n = (int)(i & 127) * 2, k2 = row & 255; const bool sn = row >= 256;
          const float a0 = (float)((k2 * n) & 255) * (1.f / 128.f), a1 = (float)((k2 * (n + 1)) & 255) * (1.f / 128.f);
          cs[i] = pk2((sn ? sinpif(a0) : cospif(a0)) * 0.0625f, (sn ? sinpif(a1) : cospif(a1)) * 0.0625f); } }
    { unsigned* cl = (unsigned*)(ws + WS_CSL);
      const float nrm = 0.022097086912079608f;
      for (size_t i = gt; i < (size_t)2048 * 2048; i += NGT) { const int k1 = (int)(i >> 11), j = (int)(i & 2047) * 2; const bool sn = j >= 2048; const int t = j & 2047;
          const float a0 = (float)((k1 * t) & 2047) * (1.f / 1024.f), a1 = (float)((k1 * (t + 1)) & 2047) * (1.f / 1024.f);
          cl[i] = pk2((sn ? -sinpif(a0) : cospif(a0)) * nrm, (sn ? -sinpif(a1) : cospif(a1)) * nrm); } }
}
__device__ __forceinline__ void mod_row(const float* xrow, const float* shift, const float* scale, bf16* orow, int lane) {
#pragma unroll
    for (int j = 0; j < 8; ++j) { const int c = 4 * lane + 256 * j; const f32x4 x = *(const f32x4*)(xrow + c), sh = *(const f32x4*)(shift + c), sc = *(const f32x4*)(scale + c);
        const f32x4 u = x * (sc + 1.f) + sh; u32x2 w; w.x = pk2(u[0], u[1]); w.y = pk2(u[2], u[3]); *(u32x2*)(orow + c) = w; }
}
__device__ __forceinline__ void modulate_phase(const Args& A, int vcu, int G) {
    const int tid = tid_opaque(), lane = tid & 63, gw = vcu * NWAVES + __builtin_amdgcn_readfirstlane(tid >> 6), NGW = G * NWAVES;
    const float* ADA = (const float*)(kws() + WS_ADA); bf16* U = (bf16*)(kws() + WS_UALL);
    for (int row = gw; row < MALL; row += NGW) {
        if (row < MLAT) { const int b = row >> 11; mod_row(kin(I_X) + (size_t)row * D, ADA + (size_t)b * 6 * D, ADA + (size_t)b * 6 * D + D, U + (size_t)row * D, lane); }
        else mod_row(kin(I_CTX) + (size_t)(row - MLAT) * D, ADA + (size_t)4 * 6 * D, ADA + (size_t)4 * 6 * D + D, U + (size_t)row * D, lane);
    }
}
__device__ __forceinline__ void postproj_phase(const Args& A, int vcu, int G) {
    const int tid = tid_opaque(), lane = tid & 63, gw = vcu * NWAVES + __builtin_amdgcn_readfirstlane(tid >> 6), NGW = G * NWAVES;
    bf16* P = (bf16*)(kws() + WS_P); bf16* CK = (bf16*)(kws() + WS_CKVN); bf16* KPE = (bf16*)(kws() + WS_KPE); const float* kvn = kin(I_KVNORM);
    const int fi = lane & 31;
    const float inv = exp2f(-(float)(fi & 15) * (13.287712379549449f / 16.f));
    for (int row = gw; row < MALL; row += NGW) {
        bf16* pr = P + (size_t)row * IN_AB_PAD;
        { const u32x4 w = *(const u32x4*)(pr + OFF_CKV + 8 * lane); float x[8] = {bflo(w.x), bfhi(w.x), bflo(w.y), bfhi(w.y), bflo(w.z), bfhi(w.z), bflo(w.w), bfhi(w.w)};
          float ss = 0.f;
#pragma unroll
          for (int i = 0; i < 8; ++i) ss += x[i] * x[i];
          const float rstd = 1.f / sqrtf(wave_sum(ss) * (1.f / KVR) + LN_EPS);
          const f32x4 g0 = *(const f32x4*)(kvn + 8 * lane), g1 = *(const f32x4*)(kvn + 8 * lane + 4);
          u32x4 o; o.x = pk2(x[0] * rstd * g0[0], x[1] * rstd * g0[1]); o.y = pk2(x[2] * rstd * g0[2], x[3] * rstd * g0[3]);
          o.z = pk2(x[4] * rstd * g1[0], x[5] * rstd * g1[1]); o.w = pk2(x[6] * rstd * g1[2], x[7] * rstd * g1[3]);
          *(u32x4*)(CK + (size_t)row * KVR + 8 * lane) = o; }
        if (row < MLAT) {
            const int t = row & 2047; const float pos = (float)(fi < 16 ? (t >> 6) : (t & 63)); float sn, cs; sincosf(pos * inv, &sn, &cs);
            if (lane < 32) { const float t1 = bf2f(pr[OFF_KPE + fi]), t2 = bf2f(pr[OFF_KPE + 32 + fi]);
                KPE[(size_t)row * 64 + fi] = (bf16)f2bf(t1 * cs - t2 * sn); KPE[(size_t)row * 64 + 32 + fi] = (bf16)f2bf(t2 * cs + t1 * sn); }
#pragma unroll
            for (int q = 0; q < 4; ++q) { const int h = 2 * q + (lane >> 5); bf16* qp = pr + h * 192 + 128;
                const float t1 = bf2f(qp[fi]), t2 = bf2f(qp[32 + fi]); qp[fi] = (bf16)f2bf(t1 * cs - t2 * sn); qp[32 + fi] = (bf16)f2bf(t2 * cs + t1 * sn); }
        } else KPE[(size_t)row * 64 + lane] = pr[OFF_KPE + lane];
    }
}
__device__ __forceinline__ void ln1_phase(LAS unsigned char* lds, int l, int vcu, int G) {
    const int tid = tid_opaque(), lane = tid & 63, gw = vcu * NWAVES + __builtin_amdgcn_readfirstlane(tid >> 6), NGW = G * NWAVES;
    LAS float* rt = (LAS float*)lds;
    { const float* router = kin(I_ROUTER) + (size_t)l * D * NE;
      for (int i = tid; i < D * NE / 4; i += NTHR) { const f32x4 v = *(const f32x4*)(router + 4 * i); const int c = i >> 2, e0 = (i & 3) * 4;
          rt[(e0 + 0) * D + c] = v[0]; rt[(e0 + 1) * D + c] = v[1]; rt[(e0 + 2) * D + c] = v[2]; rt[(e0 + 3) * D + c] = v[3]; } }
    __syncthreads();
    const float* PRE = (const float*)(kws() + WS_PRE); float* H1 = (float*)(kws() + WS_H1); bf16* U2 = (bf16*)(kws() + WS_U2); float* AFF = (float*)(kws() + WS_AFF);
    const float* g = kin(I_LN1G) + l * D; const float* bb = kin(I_LN1B) + l * D;
    for (int row = gw; row < MLAT; row += NGW) {
        const int b = row >> 11, t = row & 2047;
        const float* ada = (const float*)(kws() + WS_ADA) + (size_t)(l * 5 + b) * 6 * D;
        f32x4 v[8]; float s = 0.f;
#pragma unroll
        for (int j = 0; j < 8; ++j) { v[j] = *(const f32x4*)(PRE + (size_t)row * D + 4 * lane + 256 * j); s += (v[j][0] + v[j][1]) + (v[j][2] + v[j][3]); }
        const float mean = wave_sum(s) * (1.f / D); float q = 0.f;
#pragma unroll
        for (int j = 0; j < 8; ++j) { v[j] = v[j] - mean; q += (v[j][0] * v[j][0] + v[j][1] * v[j][1]) + (v[j][2] * v[j][2] + v[j][3] * v[j][3]); }
        const float rstd = 1.f / sqrtf(wave_sum(q) * (1.f / D) + LN_EPS);
#pragma unroll
        for (int j = 0; j < 8; ++j) { const int c = 4 * lane + 256 * j;
            const f32x4 hv = v[j] * rstd * *(const f32x4*)(g + c) + *(const f32x4*)(bb + c);
            *(f32x4*)(H1 + (size_t)row * D + c) = hv;
            const f32x4 u = hv * (*(const f32x4*)(ada + 4 * D + c) + 1.f) + *(const f32x4*)(ada + 3 * D + c);
            u32x2 w; w.x = pk2(u[0], u[1]); w.y = pk2(u[2], u[3]); *(u32x2*)(U2 + (size_t)row * D + c) = w;
            v[j] = u; }
        float mine = 0.f;
#pragma unroll 2
        for (int e = 0; e < NE; ++e) { float a = 0.f;
#pragma unroll
            for (int j = 0; j < 8; ++j) { const f32x4 r4 = *(const LAS f32x4*)(rt + e * D + 4 * lane + 256 * j); a += (v[j][0] * r4[0] + v[j][1] * r4[1]) + (v[j][2] * r4[2] + v[j][3] * r4[3]); }
            a = wave_sum(a); mine = lane == e ? a : mine; }
        float mx = mine;
#pragma unroll
        for (int o = 1; o < 16; o <<= 1) mx = fmaxf(mx, __shfl_xor(mx, o));
        mine = expf(mine - mx); float den = mine;
#pragma unroll
        for (int o = 1; o < 16; o <<= 1) den += __shfl_xor(den, o);
        if (lane < NE) AFF[(size_t)(b * NE + lane) * SEQ + t] = mine / den;
    }
}
__device__ __forceinline__ void topk_phase(LAS unsigned char* lds, const Args& A, int vcu, int G) {
    const int tid = tid_opaque(), wave = __builtin_amdgcn_readfirstlane(tid >> 6), lane = tid & 63;
    LAS unsigned long long* keys = (LAS unsigned long long*)lds;
    const float* AFF = (const float*)(kws() + WS_AFF); int* IDX = (int*)(kws() + WS_IDX); float* GATE = (float*)(kws() + WS_GATE); int* INV = (int*)(kws() + WS_INV);
    const bf16* U2 = (const bf16*)(kws() + WS_U2); bf16* XE = (bf16*)(kws() + WS_XE);
    for (int unit = vcu; unit < NRT; unit += G) {
        const int e = unit >> 2, b = unit & 3;
        for (int i = tid; i < SEQ; i += NTHR) keys[i] = ((unsigned long long)__builtin_bit_cast(unsigned, AFF[(size_t)(b * NE + e) * SEQ + i]) << 32) | (unsigned)(2047 - i);
        __syncthreads();
        for (int k = 2; k <= SEQ; k <<= 1)
            for (int j = k >> 1; j > 0; j >>= 1) {
                for (int i = tid; i < SEQ; i += NTHR) { const int x = i ^ j; if (x > i) { const unsigned long long a = keys[i], c = keys[x]; const bool asc = (i & k) == 0;
                    if ((a > c) == asc) { keys[i] = c; keys[x] = a; } } }
                __syncthreads(); }
        for (int p = tid; p < SEQ; p += NTHR) { const unsigned long long kk = keys[p]; const int idx = 2047 - (int)(unsigned)(kk & 0xffffffffu), slot = 2047 - p;
            INV[(size_t)(b * SEQ + idx) * NE + e] = slot < CAP ? slot : -1;
            if (slot < CAP) { IDX[unit * CAP + slot] = idx; GATE[unit * CAP + slot] = __builtin_bit_cast(float, (unsigned)(kk >> 32)); } }
        for (int s = wave * 32; s < wave * 32 + 32; ++s) { const int idx = 2047 - (int)(unsigned)(keys[2047 - s] & 0xffffffffu);
            const u32x4* src = (const u32x4*)(U2 + (size_t)(b * SEQ + idx) * D); u32x4* dst = (u32x4*)(XE + (size_t)(unit * CAP + s) * D);
#pragma unroll
            for (int j = 0; j < 4; ++j) dst[lane + 64 * j] = src[lane + 64 * j]; }
        __syncthreads();
    }
}
__device__ __forceinline__ void ln2_phase(const Args& A, int l, int vcu, int G) {
    const int tid = tid_opaque(), lane = tid & 63, gw = vcu * NWAVES + __builtin_amdgcn_readfirstlane(tid >> 6), NGW = G * NWAVES;
    const float* H1 = (const float*)(kws() + WS_H1); const bf16* YE = (const bf16*)(kws() + WS_YE); const int* INV = (const int*)(kws() + WS_INV);
    float* out = l == 0 ? (float*)(kws() + WS_H2) : kout(); bf16* U = (bf16*)(kws() + WS_UALL);
    const float* g = kin(I_LN2G) + l * D; const float* bb = kin(I_LN2B) + l * D;
    for (int row = gw; row < MLAT; row += NGW) {
        const int b = row >> 11;
        const float* ada = (const float*)(kws() + WS_ADA) + (size_t)(l * 5 + b) * 6 * D;
        f32x4 m[8];
#pragma unroll
        for (int j = 0; j < 8; ++j) m[j] = (f32x4){0.f, 0.f, 0.f, 0.f};
        for (int e = 0; e < NE; ++e) { const int slot = __builtin_amdgcn_readfirstlane(INV[(size_t)row * NE + e]);
            if (slot >= 0) { const bf16* yr = YE + (size_t)((e * 4 + b) * CAP + slot) * D;
#pragma unroll
                for (int j = 0; j < 8; ++j) { const u32x2 w = *(const u32x2*)(yr + 4 * lane + 256 * j); m[j][0] += bflo(w.x); m[j][1] += bfhi(w.x); m[j][2] += bflo(w.y); m[j][3] += bfhi(w.y); } } }
        f32x4 v[8]; float s = 0.f;
#pragma unroll
        for (int j = 0; j < 8; ++j) { const int c = 4 * lane + 256 * j; v[j] = *(const f32x4*)(H1 + (size_t)row * D + c) * DN_ALPHA + *(const f32x4*)(ada + 5 * D + c) * m[j]; s += (v[j][0] + v[j][1]) + (v[j][2] + v[j][3]); }
        const float mean = wave_sum(s) * (1.f / D); float q = 0.f;
#pragma unroll
        for (int j = 0; j < 8; ++j) { v[j] = v[j] - mean; q += (v[j][0] * v[j][0] + v[j][1] * v[j][1]) + (v[j][2] * v[j][2] + v[j][3] * v[j][3]); }
        const float rstd = 1.f / sqrtf(wave_sum(q) * (1.f / D) + LN_EPS);
        const float* ada1 = (const float*)(kws() + WS_ADA) + (size_t)(5 + b) * 6 * D;
#pragma unroll
        for (int j = 0; j < 8; ++j) { const int c = 4 * lane + 256 * j;
            const f32x4 hv = v[j] * rstd * *(const f32x4*)(g + c) + *(const f32x4*)(bb + c);
            *(f32x4*)(out + (size_t)row * D + c) = hv;
            if (l == 0) { const f32x4 u = hv * (*(const f32x4*)(ada1 + D + c) + 1.f) + *(const f32x4*)(ada1 + c); u32x2 w; w.x = pk2(u[0], u[1]); w.y = pk2(u[2], u[3]); *(u32x2*)(U + (size_t)row * D + c) = w; } }
    }
}

__global__ void __launch_bounds__(NTHR, 2) mk_fwd(Args A) {
    extern __shared__ __attribute__((aligned(16))) unsigned char lds_raw[];
    LAS unsigned char* lds = (LAS unsigned char*)lds_raw;
    volatile LAS unsigned* MISC = (volatile LAS unsigned*)(lds + LDS_MISC);
    const int G = gridDim.x; const int bx = blockIdx.x; const int vcu = (G % 8 == 0) ? (bx % 8) * (G / 8) + bx / 8 : bx;
    if (threadIdx.x < 16) MISC[threadIdx.x] = 0u;
    __syncthreads();
#if MK_LAUNCH_PER_PHASE
#define GRID_BAR() do { } while (0)
#else
    XcdBarrier bar = xcd_barrier_post((unsigned*)(kws() + WS_CTL) + 4096, MISC + 8);
#define GRID_BAR() xcd_barrier(bar)
#endif
    const int lo = A.ph_lo, hi = A.ph_hi;
#ifndef PH_MASK
#define PH_MASK 0xFFFFFFFFu
#endif
#define IN(k) ((((PH_MASK) >> (k)) & 1u) && lo <= (k) && (k) < hi)
#define SEAM(k) do { if ((k) + 1 < hi) GRID_BAR(); } while (0)

    #ifndef PX_PARTS
#define PX_PARTS 3
#endif
#ifndef P0_PARTS
#define P0_PARTS 7
#endif
    if (IN(0)) { if (P0_PARTS & 1) ada_phase(lds, A, vcu, G); if (P0_PARTS & 2) filt_phase(lds, A, vcu, G); if (P0_PARTS & 4) convert_phase(lds, A, vcu, G); SEAM(0); }

    {

            if (IN(1)) { modulate_phase(A, vcu, G); SEAM(1); }
            if (IN(2)) { ProbPlain P{2048, 2048, 2048, 36 * 21, (const bf16*)(kws() + WS_UALL), (const bf16*)(kws() + WS_WAB), (bf16*)(kws() + WS_P), IN_AB_PAD, 36, 21};
                pg8::gemm_phase(lds, P, vcu, G); SEAM(2); }
            if (IN(3)) { postproj_phase(A, vcu, G); SEAM(3); }
            if (IN(4)) { ProbPlain P{512, 512, 512, 36 * 8, (const bf16*)(kws() + WS_CKVN), (const bf16*)(kws() + WS_WUKV), (bf16*)(kws() + WS_KV), D, 36, 8};
                pg8::gemm_phase(lds, P, vcu, G); SEAM(4); }
            if (IN(5)) { const att::Tensors T{(const bf16*)(kws() + WS_P), (const bf16*)(kws() + WS_KV), (const bf16*)(kws() + WS_KPE), kin(I_RPB), (bf16*)(kws() + WS_CAT)};
                for (int u = vcu; u < 256; u += G) att::attn_unit<0>(lds, T, u);
                for (int u = vcu; u < 256; u += G) att::attn_unit<1>(lds, T, u);
                SEAM(5); }
    }
#define COMMON_PHASES(l, cb) \
        if (IN(cb)) { ProbOut P{2048, 2048, 2048, 256, (const bf16*)(kws() + WS_CAT), (const bf16*)(kws() + (l == 0 ? WS_WABO : WS_WCDO)), l == 0 ? kin(I_X) : (const float*)(kws() + WS_H2), \
                               (const float*)(kws() + WS_ADA) + (size_t)l * 5 * 6 * D + 2 * D, (float*)(kws() + WS_PRE)}; \
            pg8::gemm_phase(lds, P, vcu, G); SEAM(cb); } \
        if (IN(cb + 1)) { ln1_phase(lds, l, vcu, G); SEAM(cb + 1); } \
        if (IN(cb + 2)) { topk_phase(lds, A, vcu, G); SEAM(cb + 2); } \
        if (IN(cb + 3)) { ProbMoe1 P{2048, 2048, 2048, 704, (const bf16*)(kws() + WS_XE), (const bf16*)(kws() + WS_W13) + (size_t)l * 16 * (2 * FF * D), (bf16*)(kws() + WS_HDN)}; \
            pg8::gemm_phase(lds, P, vcu, G); SEAM(cb + 3); } \
        if (IN(cb + 4)) { ProbMoe2 P{FF, FF, FF, 512, (const bf16*)(kws() + WS_HDN), (const bf16*)(kws() + WS_W2) + (size_t)l * 16 * (D * FF), (const float*)(kws() + WS_GATE), (bf16*)(kws() + WS_YE)}; \
            pg8::gemm_phase(lds, P, vcu, G); SEAM(cb + 4); } \
        if (IN(cb + 5)) { ln2_phase(A, l, vcu, G); SEAM(cb + 5); }
    COMMON_PHASES(0, 6)
    {

            if (IN(12)) { ProbPlain P{2048, 2048, 2048, 32 * 16, (const bf16*)(kws() + WS_UALL), (const bf16*)(kws() + WS_WCD), (bf16*)(kws() + WS_P), IN_CD, 32, 16};
                pg8::gemm_phase(lds, P, vcu, G); SEAM(12); }
            if (IN(13)) {
                if (PX_PARTS & 1) { const int tid = tid_opaque(), lane = tid & 63, wave = __builtin_amdgcn_readfirstlane(tid >> 6);
                    for (int it = vcu * NWAVES + wave; it < NB * 32 * 48; it += G * NWAVES) prep_item(lds + wave * 9600, (const bf16*)(kws() + WS_P), kin(I_CONVW), kin(I_CONVB), (bf16*)(kws() + WS_ST), it, lane); }
                __syncthreads();
                ProbF1 P{256, 256, IN_CD, 256, (const bf16*)(kws() + WS_CS256), (const bf16*)(kws() + WS_P), (bf16*)(kws() + WS_T1)};
                if (PX_PARTS & 2) pg8::gemm_phase(lds, P, vcu, G); SEAM(13); }
            if (IN(14)) {
                if ((PX_PARTS & 1) && vcu < 128) { ProbF2 P{4096, 4096, 4096, 128, (const bf16*)(kws() + WS_CSL), (const bf16*)(kws() + WS_T1), (bf16*)(kws() + WS_CAT)}; pg8::gemm_phase(lds, P, vcu, 128); }
                { const int hs = G > 128 ? G - 128 : G, h0 = G > 128 ? vcu - 128 : vcu;
                  if ((PX_PARTS & 2) && h0 >= 0) for (int u = h0; u < 256; u += hs) hy::hyena_unit(lds, (const bf16*)(kws() + WS_ST), (const bf16*)(kws() + WS_HR), kin(I_SKIP), (bf16*)(kws() + WS_CAT), u); }
                SEAM(14); }
    }
    COMMON_PHASES(1, 15)
#undef COMMON_PHASES
#undef IN
#undef SEAM
}

extern "C" void kernel_launch(void* const* d_in, const int* in_sizes, int n_in, void* d_out, int out_size, void* d_ws, size_t ws_size, hipStream_t stream) {
    static int grid = 0;
    if (grid == 0) {
        if (n_in != 31 || out_size != MLAT * D || ws_size < WS_END) { fprintf(stderr, "kernel_launch: unexpected shapes (n_in %d, out %d, ws %zu < %zu)\n", n_in, out_size, ws_size, (size_t)WS_END); grid = -1; return; }
        int dev = 0, cus = 0, per_cu = 0;
        if (hipGetDevice(&dev) != hipSuccess || hipDeviceGetAttribute(&cus, hipDeviceAttributeMultiprocessorCount, dev) != hipSuccess) { grid = -1; return; }
        if (hipFuncSetAttribute((const void*)mk_fwd, hipFuncAttributeMaxDynamicSharedMemorySize, LDS_BYTES) != hipSuccess) { fprintf(stderr, "kernel_launch: hipFuncSetAttribute failed\n"); grid = -1; return; }
        if (hipOccupancyMaxActiveBlocksPerMultiprocessor(&per_cu, (const void*)mk_fwd, NTHR, LDS_BYTES) != hipSuccess || per_cu < 1) { fprintf(stderr, "kernel_launch: occupancy query says %d\n", per_cu); }
        (void)hipGetLastError();
        grid = cus;
    }
    if (grid < 0) return;
    (void)hipMemsetAsync((char*)d_ws + WS_CTL, 0, CTL_ZERO_BYTES, stream);
    Args a{};
    for (int i = 0; i < 31; ++i) a.in[i] = (const float*)d_in[i];
    a.out = (float*)d_out; a.ws = (unsigned char*)d_ws;
#if MK_LAUNCH_PER_PHASE
    for (int ph = 0; ph < NPHASE; ++ph) { a.ph_lo = ph; a.ph_hi = ph + 1; hipLaunchKernelGGL(mk_fwd, dim3(grid), dim3(NTHR), LDS_BYTES, stream, a); }
#else
    a.ph_lo = 0; a.ph_hi = NPHASE;
    hipLaunchKernelGGL(mk_fwd, dim3(grid), dim3(NTHR), LDS_BYTES, stream, a);
#endif
}
```

```cpp
#include <hip/hip_runtime.h>
#include <cstdio>
#include <cstdint>

#ifndef MK_LAUNCH_PER_PHASE
#define MK_LAUNCH_PER_PHASE 0
#endif

#define GAS __attribute__((address_space(1)))
#define LAS __attribute__((address_space(3)))
typedef unsigned short bf16;
typedef short bf16x8 __attribute__((ext_vector_type(8)));
typedef short s16x4 __attribute__((ext_vector_type(4)));
typedef float f32x4 __attribute__((ext_vector_type(4)));
typedef float f32x2 __attribute__((ext_vector_type(2)));
typedef float f32x16 __attribute__((ext_vector_type(16)));
typedef unsigned u32x4 __attribute__((ext_vector_type(4)));
typedef unsigned u32x2 __attribute__((ext_vector_type(2)));
#define RLX_AGENT __ATOMIC_RELAXED, __HIP_MEMORY_SCOPE_AGENT
#define LDS_WAIT() asm volatile("s_waitcnt lgkmcnt(0)" ::: "memory")
#define VM_WAIT() asm volatile("s_waitcnt vmcnt(0)" ::: "memory")

constexpr int D = 2048, NB = 4, SEQ = 2048, LC = 256, GW = 64;
constexpr int MLAT = NB * SEQ, MCTX = NB * LC, MALL = MLAT + MCTX;
constexpr int IN_AB = 5184, IN_AB_PAD = 5376;
constexpr int OFF_CKV = 1536, OFF_KPE = 2048, OFF_QNA = 2112, OFF_KNA = 3136, OFF_VNA = 4160;
constexpr int KVR = 512, NH = 8;
constexpr int FF = 1408, NE = 16, CAP = 256, NRT = NE * NB;
constexpr int IN_CD = 4096, HYW = 1024, HY3 = 3072;
constexpr float LN_EPS = 1e-6f;
constexpr float DN_ALPHA = 1.41421356237f;
constexpr int NWAVES = 8, NTHR = 512;

constexpr size_t MiB = 1u << 20;
constexpr size_t WS_CTL = 0, CTL_ZERO_BYTES = 1 * MiB;
constexpr size_t WS_ADA = 1 * MiB;
constexpr size_t WS_AFF = 2 * MiB;
constexpr size_t WS_IDX = 3 * MiB;
constexpr size_t WS_GATE = WS_IDX + 64 * 1024;
constexpr size_t WS_INV = 4 * MiB;
constexpr size_t WS_CS256 = 5 * MiB;
constexpr size_t WS_DBG = 6 * MiB;
constexpr size_t WS_WAB = 8 * MiB;
constexpr size_t WS_WUKV = 30 * MiB;
constexpr size_t WS_WABO = 32 * MiB;
constexpr size_t WS_WCD = 40 * MiB;
constexpr size_t WS_WCDO = 56 * MiB;
constexpr size_t WS_CSL = 64 * MiB;
constexpr size_t WS_HR = 80 * MiB;
constexpr size_t W13_E = (size_t)2 * FF * D * 2;
constexpr size_t W2_E = (size_t)D * FF * 2;
constexpr size_t WS_W13 = 96 * MiB;
constexpr size_t WS_W2 = WS_W13 + 32 * W13_E;
constexpr size_t WS_UALL = WS_W2 + 32 * W2_E;
constexpr size_t WS_P = WS_UALL + (size_t)MALL * D * 2;
constexpr size_t WS_CKVN = WS_P + (size_t)MALL * IN_AB_PAD * 2;
constexpr size_t WS_KPE = WS_CKVN + (size_t)MALL * KVR * 2;
constexpr size_t WS_KV = WS_KPE + (size_t)MALL * 64 * 2;
constexpr size_t WS_ST = WS_KV;
constexpr size_t WS_CAT = WS_KV + (size_t)NB * HY3 * SEQ * 2;
constexpr size_t WS_PRE = WS_CAT + (size_t)MLAT * D * 2;
constexpr size_t WS_H1 = WS_PRE + (size_t)MLAT * D * 4;
constexpr size_t WS_H2 = WS_H1 + (size_t)MLAT * D * 4;
constexpr size_t WS_U2 = WS_H2 + (size_t)MLAT * D * 4;
constexpr size_t WS_XE = WS_U2 + (size_t)MLAT * D * 2;
constexpr size_t WS_HDN = WS_XE + (size_t)NRT * CAP * D * 2;
constexpr size_t WS_YE = WS_HDN + (size_t)NRT * CAP * FF * 2;
constexpr size_t WS_T1 = WS_YE + (size_t)NRT * CAP * D * 2;
constexpr size_t WS_END = WS_T1 + (size_t)16 * 256 * 2 * 2048 * 2;
static_assert(WS_WAB + (size_t)IN_AB_PAD * D * 2 <= WS_WUKV && WS_HR + (size_t)2 * 1024 * 4096 * 2 <= WS_W13, "ws map");
static_assert(WS_END < (size_t)1400 * MiB, "ws map too large");

constexpr int LDS_MAIN = 151552;
constexpr int LDS_MISC = LDS_MAIN;
constexpr int LDS_BYTES = LDS_MAIN + 64;

__device__ __forceinline__ unsigned f2bf(float f) { unsigned u = __builtin_bit_cast(unsigned, f); return (u + 0x7fffu + ((u >> 16) & 1u)) >> 16; }
__device__ __forceinline__ unsigned pk2(float lo, float hi) { return f2bf(lo) | (f2bf(hi) << 16); }
__device__ __forceinline__ float bf2f(unsigned b) { return __builtin_bit_cast(float, b << 16); }
__device__ __forceinline__ float bflo(unsigned w) { return __builtin_bit_cast(float, w << 16); }
__device__ __forceinline__ float bfhi(unsigned w) { return __builtin_bit_cast(float, w & 0xffff0000u); }
__device__ __forceinline__ unsigned cvt_pk_bf16(float lo, float hi) { unsigned r; asm volatile("v_cvt_pk_bf16_f32 %0, %1, %2" : "=v"(r) : "v"(lo), "v"(hi)); return r; }
__device__ __forceinline__ float wave_sum(float v) {
#pragma unroll
    for (int o = 1; o < 64; o <<= 1) v += __shfl_xor(v, o);
    return v;
}
__device__ __forceinline__ int tid_opaque() { int t = threadIdx.x; asm volatile("" : "+v"(t)); return t; }
__device__ __forceinline__ float silu_f(float x) { return x / (1.f + __expf(-x)); }

#define XB_TMO      128
#define XB_XCNT(j)  (256  + 64 * (j))
#define XB_XSUB(j)  (1280 + 64 * (j))
#define XB_XGEN(j)  (2304 + 64 * (j))
#define XB_TOP      3328
#define XB_TOPGEN   3392
#define XCD_BAR_WORDS 3456
#define XB_SPIN_CAP (1u << 18)
__device__ __forceinline__ unsigned xb_ld(unsigned* p)              { return __hip_atomic_load(p, __ATOMIC_RELAXED, __HIP_MEMORY_SCOPE_AGENT); }
__device__ __forceinline__ unsigned xb_add(unsigned* p, unsigned v) { return __hip_atomic_fetch_add(p, v, __ATOMIC_RELAXED, __HIP_MEMORY_SCOPE_AGENT); }
__device__ __forceinline__ unsigned xb_xcc_id() { return (unsigned)__builtin_amdgcn_s_getreg((3 << 11) | 20) & 0xFu; }
#define XB_SPIN(cond, bar) do { unsigned _sp = 0; while (cond) { __builtin_amdgcn_s_sleep(1); \
    if ((++_sp & 255u) == 0u) { if (xb_ld(&(bar)[XB_TMO])) break; if (_sp > XB_SPIN_CAP) { atomicAdd(&(bar)[XB_TMO], 1u); break; } } } } while (0)
struct XcdBarrier { unsigned* bar; unsigned x; volatile LAS unsigned* st; };
__device__ __forceinline__ XcdBarrier xcd_barrier_post(unsigned* bar, volatile LAS unsigned* st) {
    XcdBarrier b; b.bar = bar; b.x = xb_xcc_id(); b.st = st;
    if (threadIdx.x == 0) (void)xb_add(&bar[XB_XCNT(b.x)], 1u);
    return b;
}
__device__ __forceinline__ void xcd_barrier_complete(unsigned* bar, unsigned x, unsigned& nloc, unsigned& nx) {
    const unsigned G = gridDim.x * gridDim.y * gridDim.z;
    unsigned sum, cnt, mine, sp = 0u;
    for (;;) {
        sum = 0u; cnt = 0u; mine = 0u;
#pragma unroll
        for (unsigned j = 0; j < 16; ++j) { const unsigned c = xb_ld(&bar[XB_XCNT(j)]); sum += c; cnt += (c > 0u) ? 1u : 0u; mine = (j == x) ? c : mine; }
        if (sum == G) break;
        __builtin_amdgcn_s_sleep(1);
        if ((++sp & 255u) == 0u) { if (xb_ld(&bar[XB_TMO])) break; if (sp > XB_SPIN_CAP) { atomicAdd(&bar[XB_TMO], 1u); break; } }
    }
    nloc = mine > 0u ? mine : 1u; nx = cnt > 0u ? cnt : 1u;
}
__device__ __forceinline__ void xcd_barrier(const XcdBarrier& b) {
    asm volatile("s_waitcnt vmcnt(0)" ::: "memory");
    __syncthreads();
    if (threadIdx.x == 0) {
        unsigned* bar = b.bar;
        __builtin_amdgcn_s_waitcnt(0);
        unsigned nloc = b.st[0], nx = b.st[1];
        if (nloc == 0u) { xcd_barrier_complete(bar, b.x, nloc, nx); b.st[0] = nloc; b.st[1] = nx; }
        const unsigned old = xb_add(&bar[XB_XSUB(b.x)], 1u);
        const unsigned gen = old / nloc;
        if (old + 1u == (gen + 1u) * nloc) {
            __builtin_amdgcn_fence(__ATOMIC_RELEASE, "agent");
            asm volatile("s_waitcnt vmcnt(0)" ::: "memory");
            const unsigned og = xb_add(&bar[XB_TOP], 1u);
            const unsigned tg = og / nx;
            if (og + 1u == (tg + 1u) * nx) xb_add(&bar[XB_TOPGEN], 1u);
            else XB_SPIN(xb_ld(&bar[XB_TOPGEN]) == tg, bar);
            __builtin_amdgcn_fence(__ATOMIC_ACQUIRE, "agent");
            xb_add(&bar[XB_XGEN(b.x)], 1u);
            asm volatile("s_waitcnt vmcnt(0)" ::: "memory");
        } else {
            XB_SPIN(xb_ld(&bar[XB_XGEN(b.x)]) == gen, bar);
            __builtin_amdgcn_fence(__ATOMIC_ACQUIRE, "agent");
            asm volatile("s_waitcnt vmcnt(0)" ::: "memory");
        }
    }
    __syncthreads();
}

namespace pg8 {
constexpr int BM = 256, BK = 64, HALF = 128, HTB = HALF * BK * 2, STAGE_BYTES = 8 * HTB;
__host__ __device__ __forceinline__ int lds_byte(int r, int c) { const int st = (r >> 4) * 2 + (c >> 5), rr = r & 15, cc = c & 31, ob = rr * 64 + cc * 2; return st * 1024 + (ob ^ (((ob >> 9) & 1) << 5)); }
__host__ __device__ __forceinline__ void stage_rc(int b, int& R, int& C) { const int st = b / 1024, sb = b % 1024, swz = sb ^ (((sb >> 9) & 1) << 5); R = (st >> 1) * 16 + swz / 64; C = (st & 1) * 32 + (swz % 64) / 2; }
__host__ __device__ __forceinline__ int perm32(int rho) { const int n = rho >> 4, i = rho & 15; return 8 * (i >> 2) + 4 * n + (i & 3); }

template <class Prob>
__device__ __forceinline__ void gemm_phase(LAS unsigned char* lds, const Prob& P, int u0, int ustride) {
    const int tid = tid_opaque(), wid = __builtin_amdgcn_readfirstlane(tid >> 6), lane = tid & 63, wr = wid >> 2, wc = wid & 3, fr = lane & 15, fq = lane >> 4;
    const int K = P.K, nt = K / BK;
    unsigned voffA[2], voffB[2];
#pragma unroll
    for (int i = 0; i < 2; ++i) { int R, C; stage_rc(tid * 16 + i * 8192, R, C); const int Rb = Prob::PERM ? ((R & ~31) + perm32(R & 31)) : R;
        voffA[i] = (unsigned)(R * P.lda + C) * 2u; voffB[i] = (unsigned)(Rb * P.ldb + C) * 2u; }
    const size_t kstep = (size_t)(BK * 2);
    const size_t hstepA = Prob::GATHER ? (size_t)0 : (size_t)HALF * P.lda * 2, hstepB = (size_t)HALF * P.ldb * 2;
    unsigned gvoC[2][2], gvoN[2][2];
    const unsigned ldsw = (unsigned)wid * 1024u;
    const int aoff = lds_byte(wr * 64 + fr, fq * 8), boff = lds_byte(wc * 32 + fr, fq * 8);
#define PG8_SA(b, h) (((b) * 2 + (h)) * HTB)
#define PG8_SB(b, h) ((4 + (b) * 2 + (h)) * HTB)
#define PG8_STAGE(bufoff, gbase, voff) do { _Pragma("unroll") for (int _i = 0; _i < 2; ++_i) \
        __builtin_amdgcn_global_load_lds((const unsigned*)((const char*)(gbase) + (voff)[_i]), (LAS unsigned*)(lds + (bufoff) + ldsw + _i * 8192), 16, 0, 0); } while (0)
#define PG8_STAGEA(bufoff, gbase, h, NX) do { if constexpr (Prob::GATHER) { if (NX) PG8_STAGE(bufoff, gbase, gvoN[h]); else PG8_STAGE(bufoff, gbase, gvoC[h]); } else PG8_STAGE(bufoff, (gbase) + (h) * hstepA, voffA); } while (0)
#define PG8_LDA(dst, b, h) do { _Pragma("unroll") for (int m = 0; m < 4; ++m) _Pragma("unroll") for (int k = 0; k < 2; ++k) dst[m][k] = *(const LAS bf16x8*)(lds + PG8_SA(b, h) + aoff + m * 2048 + k * 1024); } while (0)
#define PG8_LDB(dst, b, h) do { _Pragma("unroll") for (int n = 0; n < 2; ++n) _Pragma("unroll") for (int k = 0; k < 2; ++k) dst[n][k] = *(const LAS bf16x8*)(lds + PG8_SB(b, h) + boff + n * 2048 + k * 1024); } while (0)
#define PG8_MMA(ai, bj, At, Bt) do { __builtin_amdgcn_s_setprio(1); _Pragma("unroll") for (int m = 0; m < 4; ++m) _Pragma("unroll") for (int n = 0; n < 2; ++n) _Pragma("unroll") for (int k = 0; k < 2; ++k) \
        acc[ai][bj][m][n] = __builtin_amdgcn_mfma_f32_16x16x32_bf16(Bt[n][k], At[m][k], acc[ai][bj][m][n], 0, 0, 0); __builtin_amdgcn_s_setprio(0); } while (0)
#define PG8_WAIT_V(n) asm volatile("s_waitcnt vmcnt(" #n ")" ::: "memory")
#define PG8_WAIT_L(n) asm volatile("s_waitcnt lgkmcnt(" #n ")" ::: "memory")
#define PG8_BAR __builtin_amdgcn_s_barrier()
#define PG8_SCHED __builtin_amdgcn_sched_barrier(0)
    int u = u0;
    if (u >= P.nunits) return;
    f32x4 acc[2][2][4][2];
#pragma unroll
    for (int a = 0; a < 2; ++a)
#pragma unroll
        for (int b = 0; b < 2; ++b)
#pragma unroll
            for (int m = 0; m < 4; ++m)
#pragma unroll
                for (int n = 0; n < 2; ++n) acc[a][b][m][n] = (f32x4){0.f, 0.f, 0.f, 0.f};
    bf16x8 At[4][2], B0[2][2], B1[2][2];
    const char* cA; const char* cB; P.locate(u, cA, cB);
    if constexpr (Prob::GATHER) { P.aoffs(u, tid, gvoC);
#pragma unroll
        for (int h = 0; h < 2; ++h)
#pragma unroll
            for (int i = 0; i < 2; ++i) gvoN[h][i] = gvoC[h][i]; }
    PG8_STAGE(PG8_SB(0, 0), cB, voffB); PG8_STAGE(PG8_SB(0, 1), cB + hstepB, voffB); PG8_STAGEA(PG8_SA(0, 0), cA, 0, false); PG8_STAGEA(PG8_SA(0, 1), cA, 1, false);
    if (wr == 1) PG8_BAR;
    PG8_WAIT_V(2); PG8_BAR;
    PG8_STAGE(PG8_SB(1, 0), cB + kstep, voffB); PG8_STAGEA(PG8_SA(1, 0), cA + kstep, 0, false); PG8_STAGE(PG8_SB(1, 1), cB + hstepB + kstep, voffB);
    PG8_WAIT_V(6); PG8_BAR;
    for (;;) {
        const int un = u + ustride; const bool has_next = un < P.nunits;
        const char* nA = cA; const char* nB = cB; if (has_next) P.locate(un, nA, nB);
        if constexpr (Prob::GATHER) { if (has_next) P.aoffs(un, tid, gvoN); }
        for (int t = 0; t < nt; t += 2) {
            const bool last = (t == nt - 2);
            const char* a1 = cA + (size_t)(t + 1) * kstep;
            const char* a2 = last ? nA : cA + (size_t)(t + 2) * kstep; const char* b2 = last ? nB : cB + (size_t)(t + 2) * kstep;
            const char* a3 = a2 + kstep; const char* b3 = b2 + kstep;
            PG8_LDB(B0, 0, 0); PG8_LDB(B1, 0, 1); PG8_SCHED; PG8_LDA(At, 0, 0); PG8_STAGEA(PG8_SA(1, 1), a1, 1, false);
            PG8_WAIT_V(8); PG8_WAIT_L(0); PG8_BAR; PG8_MMA(0, 0, At, B0); PG8_MMA(0, 1, At, B1); PG8_BAR; PG8_SCHED;
            PG8_LDA(At, 0, 1); PG8_STAGE(PG8_SB(0, 0), b2, voffB); PG8_STAGE(PG8_SB(0, 1), b2 + hstepB, voffB); PG8_STAGEA(PG8_SA(0, 0), a2, 0, last);
            PG8_WAIT_V(8); PG8_WAIT_L(0); PG8_BAR; PG8_MMA(1, 0, At, B0); PG8_MMA(1, 1, At, B1); PG8_BAR; PG8_SCHED;
            PG8_LDB(B0, 1, 0); PG8_LDB(B1, 1, 1); PG8_SCHED; PG8_LDA(At, 1, 0); PG8_STAGEA(PG8_SA(0, 1), a2, 1, last);
            PG8_WAIT_V(8); PG8_WAIT_L(0); PG8_BAR; PG8_MMA(0, 0, At, B0); PG8_MMA(0, 1, At, B1); PG8_BAR; PG8_SCHED;
            PG8_LDA(At, 1, 1); PG8_STAGE(PG8_SB(1, 0), b3, voffB); PG8_STAGE(PG8_SB(1, 1), b3 + hstepB, voffB); PG8_STAGEA(PG8_SA(1, 0), a3, 0, last);
            PG8_WAIT_V(8); PG8_WAIT_L(0); PG8_BAR; PG8_MMA(1, 0, At, B0); PG8_MMA(1, 1, At, B1); PG8_BAR; PG8_SCHED;
        }
        if (wr == 0) PG8_BAR;
        P.epi(acc, u, wr, wc, fr, fq);
        if (!has_next) break;
#pragma unroll
        for (int a = 0; a < 2; ++a)
#pragma unroll
            for (int b = 0; b < 2; ++b)
#pragma unroll
                for (int m = 0; m < 4; ++m)
#pragma unroll
                    for (int n = 0; n < 2; ++n) acc[a][b][m][n] = (f32x4){0.f, 0.f, 0.f, 0.f};
        u = un; cA = nA; cB = nB;
        if constexpr (Prob::GATHER) {
#pragma unroll
            for (int h = 0; h < 2; ++h)
#pragma unroll
                for (int i = 0; i < 2; ++i) gvoC[h][i] = gvoN[h][i]; }
        if (wr == 1) PG8_BAR;
    }
    PG8_WAIT_V(0);
    PG8_BAR;
#undef PG8_SA
#undef PG8_SB
#undef PG8_STAGE
#undef PG8_STAGEA
#undef PG8_LDA
#undef PG8_LDB
#undef PG8_MMA
#undef PG8_WAIT_V
#undef PG8_WAIT_L
#undef PG8_BAR
#undef PG8_SCHED
}
__device__ __forceinline__ void tile_of(int u, int nM, int nN, int& pm, int& pn) {
    const int nig = 8 * nN, g = u / nig, r = u % nig, fm = g * 8, gsz = (nM - fm) < 8 ? (nM - fm) : 8;
    pm = fm + r % gsz; pn = r / gsz;
}
__device__ __forceinline__ void st8(bf16* p, f32x4 v0, f32x4 v1) {
    u32x4 w; w.x = cvt_pk_bf16(v0[0], v0[1]); w.y = cvt_pk_bf16(v0[2], v0[3]); w.z = cvt_pk_bf16(v1[0], v1[1]); w.w = cvt_pk_bf16(v1[2], v1[3]);
    *(u32x4*)p = w;
}
}

typedef __bf16 bf16x2_t __attribute__((ext_vector_type(2)));
__device__ __forceinline__ unsigned cvtpk(float lo, float hi) { f32x2 v = {lo, hi}; bf16x2_t b = __builtin_convertvector(v, bf16x2_t); return __builtin_bit_cast(unsigned, b); }

struct ProbPlain {
    static constexpr bool GATHER = false; static constexpr bool PERM = true;
    int K, lda, ldb, nunits; const bf16* A; const bf16* Bt; bf16* O; int ldc, nM, nN;
    __device__ __forceinline__ void locate(int u, const char*& a, const char*& b) const { int pm, pn; pg8::tile_of(u, nM, nN, pm, pn); a = (const char*)(A + (size_t)pm * 256 * lda); b = (const char*)(Bt + (size_t)pn * 256 * ldb); }
    __device__ __forceinline__ void epi(const f32x4 (&acc)[2][2][4][2], int u, int wr, int wc, int fr, int fq) const {
        int pm, pn; pg8::tile_of(u, nM, nN, pm, pn);
        const int row0 = pm * 256 + wr * 64 + fr, col0 = pn * 256 + wc * 32 + 8 * fq;
#pragma unroll
        for (int ai = 0; ai < 2; ++ai)
#pragma unroll
            for (int m = 0; m < 4; ++m) { bf16* rowp = O + (size_t)(row0 + ai * 128 + m * 16) * ldc + col0;
#pragma unroll
                for (int bj = 0; bj < 2; ++bj) pg8::st8(rowp + bj * 128, acc[ai][bj][m][0], acc[ai][bj][m][1]); }
    }
};
struct ProbOut {
    static constexpr bool GATHER = false; static constexpr bool PERM = false;
    int K, lda, ldb, nunits; const bf16* A; const bf16* Bt; const float* h; const float* gate; float* pre;
    __device__ __forceinline__ void locate(int u, const char*& a, const char*& b) const { int pm, pn; pg8::tile_of(u, 32, 8, pm, pn); a = (const char*)(A + (size_t)pm * 256 * lda); b = (const char*)(Bt + (size_t)pn * 256 * ldb); }
    __device__ __forceinline__ void epi(const f32x4 (&acc)[2][2][4][2], int u, int wr, int wc, int fr, int fq) const {
        int pm, pn; pg8::tile_of(u, 32, 8, pm, pn);
        const int row0 = pm * 256 + wr * 64 + fr, col0 = pn * 256 + wc * 32 + 4 * fq;
        const float* g = gate + (size_t)(pm >> 3) * (6 * D);
        f32x4 gv[2][2];
#pragma unroll
        for (int bj = 0; bj < 2; ++bj)
#pragma unroll
            for (int n = 0; n < 2; ++n) gv[bj][n] = *(const f32x4*)(g + col0 + bj * 128 + n * 16);
#pragma unroll
        for (int ai = 0; ai < 2; ++ai)
#pragma unroll
            for (int m = 0; m < 4; ++m) { const size_t off = (size_t)(row0 + ai * 128 + m * 16) * D + col0;
#pragma unroll
                for (int bj = 0; bj < 2; ++bj)
#pragma unroll
                    for (int n = 0; n < 2; ++n) { const f32x4 hv = *(const f32x4*)(h + off + bj * 128 + n * 16);
                        *(f32x4*)(pre + off + bj * 128 + n * 16) = hv * DN_ALPHA + gv[bj][n] * acc[ai][bj][m][n]; } }
    }
};
struct ProbMoe1 {
    static constexpr bool GATHER = true; static constexpr bool PERM = true;
    int K, lda, ldb, nunits; const bf16* U2; const int* IDX; const bf16* W13; bf16* HDN;
    __device__ __forceinline__ void map(int u, int& rt, int& pn) const { const int b = u & 3, q = u >> 2; pn = q % 11; rt = (q / 11) * 4 + b; }
    __device__ __forceinline__ void locate(int u, const char*& a, const char*& b) const { int rt, pn; map(u, rt, pn); a = (const char*)U2; b = (const char*)(W13 + (size_t)(rt >> 2) * (2 * FF * D) + (size_t)pn * 256 * D); }
    __device__ __forceinline__ void aoffs(int u, int tid, unsigned (&vo)[2][2]) const { int rt, pn; map(u, rt, pn);
#pragma unroll
        for (int i = 0; i < 2; ++i) { int R, C; pg8::stage_rc(tid * 16 + i * 8192, R, C);
#pragma unroll
            for (int h = 0; h < 2; ++h) { const int row = (rt & 3) * SEQ + IDX[rt * CAP + h * 128 + R]; vo[h][i] = (unsigned)(row * D + C) * 2u; } } }
    __device__ __forceinline__ void epi(const f32x4 (&acc)[2][2][4][2], int u, int wr, int wc, int fr, int fq) const {
        int rt, pn; map(u, rt, pn);
        const int row0 = rt * 256 + wr * 64 + fr, col0 = pn * 128 + wc * 32 + 8 * fq;
#pragma unroll
        for (int ai = 0; ai < 2; ++ai)
#pragma unroll
            for (int m = 0; m < 4; ++m) { bf16* rowp = HDN + (size_t)(row0 + ai * 128 + m * 16) * FF + col0;
                f32x4 v[2];
#pragma unroll
                for (int n = 0; n < 2; ++n) { const f32x4 a = acc[ai][0][m][n], g = acc[ai][1][m][n];
#pragma unroll
                    for (int j = 0; j < 4; ++j) v[n][j] = a[j] / (1.f + __expf(-a[j])) * g[j]; }
                pg8::st8(rowp, v[0], v[1]); }
    }
};
struct ProbMoe2 {
    static constexpr bool GATHER = false; static constexpr bool PERM = true;
    int K, lda, ldb, nunits; const bf16* HDN; const bf16* W2; const float* gate; bf16* YE;
    __device__ __forceinline__ void map(int u, int& rt, int& pn) const { const int b = u & 3, q = u >> 2; pn = q & 7; rt = (q >> 3) * 4 + b; }
    __device__ __forceinline__ void locate(int u, const char*& a, const char*& b) const { int rt, pn; map(u, rt, pn); a = (const char*)(HDN + (size_t)rt * 256 * FF); b = (const char*)(W2 + (size_t)(rt >> 2) * (D * FF) + (size_t)pn * 256 * FF); }
    __device__ __forceinline__ void epi(const f32x4 (&acc)[2][2][4][2], int u, int wr, int wc, int fr, int fq) const {
        int rt, pn; map(u, rt, pn);
        const int row0 = rt * 256 + wr * 64 + fr, col0 = pn * 256 + wc * 32 + 8 * fq;
#pragma unroll
        for (int ai = 0; ai < 2; ++ai)
#pragma unroll
            for (int m = 0; m < 4; ++m) { const int row = row0 + ai * 128 + m * 16; const float gt = gate[row]; bf16* rowp = YE + (size_t)row * D + col0;
#pragma unroll
                for (int bj = 0; bj < 2; ++bj) pg8::st8(rowp + bj * 128, acc[ai][bj][m][0] * gt, acc[ai][bj][m][1] * gt); }
    }
};
struct ProbF1 {
    static constexpr bool GATHER = false; static constexpr bool PERM = true;
    int K, lda, ldb, nunits; const bf16* CS; const bf16* P1; bf16* T1;
    __device__ __forceinline__ void map(int u, int& bg, int& pm, int& pn) const { pn = u & 7; pm = (u >> 3) & 1; bg = u >> 4; }
    __device__ __forceinline__ void locate(int u, const char*& a, const char*& b) const { int bg, pm, pn; map(u, bg, pm, pn);
        a = (const char*)(CS + (size_t)pm * 256 * 256); b = (const char*)(P1 + ((size_t)(bg >> 2) * SEQ + (size_t)pn * 256) * IN_CD + HY3 + (bg & 3) * 256); }
    __device__ __forceinline__ void epi(const f32x4 (&acc)[2][2][4][2], int u, int wr, int wc, int fr, int fq) const {
        int bg, pm, pn; map(u, bg, pm, pn);
        const int k20 = wr * 64 + fr, col0 = pn * 256 + wc * 32 + 8 * fq;
#pragma unroll
        for (int ai = 0; ai < 2; ++ai)
#pragma unroll
            for (int m = 0; m < 4; ++m) { const int k2 = k20 + ai * 128 + m * 16; bf16* rowp = T1 + (((size_t)bg * 256 + k2) * 2 + pm) * SEQ + col0;
#pragma unroll
                for (int bj = 0; bj < 2; ++bj) pg8::st8(rowp + bj * 128, acc[ai][bj][m][0], acc[ai][bj][m][1]); }
    }
};
struct ProbF2 {
    static constexpr bool GATHER = false; static constexpr bool PERM = true;
    int K, lda, ldb, nunits; const bf16* CSL; const bf16* T1; bf16* CAT;
    __device__ __forceinline__ void locate(int u, const char*& a, const char*& b) const { const int pm = u & 7, bg = u >> 3; a = (const char*)(CSL + (size_t)pm * 256 * 4096); b = (const char*)(T1 + (size_t)bg * 256 * 4096); }
    __device__ __forceinline__ void epi(const f32x4 (&acc)[2][2][4][2], int u, int wr, int wc, int fr, int fq) const {
        const int pm = u & 7, bg = u >> 3;
        const int row0 = (bg >> 2) * SEQ + pm * 256 + wr * 64 + fr, col0 = 1024 + (bg & 3) * 256 + wc * 32 + 8 * fq;
#pragma unroll
        for (int ai = 0; ai < 2; ++ai)
#pragma unroll
            for (int m = 0; m < 4; ++m) { bf16* rowp = CAT + (size_t)(row0 + ai * 128 + m * 16) * D + col0;
#pragma unroll
                for (int bj = 0; bj < 2; ++bj) pg8::st8(rowp + bj * 128, acc[ai][bj][m][0], acc[ai][bj][m][1]); }
    }
};

namespace att {
typedef short v4i16_t __attribute__((ext_vector_type(4)));
__device__ __forceinline__ s16x4 vtr(const LAS unsigned char* p) { return __builtin_bit_cast(s16x4, __builtin_amdgcn_ds_read_tr16_b64_v4i16((LAS v4i16_t*)p)); }
constexpr int VS = 320;
struct Tensors { const bf16* P; const bf16* KV; const bf16* KPE; const float* rpb; bf16* CAT; };

template <int MODE>
__device__ __forceinline__ void attn_unit(LAS unsigned char* lds, const Tensors& T, int unit) {
    constexpr int DK = MODE == 0 ? 192 : 128, NS = DK / 16, KCH = DK / 8, KS = DK * 2 + 16;
    constexpr int KBYTES = 64 * KS, VBYTES = 64 * VS, BUF = KBYTES + VBYTES;
    constexpr int NKC = (64 * KCH) / NTHR;
    const int tid = tid_opaque(), wave = __builtin_amdgcn_readfirstlane(tid >> 6), lane = tid & 63, l32 = lane & 31, hf = lane >> 5;
    const int b = unit >> 6, h = (unit >> 3) & 7, sub = unit & 7;
    LAS float* rpb_l = (LAS float*)(lds + 2 * BUF);
    int qrow, r = 0, qc = 0, krlo = 0, nkt;
    if (MODE == 0) { qrow = b * SEQ + sub * 256 + wave * 32 + l32; nkt = 36; }
    else { r = sub * 4 + (wave >> 1); qc = (wave & 1) * 32 + l32; qrow = b * SEQ + r * GW + qc;
        const int r0 = sub * 4, r3 = r0 + 3; krlo = r0 - 4 < 0 ? 0 : (r0 - 4 > 24 ? 24 : r0 - 4); const int rs3 = r3 - 4 < 0 ? 0 : (r3 - 4 > 24 ? 24 : r3 - 4);
        nkt = 4 + (rs3 + 8 - krlo); }
    const int rs = r - 4 < 0 ? 0 : (r - 4 > 24 ? 24 : r - 4);
    const int cs = qc - 8 < 0 ? 0 : (qc - 8 > 48 ? 48 : qc - 8);
    bf16x8 qf[NS];
    { const bf16* qp = T.P + (size_t)qrow * IN_AB_PAD + (MODE == 0 ? h * 192 : OFF_QNA + h * 128) + 8 * hf;
#pragma unroll
      for (int s = 0; s < NS; ++s) qf[s] = *(const bf16x8*)(qp + 16 * s); }
    if (MODE == 1) { for (int i = tid; i < 15 * 31; i += NTHR) rpb_l[i] = T.rpb[h * 465 + i]; }
    u32x4 kreg[NKC], vreg[2];
    auto key_row = [&](int kt, int rr) -> int {
        if (MODE == 0) return kt < 32 ? b * SEQ + kt * 64 + rr : MLAT + b * LC + (kt - 32) * 64 + rr;
        return kt < 4 ? MLAT + b * LC + kt * 64 + rr : b * SEQ + (krlo + kt - 4) * GW + rr;
    };
    auto load_tile = [&](int kt) {
#pragma unroll
        for (int i = 0; i < NKC; ++i) { const int ci = tid + i * NTHR, rr = ci / KCH, c = ci % KCH; const int row = key_row(kt, rr);
            const bf16* src;
            if (MODE == 0) src = c < 16 ? T.KV + (size_t)row * D + h * 256 + c * 8 : T.KPE + (size_t)row * 64 + (c - 16) * 8;
            else src = T.P + (size_t)row * IN_AB_PAD + OFF_KNA + h * 128 + c * 8;
            kreg[i] = *(const u32x4*)src; }
#pragma unroll
        for (int i = 0; i < 2; ++i) { const int ci = tid + i * NTHR, rr = ci >> 4, c = ci & 15; const int row = key_row(kt, rr);
            const bf16* src = MODE == 0 ? T.KV + (size_t)row * D + h * 256 + 128 + c * 8 : T.P + (size_t)row * IN_AB_PAD + OFF_VNA + h * 128 + c * 8;
            vreg[i] = *(const u32x4*)src; }
    };
    auto store_tile = [&](int buf) {
        LAS unsigned char* kb = lds + buf * BUF; LAS unsigned char* vb = kb + KBYTES;
#pragma unroll
        for (int i = 0; i < NKC; ++i) { const int ci = tid + i * NTHR, rr = ci / KCH, c = ci % KCH; *(LAS u32x4*)(kb + rr * KS + c * 16) = kreg[i]; }
#pragma unroll
        for (int i = 0; i < 2; ++i) { const int ci = tid + i * NTHR, rr = ci >> 4, c = ci & 15; *(LAS u32x4*)(vb + rr * VS + c * 16) = vreg[i]; }
    };
    f32x16 o[4];
#pragma unroll
    for (int c = 0; c < 4; ++c)
#pragma unroll
        for (int i = 0; i < 16; ++i) o[c][i] = 0.f;
    float m_run = -1e30f, l_run = 0.f;
    const float sc2 = (MODE == 0 ? 0.07216878364870322f : 0.08838834764831845f) * 1.4426950408889634f;
    load_tile(0); store_tile(0); __syncthreads();
    for (int kt = 0; kt < nkt; ++kt) {
        if (kt + 1 < nkt) load_tile(kt + 1);
        const int kr = krlo + kt - 4;
        const bool active = MODE == 0 || kt < 4 || (kr >= rs && kr < rs + 8);
        if (active) {
            const LAS unsigned char* kb = lds + (kt & 1) * BUF; const LAS unsigned char* vb = kb + KBYTES;
#pragma unroll
            for (int kb2 = 0; kb2 < 2; ++kb2) {
                f32x16 sc;
#pragma unroll
                for (int i = 0; i < 16; ++i) sc[i] = 0.f;
#pragma unroll
                for (int s = 0; s < NS; ++s) { const bf16x8 kf = *(const LAS bf16x8*)(kb + (32 * kb2 + l32) * KS + (16 * s + 8 * hf) * 2);
                    sc = __builtin_amdgcn_mfma_f32_32x32x16_bf16(kf, qf[s], sc, 0, 0, 0); }
                float mx = -1e30f;
#pragma unroll
                for (int i = 0; i < 16; ++i) {
                    float v = sc[i] * sc2;
                    if (MODE == 1 && kt >= 4) { const int kc = 32 * kb2 + 8 * (i >> 2) + 4 * hf + (i & 3); const int dcl = kc - cs; const bool ok = (unsigned)dcl < 16u;
                        int bi = (kr - r + 7) * 31 + (kc - qc + 15); bi = ok ? bi : 0;
                        v = ok ? v + rpb_l[bi] * 1.4426950408889634f : -1e30f; }
                    sc[i] = v; mx = fmaxf(mx, v); }
                mx = fmaxf(mx, __shfl_xor(mx, 32));
                const float m_new = fmaxf(m_run, mx), alpha = __builtin_amdgcn_exp2f(m_run - m_new);
                m_run = m_new;
                float ps = 0.f;
#pragma unroll
                for (int i = 0; i < 16; ++i) { const float p = __builtin_amdgcn_exp2f(sc[i] - m_new); sc[i] = p; ps += p; }
                l_run = l_run * alpha + ps;
                if (__builtin_amdgcn_ballot_w64(alpha != 1.f) != 0ull) {
#pragma unroll
                    for (int c = 0; c < 4; ++c)
#pragma unroll
                        for (int i = 0; i < 16; ++i) o[c][i] *= alpha; }
#pragma unroll
                for (int s2 = 0; s2 < 2; ++s2) {
                    u32x4 pw; pw.x = cvtpk(sc[8 * s2 + 0], sc[8 * s2 + 1]); pw.y = cvtpk(sc[8 * s2 + 2], sc[8 * s2 + 3]);
                    pw.z = cvtpk(sc[8 * s2 + 4], sc[8 * s2 + 5]); pw.w = cvtpk(sc[8 * s2 + 6], sc[8 * s2 + 7]);
                    const bf16x8 pf = __builtin_bit_cast(bf16x8, pw);
                    const LAS unsigned char* vrow = vb + (32 * kb2 + 16 * s2 + 4 * hf + ((lane & 15) >> 2)) * VS + (16 * ((lane >> 4) & 1) + 4 * (lane & 3)) * 2;
#pragma unroll
                    for (int c = 0; c < 4; ++c) {
                        const s16x4 v0 = vtr(vrow + c * 64), v1 = vtr(vrow + 8 * VS + c * 64);
                        const bf16x8 vf = {v0[0], v0[1], v0[2], v0[3], v1[0], v1[1], v1[2], v1[3]};
                        o[c] = __builtin_amdgcn_mfma_f32_32x32x16_bf16(vf, pf, o[c], 0, 0, 0); }
                }
            }
        }
        if (kt + 1 < nkt) store_tile((kt + 1) & 1);
        __syncthreads();
    }
    const float linv = 1.f / (l_run + __shfl_xor(l_run, 32));
    bf16* op = T.CAT + (size_t)qrow * D + (MODE == 0 ? h * 128 : 1024 + h * 128) + 4 * hf;
#pragma unroll
    for (int c = 0; c < 4; ++c)
#pragma unroll
        for (int g = 0; g < 4; ++g) { u32x2 w; w.x = cvtpk(o[c][4 * g] * linv, o[c][4 * g + 1] * linv); w.y = cvtpk(o[c][4 * g + 2] * linv, o[c][4 * g + 3] * linv);
            *(u32x2*)(op + 32 * c + 8 * g) = w; }
}
}

namespace hy {
constexpr int ZROW = 32 * 144 + 16;
constexpr int Z_BYTES = 16 * ZROW;
constexpr int HR_OFF = 74240;
constexpr int HR_CH = 16384;
constexpr int XROW = 4096 + 16;
constexpr int HR_BYTES = 16 * XROW;
static_assert(HR_OFF + HR_BYTES <= LDS_MAIN && HR_OFF >= Z_BYTES && HR_BYTES >= 4 * HR_CH, "hyena LDS map");

__device__ __forceinline__ void load_rows(LAS unsigned char* lds, const bf16* ST, int part, int c0, bool zlayout) {
    const int tid = tid_opaque();
#pragma unroll
    for (int i = 0; i < 8; ++i) { const int ci = tid + i * NTHR, row = ci >> 8, cc = ci & 255, ch = row >> 2, b = row & 3;
        const u32x4 v = *(const u32x4*)(ST + ((size_t)(b * HY3 + part * HYW + c0 + ch) * SEQ + cc * 8));
        if (zlayout) *(LAS u32x4*)(lds + row * ZROW + (cc >> 3) * 144 + (cc & 7) * 16) = v;
        else *(LAS u32x4*)(lds + HR_OFF + row * XROW + cc * 16) = v; }
}
__device__ __forceinline__ void load_hr(LAS unsigned char* lds, const bf16* HRg, int o, int c0) {
    const int tid = tid_opaque();
#pragma unroll
    for (int i = 0; i < 4; ++i) { const int ci = tid + i * NTHR, ch = ci >> 9, cc = ci & 511;
        const unsigned* src = (const unsigned*)(HRg + ((size_t)(o * HYW + c0 + ch) * 4096 + cc * 8));
        const u32x4 v = *(const u32x4*)src; const unsigned nx = cc == 511 ? 0u : src[4];
        *(LAS u32x4*)(lds + HR_OFF + ch * HR_CH + cc * 16) = v;
        u32x4 s; s.x = (v.x >> 16) | (v.y << 16); s.y = (v.y >> 16) | (v.z << 16); s.z = (v.z >> 16) | (v.w << 16); s.w = (v.w >> 16) | (nx << 16);
        *(LAS u32x4*)(lds + HR_OFF + ch * HR_CH + 8192 + cc * 16) = s; }
}
__device__ __forceinline__ void conv_mma(LAS unsigned char* lds, f32x16 (&acc)[4], int wave, int lane) {
    const int ch = wave >> 1, a0 = (wave & 1) * 32, l32 = lane & 31, hf = lane >> 5, il = l32 >> 2, b = l32 & 3;
    const LAS unsigned char* hrc = lds + HR_OFF + ch * HR_CH;
    const LAS unsigned char* zl = lds + (ch * 4 + b) * ZROW + hf * 16;
#pragma unroll
    for (int n = 0; n < 4; ++n)
#pragma unroll
        for (int i = 0; i < 16; ++i) acc[n][i] = 0.f;
    for (int d = -31; d <= 31; ++d) {
        const int ilo = d > 0 ? d : 0, ihi = d < 0 ? 31 + d : 31;
#pragma unroll
        for (int k4 = 0; k4 < 4; ++k4) { const int k0 = 16 * k4;
            const int x0 = 2048 - 64 * d + k0 - a0 - l32 + 8 * hf;
            const LAS unsigned* ap = (const LAS unsigned*)(hrc + (x0 & 1) * 8192 + (x0 >> 1) * 4);
            u32x4 aw; aw.x = ap[0]; aw.y = ap[1]; aw.z = ap[2]; aw.w = ap[3];
            const bf16x8 af = __builtin_bit_cast(bf16x8, aw);
#pragma unroll
            for (int n = 0; n < 4; ++n) if (8 * n + 7 >= ilo && 8 * n <= ihi) {
                const int j = 8 * n + il - d; const bool ok = (unsigned)j < 32u; const int jc = ok ? j : 0;
                u32x4 bw = *(const LAS u32x4*)(zl + jc * 144 + k0 * 2);
                if (!ok) bw = (u32x4){0u, 0u, 0u, 0u};
                acc[n] = __builtin_amdgcn_mfma_f32_32x32x16_bf16(af, __builtin_bit_cast(bf16x8, bw), acc[n], 0, 0, 0); }
        }
    }
}
__device__ __forceinline__ void gate_epi(LAS unsigned char* lds, f32x16 (&acc)[4], float skip, int wave, int lane) {
    const int ch = wave >> 1, a0 = (wave & 1) * 32, l32 = lane & 31, hf = lane >> 5, il = l32 >> 2, b = l32 & 3;
#pragma unroll
    for (int n = 0; n < 4; ++n)
#pragma unroll
        for (int g = 0; g < 4; ++g) { const int i = 8 * n + il, ao = a0 + 8 * g + 4 * hf;
            const u32x2 zw = *(const LAS u32x2*)(lds + (ch * 4 + b) * ZROW + i * 144 + ao * 2);
            const u32x2 xw = *(const LAS u32x2*)(lds + HR_OFF + (ch * 4 + b) * XROW + (64 * i + ao) * 2);
            acc[n][4 * g + 0] = bflo(xw.x) * (acc[n][4 * g + 0] + skip * bflo(zw.x));
            acc[n][4 * g + 1] = bfhi(xw.x) * (acc[n][4 * g + 1] + skip * bfhi(zw.x));
            acc[n][4 * g + 2] = bflo(xw.y) * (acc[n][4 * g + 2] + skip * bflo(zw.y));
            acc[n][4 * g + 3] = bfhi(xw.y) * (acc[n][4 * g + 3] + skip * bfhi(zw.y)); }
}
__device__ __forceinline__ void hyena_unit(LAS unsigned char* lds, const bf16* ST, const bf16* HRg, const float* skip, bf16* CAT, int unit) {
    const int tid = tid_opaque(), wave = __builtin_amdgcn_readfirstlane(tid >> 6), lane = tid & 63;
    const int c0 = unit * 4, ch = wave >> 1, a0 = (wave & 1) * 32, l32 = lane & 31, hf = lane >> 5, il = l32 >> 2, b = l32 & 3;
    f32x16 acc[4];
    load_rows(lds, ST, 0, c0, true); load_hr(lds, HRg, 0, c0);
    __syncthreads();
    conv_mma(lds, acc, wave, lane);
    __syncthreads();
    load_rows(lds, ST, 1, c0, false);
    __syncthreads();
    gate_epi(lds, acc, skip[c0 + ch], wave, lane);
    __syncthreads();
#pragma unroll
    for (int n = 0; n < 4; ++n)
#pragma unroll
        for (int g = 0; g < 4; ++g) { const int i = 8 * n + il, ao = a0 + 8 * g + 4 * hf;
            u32x2 w; w.x = cvtpk(acc[n][4 * g], acc[n][4 * g + 1]); w.y = cvtpk(acc[n][4 * g + 2], acc[n][4 * g + 3]);
            *(LAS u32x2*)(lds + (ch * 4 + b) * ZROW + i * 144 + ao * 2) = w; }
    load_hr(lds, HRg, 1, c0);
    __syncthreads();
    conv_mma(lds, acc, wave, lane);
    __syncthreads();
    load_rows(lds, ST, 2, c0, false);
    __syncthreads();
    gate_epi(lds, acc, skip[HYW + c0 + ch], wave, lane);
    __syncthreads();
    LAS bf16* Y = (LAS bf16*)lds;
#pragma unroll
    for (int n = 0; n < 4; ++n)
#pragma unroll
        for (int e = 0; e < 16; ++e) { const int t = 64 * (8 * n + il) + a0 + 8 * (e >> 2) + 4 * hf + (e & 3);
            Y[(b * SEQ + t) * 4 + ch] = (bf16)f2bf(acc[n][e]); }
    __syncthreads();
#pragma unroll 4
    for (int i = 0; i < 16; ++i) { const int it = tid + i * NTHR; const u32x2 v = *(const LAS u32x2*)(lds + it * 8);
        *(u32x2*)(CAT + (size_t)it * D + c0) = v; }
    __syncthreads();
}
}

__device__ __forceinline__ void prep_item(LAS unsigned char* scr, const bf16* P1, const float* cw, const float* cb, bf16* ST, int item, int lane) {
    const int ct = item % 48, tt = (item / 48) & 31, b = item / (48 * 32), t0 = tt * 64, c30 = ct * 64;
#pragma unroll
    for (int i = 0; i < 9; ++i) { const int ci = lane + i * 64; if (ci < 66 * 8) { const int rr = ci >> 3, cc = ci & 7, t = t0 - 1 + rr;
        u32x4 v = (u32x4){0u, 0u, 0u, 0u};
        if (t >= 0 && t < SEQ) v = *(const u32x4*)(P1 + ((size_t)(b * SEQ + t) * IN_CD + c30 + cc * 8));
        *(LAS u32x4*)(scr + rr * 144 + cc * 16) = v; } }
    LDS_WAIT(); asm volatile("" ::: "memory");
    const LAS bf16* tile = (const LAS bf16*)scr;
    for (int c = 0; c < 64; ++c) { const int c3 = c30 + c;
        const float w0 = cw[c3], w1 = cw[HY3 + c3], w2 = cw[2 * HY3 + c3], bb = cb[c3];
        const float v = bb + w0 * bf2f(tile[lane * 72 + c]) + w1 * bf2f(tile[(lane + 1) * 72 + c]) + w2 * bf2f(tile[(lane + 2) * 72 + c]);
        ST[(size_t)(b * HY3 + c3) * SEQ + t0 + lane] = (bf16)f2bf(v); }
    LDS_WAIT(); asm volatile("" ::: "memory");
}

__device__ __forceinline__ void transpose_item(const float* W, int N, bf16* WT, int ldt, int k0, int n0, int drow0, LAS float* scr, int lane) {
#pragma unroll 8
    for (int i = 0; i < 32; ++i) { const int kk = 2 * i + (lane >> 5); scr[kk * 33 + (lane & 31)] = W[(size_t)(k0 + kk) * N + n0 + (lane & 31)]; }
    LDS_WAIT(); asm volatile("" ::: "memory");
    const int c = lane & 7;
#pragma unroll
    for (int j = 0; j < 4; ++j) { const int n = (lane >> 3) + 8 * j; const LAS float* s = scr + (8 * c) * 33 + n;
        u32x4 o; o.x = pk2(s[0 * 33], s[1 * 33]); o.y = pk2(s[2 * 33], s[3 * 33]); o.z = pk2(s[4 * 33], s[5 * 33]); o.w = pk2(s[6 * 33], s[7 * 33]);
        *(u32x4*)(WT + (size_t)(drow0 + n) * ldt + k0 + 8 * c) = o; }
    LDS_WAIT(); asm volatile("" ::: "memory");
}

struct Args { const float* in[31]; float* out; unsigned char* ws; int ph_lo, ph_hi; };
enum { I_X = 0, I_C, I_CTX, I_CCTX, I_ADAW, I_ADAB, I_LN1G, I_LN1B, I_LN2G, I_LN2B, I_ROUTER, I_W1, I_W3, I_W2, I_ABIN, I_KVNORM, I_UKV, I_RPB, I_ABOUT,
       I_CDIN, I_CONVW, I_CONVB, I_FW1, I_FB1, I_FF1, I_FW2, I_FB2, I_FF2, I_FW3, I_SKIP, I_CDOUT };
constexpr int NPHASE = 21;
typedef const char __attribute__((address_space(4)))* kptr_t;
__device__ __forceinline__ const float* kin(int i) { kptr_t ka = (kptr_t)__builtin_amdgcn_kernarg_segment_ptr(); int off = i * 8; asm volatile("" : "+s"(off)); return *(const float* const __attribute__((address_space(4)))*)(ka + off); }
__device__ __forceinline__ float* kout() { kptr_t ka = (kptr_t)__builtin_amdgcn_kernarg_segment_ptr(); int off = 31 * 8; asm volatile("" : "+s"(off)); return *(float* const __attribute__((address_space(4)))*)(ka + off); }
__device__ __forceinline__ unsigned char* kws() { kptr_t ka = (kptr_t)__builtin_amdgcn_kernarg_segment_ptr(); int off = 32 * 8; asm volatile("" : "+s"(off)); return *(unsigned char* const __attribute__((address_space(4)))*)(ka + off); }
static_assert(sizeof(Args) == 33 * 8 + 8, "Args layout");

__device__ __forceinline__ void ada_phase(LAS unsigned char* lds, const Args& A, int vcu, int G) {
    const int tid = tid_opaque();
    LAS float* sil = (LAS float*)lds; LAS float* part = sil + 5 * D;
    float* ADA = (float*)(kws() + WS_ADA);
    for (int i = tid; i < 5 * D; i += NTHR) { const int r = i / D, k = i % D; const float x = r < 4 ? kin(I_C)[r * D + k] : kin(I_CCTX)[k]; sil[i] = x / (1.f + expf(-x)); }
    __syncthreads();
    const int kg = tid >> 4, c4 = tid & 15;
    for (int unit = vcu; unit < 384; unit += G) {
        const int l = unit / 192, col0 = (unit % 192) * 64;
        f32x4 acc[5];
#pragma unroll
        for (int r = 0; r < 5; ++r) acc[r] = (f32x4){0.f, 0.f, 0.f, 0.f};
        const float* W = kin(I_ADAW) + (size_t)l * D * (6 * D) + col0 + 4 * c4;
#pragma unroll 8
        for (int i = 0; i < 64; ++i) { const int row = kg * 64 + i; const f32x4 w = *(const f32x4*)(W + (size_t)row * (6 * D));
#pragma unroll
            for (int r = 0; r < 5; ++r) acc[r] += w * sil[r * D + row]; }
#pragma unroll
        for (int r = 0; r < 5; ++r) *(LAS f32x4*)(part + ((kg * 16 + c4) * 5 + r) * 4) = acc[r];
        __syncthreads();
        if (tid < 320) { const int r = tid >> 6, col = tid & 63; float s = 0.f;
            for (int g = 0; g < 32; ++g) s += part[((g * 16 + (col >> 2)) * 5 + r) * 4 + (col & 3)];
            ADA[(size_t)(l * 5 + r) * (6 * D) + col0 + col] = s + kin(I_ADAB)[l * 6 * D + col0 + col]; }
        __syncthreads();
    }
}
__device__ __forceinline__ void filt_phase(LAS unsigned char* lds, const Args& A, int vcu, int G) {
    const int tid = tid_opaque(), wave = __builtin_amdgcn_readfirstlane(tid >> 6), lane = tid & 63;
    LAS float* zf = (LAS float*)lds;
    LAS float* h1 = zf + 64 * 33;
    LAS float* h2 = h1 + 64 * 65;
    bf16* HRg = (bf16*)(kws() + WS_HR);
    const float* fw1 = kin(I_FW1); const float* fb1 = kin(I_FB1); const float* ff1 = kin(I_FF1);
    const float* fw2 = kin(I_FW2); const float* fb2 = kin(I_FB2); const float* ff2 = kin(I_FF2); const float* fw3 = kin(I_FW3);
    for (int unit = vcu; unit < 256; unit += G) {
        const int lb = unit >> 3, cbk = unit & 7, l = lb * 64 + lane;
        const float t01 = (float)l / 2047.f, w = 6.283185307179586f * (float)l / 2048.f;
        for (int f = wave; f < 33; f += 8) { float v;
            if (f == 0) v = t01; else { const int j = (f - 1) & 15; const float band = 1e-4f + (float)j * ((15.f - 1e-4f) / 15.f); v = f <= 16 ? cosf(w * band) : -sinf(w * band); }
            zf[lane * 33 + f] = v; }
        __syncthreads();
        { float a[8];
#pragma unroll
          for (int i = 0; i < 8; ++i) a[i] = fb1[wave * 8 + i];
#pragma unroll 1
          for (int f = 0; f < 33; ++f) { const float z = zf[lane * 33 + f];
#pragma unroll
              for (int i = 0; i < 8; ++i) a[i] += z * fw1[f * 64 + wave * 8 + i]; }
#pragma unroll
          for (int i = 0; i < 8; ++i) h1[lane * 65 + wave * 8 + i] = sinf(ff1[wave * 8 + i] * a[i]); }
        __syncthreads();
        { float a[8];
#pragma unroll
          for (int i = 0; i < 8; ++i) a[i] = fb2[wave * 8 + i];
#pragma unroll 1
          for (int f = 0; f < 64; ++f) { const float z = h1[lane * 65 + f];
#pragma unroll
              for (int i = 0; i < 8; ++i) a[i] += z * fw2[f * 64 + wave * 8 + i]; }
#pragma unroll
          for (int i = 0; i < 8; ++i) h2[lane * 65 + wave * 8 + i] = sinf(ff2[wave * 8 + i] * a[i]); }
        __syncthreads();
        for (int cg = 0; cg < 4; ++cg) {
            const int col0 = cbk * 512 + wave * 64 + cg * 16;
            float acc[16];
#pragma unroll
            for (int i = 0; i < 16; ++i) acc[i] = 0.f;
#pragma unroll 1
            for (int j = 0; j < 64; ++j) { const float hv = h2[lane * 65 + j]; const float* wr = fw3 + (size_t)j * 4096 + col0;
#pragma unroll
                for (int i = 0; i < 16; ++i) acc[i] += hv * wr[i]; }
            const int o = col0 >> 11, dir = (col0 >> 10) & 1, cbase = col0 & 1023;
#pragma unroll
            for (int i = 0; i < 16; ++i) { const int c = cbase + i;
                const float delta = fabsf(-3.0701134573253946f + (float)c * ((-15.350567286626973f + 3.0701134573253946f) / 1023.f));
                const float v = acc[i] * expf(-t01 * delta);
                bf16* row = HRg + (size_t)(o * HYW + c) * 4096;
                if (dir == 0) row[2048 - l] = (bf16)f2bf(v); else row[l == 0 ? 0 : 2048 + l] = l == 0 ? (bf16)0 : (bf16)f2bf(v); }
        }
        __syncthreads();
    }
}
__device__ __forceinline__ void convert_phase(LAS unsigned char* lds, const Args& A, int vcu, int G) {
    const int tid = tid_opaque(), wave = __builtin_amdgcn_readfirstlane(tid >> 6), lane = tid & 63;
    LAS float* scr = (LAS float*)(lds + wave * 16384);
    const int gw = vcu * NWAVES + wave, NGW = G * NWAVES;
    unsigned char* ws = kws();
    constexpr int N0 = 32 * 162, N1 = 8 * 64, N2 = 32 * 64, N3 = 32 * 128, N4 = 32 * 64, NEI = 32 * 44, N5 = 32 * NEI, N6 = N5, N7 = 32 * (22 * 64);
    constexpr int NIT = N0 + N1 + N2 + N3 + N4 + N5 + N6 + N7;
    for (int it = gw; it < NIT; it += NGW) {
        int r = it;
        if (r < N5) { const int le = r / NEI, q = r % NEI, kb = q / 44, nb = q % 44, f0 = nb * 32;
            transpose_item(kin(I_W1) + (size_t)le * D * FF, FF, (bf16*)(ws + WS_W13) + (size_t)le * (2 * FF * D), D, kb * 64, f0, (f0 >> 7) * 256 + (f0 & 127), scr, lane); continue; } r -= N5;
        if (r < N6) { const int le = r / NEI, q = r % NEI, kb = q / 44, nb = q % 44, f0 = nb * 32;
            transpose_item(kin(I_W3) + (size_t)le * D * FF, FF, (bf16*)(ws + WS_W13) + (size_t)le * (2 * FF * D), D, kb * 64, f0, (f0 >> 7) * 256 + 128 + (f0 & 127), scr, lane); continue; } r -= N6;
        if (r < N7) { const int le = r / NEI, q = r % NEI, kb = q / 64, nb = q % 64;
            transpose_item(kin(I_W2) + (size_t)le * FF * D, D, (bf16*)(ws + WS_W2) + (size_t)le * (D * FF), FF, kb * 64, nb * 32, nb * 32, scr, lane); continue; } r -= N7;
        if (r < N0) { transpose_item(kin(I_ABIN), IN_AB, (bf16*)(ws + WS_WAB), D, (r / 162) * 64, (r % 162) * 32, (r % 162) * 32, scr, lane); continue; } r -= N0;
        if (r < N1) { transpose_item(kin(I_UKV), D, (bf16*)(ws + WS_WUKV), KVR, (r / 64) * 64, (r % 64) * 32, (r % 64) * 32, scr, lane); continue; } r -= N1;
        if (r < N2) { transpose_item(kin(I_ABOUT), D, (bf16*)(ws + WS_WABO), D, (r / 64) * 64, (r % 64) * 32, (r % 64) * 32, scr, lane); continue; } r -= N2;
        if (r < N3) { transpose_item(kin(I_CDIN), IN_CD, (bf16*)(ws + WS_WCD), D, (r / 128) * 64, (r % 128) * 32, (r % 128) * 32, scr, lane); continue; } r -= N3;
        transpose_item(kin(I_CDOUT), D, (bf16*)(ws + WS_WCDO), D, (r / 64) * 64, (r % 64) * 32, (r % 64) * 32, scr, lane);
    }
    const size_t gt = (size_t)vcu * NTHR + tid, NGT = (size_t)G * NTHR;
    { u32x4* z = (u32x4*)(ws + WS_WAB + (size_t)IN_AB * D * 2); for (size_t i = gt; i < (size_t)(IN_AB_PAD - IN_AB) * D * 2 / 16; i += NGT) z[i] = (u32x4){0u, 0u, 0u, 0u}; }
    { unsigned* cs = (unsigned*)(ws + WS_CS256);
      for (size_t i = gt; i < 512 * 128; i += NGT) { const int row = (int)(i >> 7), n = (int)(i & 127) * 2, k2 = row & 255; const bool sn = row >= 256;
          const float a0 = (float)((k2 * n) & 255) * (1.f / 128.f), a1 = (float)((k2 * (n + 1)) & 255) * (1.f / 128.f);
          cs[i] = pk2((sn ? sinpif(a0) : cospif(a0)) * 0.0625f, (sn ? sinpif(a1) : cospif(a1)) * 0.0625f); } }
    { unsigned* cl = (unsigned*)(ws + WS_CSL);
      const float nrm = 0.022097086912079608f;
      for (size_t i = gt; i < (size_t)2048 * 2048; i += NGT) { const int k1 = (int)(i >> 11), j = (int)(i & 2047) * 2; const bool sn = j >= 2048; const int t = j & 2047;
          const float a0 = (float)((k1 * t) & 2047) * (1.f / 1024.f), a1 = (float)((k1 * (t + 1)) & 2047) * (1.f / 1024.f);
          cl[i] = pk2((sn ? -sinpif(a0) : cospif(a0)) * nrm, (sn ? -sinpif(a1) : cospif(a1)) * nrm); } }
}
__device__ __forceinline__ void mod_row(const float* xrow, const float* shift, const float* scale, bf16* orow, int lane) {
#pragma unroll
    for (int j = 0; j < 8; ++j) { const int c = 4 * lane + 256 * j; const f32x4 x = *(const f32x4*)(xrow + c), sh = *(const f32x4*)(shift + c), sc = *(const f32x4*)(scale + c);
        const f32x4 u = x * (sc + 1.f) + sh; u32x2 w; w.x = pk2(u[0], u[1]); w.y = pk2(u[2], u[3]); *(u32x2*)(orow + c) = w; }
}
__device__ __forceinline__ void modulate_phase(const Args& A, int vcu, int G) {
    const int tid = tid_opaque(), lane = tid & 63, gw = vcu * NWAVES + __builtin_amdgcn_readfirstlane(tid >> 6), NGW = G * NWAVES;
    const float* ADA = (const float*)(kws() + WS_ADA); bf16* U = (bf16*)(kws() + WS_UALL); const float* X = kin(I_X); const float* CT = kin(I_CTX);
    for (int row = gw; row < MALL; row += NGW) {
        if (row < MLAT) { const int b = row >> 11; mod_row(X + (size_t)row * D, ADA + (size_t)b * 6 * D, ADA + (size_t)b * 6 * D + D, U + (size_t)row * D, lane); }
        else mod_row(CT + (size_t)(row - MLAT) * D, ADA + (size_t)4 * 6 * D, ADA + (size_t)4 * 6 * D + D, U + (size_t)row * D, lane);
    }
}
__device__ __forceinline__ void postproj_phase(const Args& A, int vcu, int G) {
    const int tid = tid_opaque(), lane = tid & 63, gw = vcu * NWAVES + __builtin_amdgcn_readfirstlane(tid >> 6), NGW = G * NWAVES;
    bf16* P = (bf16*)(kws() + WS_P); bf16* CK = (bf16*)(kws() + WS_CKVN); bf16* KPE = (bf16*)(kws() + WS_KPE); const float* kvn = kin(I_KVNORM);
    const int fi = lane & 31;
    const float inv = exp2f(-(float)(fi & 15) * (13.287712379549449f / 16.f));
    for (int row = gw; row < MALL; row += NGW) {
        bf16* pr = P + (size_t)row * IN_AB_PAD;
        { const u32x4 w = *(const u32x4*)(pr + OFF_CKV + 8 * lane); float x[8] = {bflo(w.x), bfhi(w.x), bflo(w.y), bfhi(w.y), bflo(w.z), bfhi(w.z), bflo(w.w), bfhi(w.w)};
          float ss = 0.f;
#pragma unroll
          for (int i = 0; i < 8; ++i) ss += x[i] * x[i];
          const float rstd = 1.f / sqrtf(wave_sum(ss) * (1.f / KVR) + LN_EPS);
          const f32x4 g0 = *(const f32x4*)(kvn + 8 * lane), g1 = *(const f32x4*)(kvn + 8 * lane + 4);
          u32x4 o; o.x = pk2(x[0] * rstd * g0[0], x[1] * rstd * g0[1]); o.y = pk2(x[2] * rstd * g0[2], x[3] * rstd * g0[3]);
          o.z = pk2(x[4] * rstd * g1[0], x[5] * rstd * g1[1]); o.w = pk2(x[6] * rstd * g1[2], x[7] * rstd * g1[3]);
          *(u32x4*)(CK + (size_t)row * KVR + 8 * lane) = o; }
        if (row < MLAT) {
            const int t = row & 2047; const float pos = (float)(fi < 16 ? (t >> 6) : (t & 63)); float sn, cs; sincosf(pos * inv, &sn, &cs);
            if (lane < 32) { const float t1 = bf2f(pr[OFF_KPE + fi]), t2 = bf2f(pr[OFF_KPE + 32 + fi]);
                KPE[(size_t)row * 64 + fi] = (bf16)f2bf(t1 * cs - t2 * sn); KPE[(size_t)row * 64 + 32 + fi] = (bf16)f2bf(t2 * cs + t1 * sn); }
#pragma unroll
            for (int q = 0; q < 4; ++q) { const int h = 2 * q + (lane >> 5); bf16* qp = pr + h * 192 + 128;
                const float t1 = bf2f(qp[fi]), t2 = bf2f(qp[32 + fi]); qp[fi] = (bf16)f2bf(t1 * cs - t2 * sn); qp[32 + fi] = (bf16)f2bf(t2 * cs + t1 * sn); }
        } else KPE[(size_t)row * 64 + lane] = pr[OFF_KPE + lane];
    }
}
__device__ __forceinline__ void ln1_phase(LAS unsigned char* lds, int l, int vcu, int G) {
    const int tid = tid_opaque(), lane = tid & 63, gw = vcu * NWAVES + __builtin_amdgcn_readfirstlane(tid >> 6), NGW = G * NWAVES;
    LAS float* rt = (LAS float*)lds;
    unsigned char* ws = kws();
    { const float* router = kin(I_ROUTER) + (size_t)l * D * NE;
      for (int i = tid; i < 4 * D; i += NTHR) { const int c = i & (D - 1), q = i >> 11; const f32x4 v = *(const f32x4*)(router + (size_t)c * NE + 4 * q);
          rt[(4 * q + 0) * D + c] = v[0]; rt[(4 * q + 1) * D + c] = v[1]; rt[(4 * q + 2) * D + c] = v[2]; rt[(4 * q + 3) * D + c] = v[3]; } }
    __syncthreads();
    const float* PRE = (const float*)(ws + WS_PRE); float* H1 = (float*)(ws + WS_H1); bf16* U2 = (bf16*)(ws + WS_U2); float* AFF = (float*)(ws + WS_AFF);
    const float* g = kin(I_LN1G) + l * D; const float* bb = kin(I_LN1B) + l * D; const float* ADA = (const float*)(ws + WS_ADA) + (size_t)l * 5 * 6 * D;
    for (int rp = gw; rp < MLAT / 2; rp += NGW) {
        const int row0 = rp * 2, b = row0 >> 11;
        const float* ada = ADA + (size_t)b * 6 * D;
        f32x4 v[2][8];
#pragma unroll
        for (int rr = 0; rr < 2; ++rr)
#pragma unroll
            for (int j = 0; j < 8; ++j) v[rr][j] = *(const f32x4*)(PRE + (size_t)(row0 + rr) * D + 4 * lane + 256 * j);
#pragma unroll
        for (int rr = 0; rr < 2; ++rr) { float s = 0.f;
#pragma unroll
            for (int j = 0; j < 8; ++j) s += (v[rr][j][0] + v[rr][j][1]) + (v[rr][j][2] + v[rr][j][3]);
            const float mean = wave_sum(s) * (1.f / D); float q = 0.f;
#pragma unroll
            for (int j = 0; j < 8; ++j) { v[rr][j] = v[rr][j] - mean; q += (v[rr][j][0] * v[rr][j][0] + v[rr][j][1] * v[rr][j][1]) + (v[rr][j][2] * v[rr][j][2] + v[rr][j][3] * v[rr][j][3]); }
            const float rstd = 1.f / sqrtf(wave_sum(q) * (1.f / D) + LN_EPS);
#pragma unroll
            for (int j = 0; j < 8; ++j) { const int c = 4 * lane + 256 * j;
                const f32x4 hv = v[rr][j] * rstd * *(const f32x4*)(g + c) + *(const f32x4*)(bb + c);
                *(f32x4*)(H1 + (size_t)(row0 + rr) * D + c) = hv;
                const f32x4 u = hv * (*(const f32x4*)(ada + 4 * D + c) + 1.f) + *(const f32x4*)(ada + 3 * D + c);
                u32x2 w; w.x = pk2(u[0], u[1]); w.y = pk2(u[2], u[3]); *(u32x2*)(U2 + (size_t)(row0 + rr) * D + c) = w;
                v[rr][j] = u; } }
        float a[32];
#pragma unroll
        for (int e = 0; e < NE; ++e) { float a0 = 0.f, a1 = 0.f;
#pragma unroll
            for (int j = 0; j < 8; ++j) { const f32x4 r4 = *(const LAS f32x4*)(rt + e * D + 4 * lane + 256 * j);
                a0 += (v[0][j][0] * r4[0] + v[0][j][1] * r4[1]) + (v[0][j][2] * r4[2] + v[0][j][3] * r4[3]);
                a1 += (v[1][j][0] * r4[0] + v[1][j][1] * r4[1]) + (v[1][j][2] * r4[2] + v[1][j][3] * r4[3]); }
            a[e] = a0; a[16 + e] = a1; __builtin_amdgcn_sched_barrier(0); }
#pragma unroll
        for (int i = 0; i < 16; ++i) { const bool up = (lane & 32) != 0; const float snd = up ? a[i] : a[i + 16], kp = up ? a[i + 16] : a[i]; a[i] = kp + __shfl_xor(snd, 32); }
#pragma unroll
        for (int i = 0; i < 8; ++i) { const bool up = (lane & 16) != 0; const float snd = up ? a[i] : a[i + 8], kp = up ? a[i + 8] : a[i]; a[i] = kp + __shfl_xor(snd, 16); }
#pragma unroll
        for (int i = 0; i < 4; ++i) { const bool up = (lane & 8) != 0; const float snd = up ? a[i] : a[i + 4], kp = up ? a[i + 4] : a[i]; a[i] = kp + __shfl_xor(snd, 8); }
#pragma unroll
        for (int i = 0; i < 2; ++i) { const bool up = (lane & 4) != 0; const float snd = up ? a[i] : a[i + 2], kp = up ? a[i + 2] : a[i]; a[i] = kp + __shfl_xor(snd, 4); }
        { const bool up = (lane & 2) != 0; const float snd = up ? a[0] : a[1], kp = up ? a[1] : a[0]; a[0] = kp + __shfl_xor(snd, 2); }
        float lg = a[0] + __shfl_xor(a[0], 1);
        float mx = lg;
#pragma unroll
        for (int o = 2; o < 32; o <<= 1) mx = fmaxf(mx, __shfl_xor(mx, o));
        const float ex = expf(lg - mx); float den = ex;
#pragma unroll
        for (int o = 2; o < 32; o <<= 1) den += __shfl_xor(den, o);
        if ((lane & 1) == 0) { const int rr = lane >> 5, e = (lane >> 1) & 15, t = (row0 + rr) & 2047; AFF[(size_t)(b * NE + e) * SEQ + t] = ex / den; }
    }
}
__device__ __forceinline__ void topk_phase(LAS unsigned char* lds, const Args& A, int vcu, int G) {
    const int tid = tid_opaque(), wave = __builtin_amdgcn_readfirstlane(tid >> 6), lane = tid & 63;
    LAS unsigned long long* keys = (LAS unsigned long long*)lds;
    const float* AFF = (const float*)(kws() + WS_AFF); int* IDX = (int*)(kws() + WS_IDX); float* GATE = (float*)(kws() + WS_GATE); int* INV = (int*)(kws() + WS_INV);
    for (int unit = vcu; unit < NRT; unit += G) {
        const int e = unit >> 2, b = unit & 3;
        for (int i = tid; i < SEQ; i += NTHR) keys[i] = ((unsigned long long)__builtin_bit_cast(unsigned, AFF[(size_t)(b * NE + e) * SEQ + i]) << 32) | (unsigned)(2047 - i);
        __syncthreads();
        for (int k = 2; k <= SEQ; k <<= 1)
            for (int j = k >> 1; j > 0; j >>= 1) {
                for (int i = tid; i < SEQ; i += NTHR) { const int x = i ^ j; if (x > i) { const unsigned long long a = keys[i], c = keys[x]; const bool asc = (i & k) == 0;
                    if ((a > c) == asc) { keys[i] = c; keys[x] = a; } } }
                __syncthreads(); }
        for (int p = tid; p < SEQ; p += NTHR) { const unsigned long long kk = keys[p]; const int idx = 2047 - (int)(unsigned)(kk & 0xffffffffu), slot = 2047 - p;
            INV[(size_t)(b * SEQ + idx) * NE + e] = slot < CAP ? slot : -1;
            if (slot < CAP) { IDX[unit * CAP + slot] = idx; GATE[unit * CAP + slot] = __builtin_bit_cast(float, (unsigned)(kk >> 32)); } }
        __syncthreads();
    }
}
__device__ __forceinline__ void ln2_phase(int l, int vcu, int G) {
    const int tid = tid_opaque(), lane = tid & 63, gw = vcu * NWAVES + __builtin_amdgcn_readfirstlane(tid >> 6), NGW = G * NWAVES;
    unsigned char* ws = kws();
    const float* H1 = (const float*)(ws + WS_H1); const bf16* YE = (const bf16*)(ws + WS_YE); const int* INV = (const int*)(ws + WS_INV);
    float* out = l == 0 ? (float*)(ws + WS_H2) : kout(); bf16* U = (bf16*)(ws + WS_UALL);
    const float* g = kin(I_LN2G) + l * D; const float* bb = kin(I_LN2B) + l * D; const float* ADA = (const float*)(ws + WS_ADA);
    int inv_n = (gw < MLAT && lane < NE) ? INV[(size_t)gw * NE + lane] : -1;
    for (int row = gw; row < MLAT; row += NGW) {
        const int b = row >> 11; const int inv = inv_n;
        if (row + NGW < MLAT && lane < NE) inv_n = INV[(size_t)(row + NGW) * NE + lane];
        const float* ada = ADA + (size_t)(l * 5 + b) * 6 * D;
        f32x4 v[8];
#pragma unroll
        for (int j = 0; j < 8; ++j) v[j] = *(const f32x4*)(H1 + (size_t)row * D + 4 * lane + 256 * j);
        f32x4 m[8];
#pragma unroll
        for (int j = 0; j < 8; ++j) m[j] = (f32x4){0.f, 0.f, 0.f, 0.f};
        unsigned mask = (unsigned)__builtin_amdgcn_ballot_w64(inv >= 0) & 0xffffu;
        while (mask) {
            const int e0 = __builtin_ctz(mask); mask &= mask - 1; const bool two = mask != 0u; const int e1 = two ? __builtin_ctz(mask) : e0; if (two) mask &= mask - 1;
            const int s0 = __builtin_amdgcn_readlane(inv, e0), s1 = __builtin_amdgcn_readlane(inv, e1);
            const bf16* y0 = YE + (size_t)((e0 * 4 + b) * CAP + s0) * D + 4 * lane; const bf16* y1 = YE + (size_t)((e1 * 4 + b) * CAP + s1) * D + 4 * lane;
            u32x2 w0[8], w1[8];
#pragma unroll
            for (int j = 0; j < 8; ++j) { w0[j] = *(const u32x2*)(y0 + 256 * j); w1[j] = *(const u32x2*)(y1 + 256 * j); }
            const float f1 = two ? 1.f : 0.f;
#pragma unroll
            for (int j = 0; j < 8; ++j) { m[j][0] += bflo(w0[j].x) + f1 * bflo(w1[j].x); m[j][1] += bfhi(w0[j].x) + f1 * bfhi(w1[j].x); m[j][2] += bflo(w0[j].y) + f1 * bflo(w1[j].y); m[j][3] += bfhi(w0[j].y) + f1 * bfhi(w1[j].y); }
        }
        float s = 0.f;
#pragma unroll
        for (int j = 0; j < 8; ++j) { const int c = 4 * lane + 256 * j; v[j] = v[j] * DN_ALPHA + *(const f32x4*)(ada + 5 * D + c) * m[j]; s += (v[j][0] + v[j][1]) + (v[j][2] + v[j][3]); }
        const float mean = wave_sum(s) * (1.f / D); float q = 0.f;
#pragma unroll
        for (int j = 0; j < 8; ++j) { v[j] = v[j] - mean; q += (v[j][0] * v[j][0] + v[j][1] * v[j][1]) + (v[j][2] * v[j][2] + v[j][3] * v[j][3]); }
        const float rstd = 1.f / sqrtf(wave_sum(q) * (1.f / D) + LN_EPS);
        const float* ada1 = ADA + (size_t)(5 + b) * 6 * D;
#pragma unroll
        for (int j = 0; j < 8; ++j) { const int c = 4 * lane + 256 * j;
            const f32x4 hv = v[j] * rstd * *(const f32x4*)(g + c) + *(const f32x4*)(bb + c);
            *(f32x4*)(out + (size_t)row * D + c) = hv;
            if (l == 0) { const f32x4 u = hv * (*(const f32x4*)(ada1 + D + c) + 1.f) + *(const f32x4*)(ada1 + c); u32x2 w; w.x = pk2(u[0], u[1]); w.y = pk2(u[2], u[3]); *(u32x2*)(U + (size_t)row * D + c) = w; } }
    }
}

__global__ void __launch_bounds__(NTHR, 2) mk_fwd(Args A) {
    extern __shared__ __attribute__((aligned(16))) unsigned char lds_raw[];
    LAS unsigned char* lds = (LAS unsigned char*)lds_raw;
    volatile LAS unsigned* MISC = (volatile LAS unsigned*)(lds + LDS_MISC);
    const int G = gridDim.x; const int bx = blockIdx.x; const int vcu = (G % 8 == 0) ? (bx % 8) * (G / 8) + bx / 8 : bx;
    if (threadIdx.x < 16) MISC[threadIdx.x] = 0u;
    __syncthreads();
#if MK_LAUNCH_PER_PHASE
#define GRID_BAR() do { } while (0)
#else
    XcdBarrier bar = xcd_barrier_post((unsigned*)(kws() + WS_CTL) + 4096, MISC + 8);
#define GRID_BAR() xcd_barrier(bar)
#endif
    const int lo = A.ph_lo, hi = A.ph_hi;
#ifndef PH_MASK
#define PH_MASK 0xFFFFFFFFu
#endif
#define IN(k) ((((PH_MASK) >> (k)) & 1u) && lo <= (k) && (k) < hi)
#define SEAM(k) do { if ((k) + 1 < hi) GRID_BAR(); } while (0)
#ifndef PROBE_DUP
#define PROBE_DUP 0u
#endif
#define REP(k) for (int rep_ = 0; rep_ < (int)(((PROBE_DUP) >> (k)) & 1u) + 1; ++rep_)

    #ifndef PX_PARTS
#define PX_PARTS 3
#endif
#ifndef P0_PARTS
#define P0_PARTS 7
#endif
    if (IN(0)) REP(0) { if (P0_PARTS & 1) ada_phase(lds, A, vcu, G); if (P0_PARTS & 2) filt_phase(lds, A, vcu, G); if (P0_PARTS & 4) convert_phase(lds, A, vcu, G); SEAM(0); }

    {

            if (IN(1)) REP(1) { modulate_phase(A, vcu, G); SEAM(1); }
            if (IN(2)) REP(2) { ProbPlain P{2048, 2048, 2048, 36 * 21, (const bf16*)(kws() + WS_UALL), (const bf16*)(kws() + WS_WAB), (bf16*)(kws() + WS_P), IN_AB_PAD, 36, 21};
                pg8::gemm_phase(lds, P, vcu, G); SEAM(2); }
            if (IN(3)) REP(3) { postproj_phase(A, vcu, G); SEAM(3); }
            if (IN(4)) REP(4) { ProbPlain P{512, 512, 512, 36 * 8, (const bf16*)(kws() + WS_CKVN), (const bf16*)(kws() + WS_WUKV), (bf16*)(kws() + WS_KV), D, 36, 8};
                pg8::gemm_phase(lds, P, vcu, G); SEAM(4); }
            if (IN(5)) REP(5) { const att::Tensors T{(const bf16*)(kws() + WS_P), (const bf16*)(kws() + WS_KV), (const bf16*)(kws() + WS_KPE), kin(I_RPB), (bf16*)(kws() + WS_CAT)};
                for (int u = vcu; u < 256; u += G) att::attn_unit<0>(lds, T, u);
                for (int u = vcu; u < 256; u += G) att::attn_unit<1>(lds, T, u);
                SEAM(5); }
    }
#define COMMON_PHASES(l, cb) \
        if (IN(cb)) REP(cb) { ProbOut P{2048, 2048, 2048, 256, (const bf16*)(kws() + WS_CAT), (const bf16*)(kws() + (l == 0 ? WS_WABO : WS_WCDO)), l == 0 ? kin(I_X) : (const float*)(kws() + WS_H2), \
                               (const float*)(kws() + WS_ADA) + (size_t)l * 5 * 6 * D + 2 * D, (float*)(kws() + WS_PRE)}; \
            pg8::gemm_phase(lds, P, vcu, G); SEAM(cb); } \
        if (IN(cb + 1)) REP(cb + 1) { ln1_phase(lds, l, vcu, G); SEAM(cb + 1); } \
        if (IN(cb + 2)) REP(cb + 2) { topk_phase(lds, A, vcu, G); SEAM(cb + 2); } \
        if (IN(cb + 3)) REP(cb + 3) { ProbMoe1 P{2048, 2048, 2048, 704, (const bf16*)(kws() + WS_U2), (const int*)(kws() + WS_IDX), (const bf16*)(kws() + WS_W13) + (size_t)l * 16 * (2 * FF * D), (bf16*)(kws() + WS_HDN)}; \
            pg8::gemm_phase(lds, P, vcu, G); SEAM(cb + 3); } \
        if (IN(cb + 4)) REP(cb + 4) { ProbMoe2 P{FF, FF, FF, 512, (const bf16*)(kws() + WS_HDN), (const bf16*)(kws() + WS_W2) + (size_t)l * 16 * (D * FF), (const float*)(kws() + WS_GATE), (bf16*)(kws() + WS_YE)}; \
            pg8::gemm_phase(lds, P, vcu, G); SEAM(cb + 4); } \
        if (IN(cb + 5)) REP(cb + 5) { ln2_phase(l, vcu, G); SEAM(cb + 5); }
    COMMON_PHASES(0, 6)
    {

            if (IN(12)) REP(12) { ProbPlain P{2048, 2048, 2048, 32 * 16, (const bf16*)(kws() + WS_UALL), (const bf16*)(kws() + WS_WCD), (bf16*)(kws() + WS_P), IN_CD, 32, 16};
                pg8::gemm_phase(lds, P, vcu, G); SEAM(12); }
            if (IN(13)) REP(13) {
                if (PX_PARTS & 1) { const int tid = tid_opaque(), lane = tid & 63, wave = __builtin_amdgcn_readfirstlane(tid >> 6);
                    for (int it = vcu * NWAVES + wave; it < NB * 32 * 48; it += G * NWAVES) prep_item(lds + wave * 9600, (const bf16*)(kws() + WS_P), kin(I_CONVW), kin(I_CONVB), (bf16*)(kws() + WS_ST), it, lane); }
                __syncthreads();
                ProbF1 P{256, 256, IN_CD, 256, (const bf16*)(kws() + WS_CS256), (const bf16*)(kws() + WS_P), (bf16*)(kws() + WS_T1)};
                if (PX_PARTS & 2) pg8::gemm_phase(lds, P, vcu, G); SEAM(13); }
            if (IN(14)) REP(14) {
                if ((PX_PARTS & 1) && vcu < 128) { ProbF2 P{4096, 4096, 4096, 128, (const bf16*)(kws() + WS_CSL), (const bf16*)(kws() + WS_T1), (bf16*)(kws() + WS_CAT)}; pg8::gemm_phase(lds, P, vcu, 128); }
                { const int hs = G > 128 ? G - 128 : G, h0 = G > 128 ? vcu - 128 : vcu;
                  if ((PX_PARTS & 2) && h0 >= 0) for (int u = h0; u < 256; u += hs) hy::hyena_unit(lds, (const bf16*)(kws() + WS_ST), (const bf16*)(kws() + WS_HR), kin(I_SKIP), (bf16*)(kws() + WS_CAT), u); }
                SEAM(14); }
    }
    COMMON_PHASES(1, 15)
#undef COMMON_PHASES
#undef IN
#undef SEAM
}

extern "C" void kernel_launch(void* const* d_in, const int* in_sizes, int n_in, void* d_out, int out_size, void* d_ws, size_t ws_size, hipStream_t stream) {
    static int grid = 0;
    if (grid == 0) {
        if (n_in != 31 || out_size != MLAT * D || ws_size < WS_END) { fprintf(stderr, "kernel_launch: unexpected shapes (n_in %d, out %d, ws %zu < %zu)\n", n_in, out_size, ws_size, (size_t)WS_END); grid = -1; return; }
        int dev = 0, cus = 0, per_cu = 0;
        if (hipGetDevice(&dev) != hipSuccess || hipDeviceGetAttribute(&cus, hipDeviceAttributeMultiprocessorCount, dev) != hipSuccess) { grid = -1; return; }
        if (hipFuncSetAttribute((const void*)mk_fwd, hipFuncAttributeMaxDynamicSharedMemorySize, LDS_BYTES) != hipSuccess) { fprintf(stderr, "kernel_launch: hipFuncSetAttribute failed\n"); grid = -1; return; }
        if (hipOccupancyMaxActiveBlocksPerMultiprocessor(&per_cu, (const void*)mk_fwd, NTHR, LDS_BYTES) != hipSuccess || per_cu < 1) { fprintf(stderr, "kernel_launch: occupancy query says %d\n", per_cu); }
        (void)hipGetLastError();
        grid = cus;
    }
    if (grid < 0) return;
    (void)hipMemsetAsync((char*)d_ws + WS_CTL, 0, CTL_ZERO_BYTES, stream);
    Args a{};
    for (int i = 0; i < 31; ++i) a.in[i] = (const float*)d_in[i];
    a.out = (float*)d_out; a.ws = (unsigned char*)d_ws;
#if MK_LAUNCH_PER_PHASE
    for (int ph = 0; ph < NPHASE; ++ph) { a.ph_lo = ph; a.ph_hi = ph + 1; hipLaunchKernelGGL(mk_fwd, dim3(grid), dim3(NTHR), LDS_BYTES, stream, a); }
#else
    a.ph_lo = 0; a.ph_hi = NPHASE;
    hipLaunchKernelGGL(mk_fwd, dim3(grid), dim3(NTHR), LDS_BYTES, stream, a);
#endif
}
```

```cpp
#include <hip/hip_runtime.h>
#include <cstdio>
#include <cstdint>

#ifndef MK_LAUNCH_PER_PHASE
#define MK_LAUNCH_PER_PHASE 0
#endif

#define GAS __attribute__((address_space(1)))
#define LAS __attribute__((address_space(3)))
typedef unsigned short bf16;
typedef short bf16x8 __attribute__((ext_vector_type(8)));
typedef short s16x4 __attribute__((ext_vector_type(4)));
typedef float f32x4 __attribute__((ext_vector_type(4)));
typedef float f32x2 __attribute__((ext_vector_type(2)));
typedef float f32x16 __attribute__((ext_vector_type(16)));
typedef unsigned u32x4 __attribute__((ext_vector_type(4)));
typedef unsigned u32x2 __attribute__((ext_vector_type(2)));
#define RLX_AGENT __ATOMIC_RELAXED, __HIP_MEMORY_SCOPE_AGENT
#define LDS_WAIT() asm volatile("s_waitcnt lgkmcnt(0)" ::: "memory")
#define VM_WAIT() asm volatile("s_waitcnt vmcnt(0)" ::: "memory")

constexpr int D = 2048, NB = 4, SEQ = 2048, LC = 256, GW = 64;
constexpr int MLAT = NB * SEQ, MCTX = NB * LC, MALL = MLAT + MCTX;
constexpr int IN_AB = 5184, IN_AB_PAD = 5376;
constexpr int OFF_CKV = 1536, OFF_KPE = 2048, OFF_QNA = 2112, OFF_KNA = 3136, OFF_VNA = 4160;
constexpr int KVR = 512, NH = 8;
constexpr int FF = 1408, NE = 16, CAP = 256, NRT = NE * NB;
constexpr int IN_CD = 4096, HYW = 1024, HY3 = 3072;
constexpr float LN_EPS = 1e-6f;
constexpr float DN_ALPHA = 1.41421356237f;
constexpr int NWAVES = 8, NTHR = 512;

constexpr size_t MiB = 1u << 20;
constexpr size_t WS_CTL = 0, CTL_ZERO_BYTES = 1 * MiB;
constexpr size_t WS_ADA = 1 * MiB;
constexpr size_t WS_AFF = 2 * MiB;
constexpr size_t WS_IDX = 3 * MiB;
constexpr size_t WS_GATE = WS_IDX + 64 * 1024;
constexpr size_t WS_INV = 4 * MiB;
constexpr size_t WS_CS256 = 5 * MiB;
constexpr size_t WS_DBG = 6 * MiB;
constexpr size_t WS_WAB = 8 * MiB;
constexpr size_t WS_WUKV = 30 * MiB;
constexpr size_t WS_WABO = 32 * MiB;
constexpr size_t WS_WCD = 40 * MiB;
constexpr size_t WS_WCDO = 56 * MiB;
constexpr size_t WS_CSL = 64 * MiB;
constexpr size_t WS_HR = 80 * MiB;
constexpr size_t W13_E = (size_t)2 * FF * D * 2;
constexpr size_t W2_E = (size_t)D * FF * 2;
constexpr size_t WS_W13 = 96 * MiB;
constexpr size_t WS_W2 = WS_W13 + 32 * W13_E;
constexpr size_t WS_UALL = WS_W2 + 32 * W2_E;
constexpr size_t WS_P = WS_UALL + (size_t)MALL * D * 2;
constexpr size_t WS_CKVN = WS_P + (size_t)MALL * IN_AB_PAD * 2;
constexpr size_t WS_KPE = WS_CKVN + (size_t)MALL * KVR * 2;
constexpr size_t WS_KV = WS_KPE + (size_t)MALL * 64 * 2;
constexpr size_t WS_ST = WS_KV;
constexpr size_t WS_CAT = WS_KV + (size_t)NB * HY3 * SEQ * 2;
constexpr size_t WS_PRE = WS_CAT + (size_t)MLAT * D * 2;
constexpr size_t WS_H1 = WS_PRE + (size_t)MLAT * D * 4;
constexpr size_t WS_H2 = WS_H1 + (size_t)MLAT * D * 4;
constexpr size_t WS_U2 = WS_H2 + (size_t)MLAT * D * 4;
constexpr size_t WS_XE = WS_U2 + (size_t)MLAT * D * 2;
constexpr size_t WS_HDN = WS_XE + (size_t)NRT * CAP * D * 2;
constexpr size_t WS_YE = WS_HDN + (size_t)NRT * CAP * FF * 2;
constexpr size_t WS_T1 = WS_YE + (size_t)NRT * CAP * D * 2;
constexpr size_t WS_END = WS_T1 + (size_t)16 * 256 * 2 * 2048 * 2;
static_assert(WS_WAB + (size_t)IN_AB_PAD * D * 2 <= WS_WUKV && WS_HR + (size_t)2 * 1024 * 4096 * 2 <= WS_W13, "ws map");
static_assert(WS_END < (size_t)1400 * MiB, "ws map too large");

constexpr int LDS_MAIN = 151552;
constexpr int LDS_MISC = LDS_MAIN;
constexpr int LDS_BYTES = LDS_MAIN + 64;

__device__ __forceinline__ unsigned f2bf(float f) { unsigned u = __builtin_bit_cast(unsigned, f); return (u + 0x7fffu + ((u >> 16) & 1u)) >> 16; }
__device__ __forceinline__ unsigned pk2(float lo, float hi) { return f2bf(lo) | (f2bf(hi) << 16); }
__device__ __forceinline__ float bf2f(unsigned b) { return __builtin_bit_cast(float, b << 16); }
__device__ __forceinline__ float bflo(unsigned w) { return __builtin_bit_cast(float, w << 16); }
__device__ __forceinline__ float bfhi(unsigned w) { return __builtin_bit_cast(float, w & 0xffff0000u); }
__device__ __forceinline__ unsigned cvt_pk_bf16(float lo, float hi) { unsigned r; asm volatile("v_cvt_pk_bf16_f32 %0, %1, %2" : "=v"(r) : "v"(lo), "v"(hi)); return r; }
__device__ __forceinline__ float wave_sum(float v) {
#pragma unroll
    for (int o = 1; o < 64; o <<= 1) v += __shfl_xor(v, o);
    return v;
}
__device__ __forceinline__ int tid_opaque() { int t = threadIdx.x; asm volatile("" : "+v"(t)); return t; }
__device__ __forceinline__ float silu_f(float x) { return x / (1.f + __expf(-x)); }

#define XB_TMO      128
#define XB_XCNT(j)  (256  + 64 * (j))
#define XB_XSUB(j)  (1280 + 64 * (j))
#define XB_XGEN(j)  (2304 + 64 * (j))
#define XB_TOP      3328
#define XB_TOPGEN   3392
#define XCD_BAR_WORDS 3456
#define XB_SPIN_CAP (1u << 18)
__device__ __forceinline__ unsigned xb_ld(unsigned* p)              { return __hip_atomic_load(p, __ATOMIC_RELAXED, __HIP_MEMORY_SCOPE_AGENT); }
__device__ __forceinline__ unsigned xb_add(unsigned* p, unsigned v) { return __hip_atomic_fetch_add(p, v, __ATOMIC_RELAXED, __HIP_MEMORY_SCOPE_AGENT); }
__device__ __forceinline__ unsigned xb_xcc_id() { return (unsigned)__builtin_amdgcn_s_getreg((3 << 11) | 20) & 0xFu; }
#define XB_SPIN(cond, bar) do { unsigned _sp = 0; while (cond) { __builtin_amdgcn_s_sleep(1); \
    if ((++_sp & 255u) == 0u) { if (xb_ld(&(bar)[XB_TMO])) break; if (_sp > XB_SPIN_CAP) { atomicAdd(&(bar)[XB_TMO], 1u); break; } } } } while (0)
struct XcdBarrier { unsigned* bar; unsigned x; volatile LAS unsigned* st; };
__device__ __forceinline__ XcdBarrier xcd_barrier_post(unsigned* bar, volatile LAS unsigned* st) {
    XcdBarrier b; b.bar = bar; b.x = xb_xcc_id(); b.st = st;
    if (threadIdx.x == 0) (void)xb_add(&bar[XB_XCNT(b.x)], 1u);
    return b;
}
__device__ __forceinline__ void xcd_barrier_complete(unsigned* bar, unsigned x, unsigned& nloc, unsigned& nx) {
    const unsigned G = gridDim.x * gridDim.y * gridDim.z;
    unsigned sum, cnt, mine, sp = 0u;
    for (;;) {
        sum = 0u; cnt = 0u; mine = 0u;
#pragma unroll
        for (unsigned j = 0; j < 16; ++j) { const unsigned c = xb_ld(&bar[XB_XCNT(j)]); sum += c; cnt += (c > 0u) ? 1u : 0u; mine = (j == x) ? c : mine; }
        if (sum == G) break;
        __builtin_amdgcn_s_sleep(1);
        if ((++sp & 255u) == 0u) { if (xb_ld(&bar[XB_TMO])) break; if (sp > XB_SPIN_CAP) { atomicAdd(&bar[XB_TMO], 1u); break; } }
    }
    nloc = mine > 0u ? mine : 1u; nx = cnt > 0u ? cnt : 1u;
}
__device__ __forceinline__ void xcd_barrier(const XcdBarrier& b) {
    asm volatile("s_waitcnt vmcnt(0)" ::: "memory");
    __syncthreads();
    if (threadIdx.x == 0) {
        unsigned* bar = b.bar;
        __builtin_amdgcn_s_waitcnt(0);
        unsigned nloc = b.st[0], nx = b.st[1];
        if (nloc == 0u) { xcd_barrier_complete(bar, b.x, nloc, nx); b.st[0] = nloc; b.st[1] = nx; }
        const unsigned old = xb_add(&bar[XB_XSUB(b.x)], 1u);
        const unsigned gen = old / nloc;
        if (old + 1u == (gen + 1u) * nloc) {
            __builtin_amdgcn_fence(__ATOMIC_RELEASE, "agent");
            asm volatile("s_waitcnt vmcnt(0)" ::: "memory");
            const unsigned og = xb_add(&bar[XB_TOP], 1u);
            const unsigned tg = og / nx;
            if (og + 1u == (tg + 1u) * nx) xb_add(&bar[XB_TOPGEN], 1u);
            else XB_SPIN(xb_ld(&bar[XB_TOPGEN]) == tg, bar);
            __builtin_amdgcn_fence(__ATOMIC_ACQUIRE, "agent");
            xb_add(&bar[XB_XGEN(b.x)], 1u);
            asm volatile("s_waitcnt vmcnt(0)" ::: "memory");
        } else {
            XB_SPIN(xb_ld(&bar[XB_XGEN(b.x)]) == gen, bar);
            __builtin_amdgcn_fence(__ATOMIC_ACQUIRE, "agent");
            asm volatile("s_waitcnt vmcnt(0)" ::: "memory");
        }
    }
    __syncthreads();
}

namespace pg8 {
constexpr int BM = 256, BK = 64, HALF = 128, HTB = HALF * BK * 2, STAGE_BYTES = 8 * HTB;
__host__ __device__ __forceinline__ int lds_byte(int r, int c) { const int st = (r >> 4) * 2 + (c >> 5), rr = r & 15, cc = c & 31, ob = rr * 64 + cc * 2; return st * 1024 + (ob ^ (((ob >> 9) & 1) << 5)); }
__host__ __device__ __forceinline__ void stage_rc(int b, int& R, int& C) { const int st = b / 1024, sb = b % 1024, swz = sb ^ (((sb >> 9) & 1) << 5); R = (st >> 1) * 16 + swz / 64; C = (st & 1) * 32 + (swz % 64) / 2; }
__host__ __device__ __forceinline__ int perm32(int rho) { const int n = rho >> 4, i = rho & 15; return 8 * (i >> 2) + 4 * n + (i & 3); }

template <class Prob>
__device__ __forceinline__ void gemm_phase(LAS unsigned char* lds, const Prob& P, int u0, int ustride) {
    const int tid = tid_opaque(), wid = __builtin_amdgcn_readfirstlane(tid >> 6), lane = tid & 63, wr = wid >> 2, wc = wid & 3, fr = lane & 15, fq = lane >> 4;
    const int K = P.K, nt = K / BK;
    unsigned voffA[2], voffB[2];
#pragma unroll
    for (int i = 0; i < 2; ++i) { int R, C; stage_rc(tid * 16 + i * 8192, R, C); const int Rb = Prob::PERM ? ((R & ~31) + perm32(R & 31)) : R;
        voffA[i] = (unsigned)(R * P.lda + C) * 2u; voffB[i] = (unsigned)(Rb * P.ldb + C) * 2u; }
    const size_t kstep = (size_t)(BK * 2);
    const size_t hstepA = Prob::GATHER ? (size_t)0 : (size_t)HALF * P.lda * 2, hstepB = (size_t)HALF * P.ldb * 2;
    unsigned gvoC[2][2], gvoN[2][2];
    const unsigned ldsw = (unsigned)wid * 1024u;
    const int aoff = lds_byte(wr * 64 + fr, fq * 8), boff = lds_byte(wc * 32 + fr, fq * 8);
#define PG8_SA(b, h) (((b) * 2 + (h)) * HTB)
#define PG8_SB(b, h) ((4 + (b) * 2 + (h)) * HTB)
#define PG8_STAGE(bufoff, gbase, voff) do { _Pragma("unroll") for (int _i = 0; _i < 2; ++_i) \
        __builtin_amdgcn_global_load_lds((const unsigned*)((const char*)(gbase) + (voff)[_i]), (LAS unsigned*)(lds + (bufoff) + ldsw + _i * 8192), 16, 0, 0); } while (0)
#define PG8_STAGEA(bufoff, gbase, h, NX) do { if constexpr (Prob::GATHER) { if (NX) PG8_STAGE(bufoff, gbase, gvoN[h]); else PG8_STAGE(bufoff, gbase, gvoC[h]); } else PG8_STAGE(bufoff, (gbase) + (h) * hstepA, voffA); } while (0)
#define PG8_LDA(dst, b, h) do { _Pragma("unroll") for (int m = 0; m < 4; ++m) _Pragma("unroll") for (int k = 0; k < 2; ++k) dst[m][k] = *(const LAS bf16x8*)(lds + PG8_SA(b, h) + aoff + m * 2048 + k * 1024); } while (0)
#define PG8_LDB(dst, b, h) do { _Pragma("unroll") for (int n = 0; n < 2; ++n) _Pragma("unroll") for (int k = 0; k < 2; ++k) dst[n][k] = *(const LAS bf16x8*)(lds + PG8_SB(b, h) + boff + n * 2048 + k * 1024); } while (0)
#define PG8_MMA(ai, bj, At, Bt) do { __builtin_amdgcn_s_setprio(1); _Pragma("unroll") for (int m = 0; m < 4; ++m) _Pragma("unroll") for (int n = 0; n < 2; ++n) _Pragma("unroll") for (int k = 0; k < 2; ++k) \
        acc[ai][bj][m][n] = __builtin_amdgcn_mfma_f32_16x16x32_bf16(Bt[n][k], At[m][k], acc[ai][bj][m][n], 0, 0, 0); __builtin_amdgcn_s_setprio(0); } while (0)
#define PG8_WAIT_V(n) asm volatile("s_waitcnt vmcnt(" #n ")" ::: "memory")
#define PG8_WAIT_L(n) asm volatile("s_waitcnt lgkmcnt(" #n ")" ::: "memory")
#define PG8_BAR __builtin_amdgcn_s_barrier()
#define PG8_SCHED __builtin_amdgcn_sched_barrier(0)
    int u = u0;
    if (u >= P.nunits) return;
    f32x4 acc[2][2][4][2];
#pragma unroll
    for (int a = 0; a < 2; ++a)
#pragma unroll
        for (int b = 0; b < 2; ++b)
#pragma unroll
            for (int m = 0; m < 4; ++m)
#pragma unroll
                for (int n = 0; n < 2; ++n) acc[a][b][m][n] = (f32x4){0.f, 0.f, 0.f, 0.f};
    bf16x8 At[4][2], B0[2][2], B1[2][2];
    const char* cA; const char* cB; P.locate(u, cA, cB);
    if constexpr (Prob::GATHER) { P.aoffs(u, tid, gvoC);
#pragma unroll
        for (int h = 0; h < 2; ++h)
#pragma unroll
            for (int i = 0; i < 2; ++i) gvoN[h][i] = gvoC[h][i]; }
    PG8_STAGE(PG8_SB(0, 0), cB, voffB); PG8_STAGE(PG8_SB(0, 1), cB + hstepB, voffB); PG8_STAGEA(PG8_SA(0, 0), cA, 0, false); PG8_STAGEA(PG8_SA(0, 1), cA, 1, false);
    if (wr == 1) PG8_BAR;
    PG8_WAIT_V(2); PG8_BAR;
    PG8_STAGE(PG8_SB(1, 0), cB + kstep, voffB); PG8_STAGEA(PG8_SA(1, 0), cA + kstep, 0, false); PG8_STAGE(PG8_SB(1, 1), cB + hstepB + kstep, voffB);
    PG8_WAIT_V(6); PG8_BAR;
    for (;;) {
        const int un = u + ustride; const bool has_next = un < P.nunits;
        const char* nA = cA; const char* nB = cB; if (has_next) P.locate(un, nA, nB);
        if constexpr (Prob::GATHER) { if (has_next) P.aoffs(un, tid, gvoN); }
        for (int t = 0; t < nt; t += 2) {
            const bool last = (t == nt - 2);
            const char* a1 = cA + (size_t)(t + 1) * kstep;
            const char* a2 = last ? nA : cA + (size_t)(t + 2) * kstep; const char* b2 = last ? nB : cB + (size_t)(t + 2) * kstep;
            const char* a3 = a2 + kstep; const char* b3 = b2 + kstep;
            PG8_LDB(B0, 0, 0); PG8_LDB(B1, 0, 1); PG8_SCHED; PG8_LDA(At, 0, 0); PG8_STAGEA(PG8_SA(1, 1), a1, 1, false);
            PG8_WAIT_V(8); PG8_WAIT_L(0); PG8_BAR; PG8_MMA(0, 0, At, B0); PG8_MMA(0, 1, At, B1); PG8_BAR; PG8_SCHED;
            PG8_LDA(At, 0, 1); PG8_STAGE(PG8_SB(0, 0), b2, voffB); PG8_STAGE(PG8_SB(0, 1), b2 + hstepB, voffB); PG8_STAGEA(PG8_SA(0, 0), a2, 0, last);
            PG8_WAIT_V(8); PG8_WAIT_L(0); PG8_BAR; PG8_MMA(1, 0, At, B0); PG8_MMA(1, 1, At, B1); PG8_BAR; PG8_SCHED;
            PG8_LDB(B0, 1, 0); PG8_LDB(B1, 1, 1); PG8_SCHED; PG8_LDA(At, 1, 0); PG8_STAGEA(PG8_SA(0, 1), a2, 1, last);
            PG8_WAIT_V(8); PG8_WAIT_L(0); PG8_BAR; PG8_MMA(0, 0, At, B0); PG8_MMA(0, 1, At, B1); PG8_BAR; PG8_SCHED;
            PG8_LDA(At, 1, 1); PG8_STAGE(PG8_SB(1, 0), b3, voffB); PG8_STAGE(PG8_SB(1, 1), b3 + hstepB, voffB); PG8_STAGEA(PG8_SA(1, 0), a3, 0, last);
            PG8_WAIT_V(8); PG8_WAIT_L(0); PG8_BAR; PG8_MMA(1, 0, At, B0); PG8_MMA(1, 1, At, B1); PG8_BAR; PG8_SCHED;
        }
        if (wr == 0) PG8_BAR;
        P.epi(acc, u, wr, wc, fr, fq);
        if (!has_next) break;
#pragma unroll
        for (int a = 0; a < 2; ++a)
#pragma unroll
            for (int b = 0; b < 2; ++b)
#pragma unroll
                for (int m = 0; m < 4; ++m)
#pragma unroll
                    for (int n = 0; n < 2; ++n) acc[a][b][m][n] = (f32x4){0.f, 0.f, 0.f, 0.f};
        u = un; cA = nA; cB = nB;
        if constexpr (Prob::GATHER) {
#pragma unroll
            for (int h = 0; h < 2; ++h)
#pragma unroll
                for (int i = 0; i < 2; ++i) gvoC[h][i] = gvoN[h][i]; }
        if (wr == 1) PG8_BAR;
    }
    PG8_WAIT_V(0);
    PG8_BAR;
#undef PG8_SA
#undef PG8_SB
#undef PG8_STAGE
#undef PG8_STAGEA
#undef PG8_LDA
#undef PG8_LDB
#undef PG8_MMA
#undef PG8_WAIT_V
#undef PG8_WAIT_L
#undef PG8_BAR
#undef PG8_SCHED
}
__device__ __forceinline__ void tile_of(int u, int nM, int nN, int& pm, int& pn) {
    const int nig = 8 * nN, g = u / nig, r = u % nig, fm = g * 8, gsz = (nM - fm) < 8 ? (nM - fm) : 8;
    pm = fm + r % gsz; pn = r / gsz;
}
__device__ __forceinline__ void st8(bf16* p, f32x4 v0, f32x4 v1) {
    u32x4 w; w.x = cvt_pk_bf16(v0[0], v0[1]); w.y = cvt_pk_bf16(v0[2], v0[3]); w.z = cvt_pk_bf16(v1[0], v1[1]); w.w = cvt_pk_bf16(v1[2], v1[3]);
    *(u32x4*)p = w;
}
}

typedef __bf16 bf16x2_t __attribute__((ext_vector_type(2)));
__device__ __forceinline__ unsigned cvtpk(float lo, float hi) { f32x2 v = {lo, hi}; bf16x2_t b = __builtin_convertvector(v, bf16x2_t); return __builtin_bit_cast(unsigned, b); }

struct ProbPlain {
    static constexpr bool GATHER = false; static constexpr bool PERM = true;
    int K, lda, ldb, nunits; const bf16* A; const bf16* Bt; bf16* O; int ldc, nM, nN;
    __device__ __forceinline__ void locate(int u, const char*& a, const char*& b) const { int pm, pn; pg8::tile_of(u, nM, nN, pm, pn); a = (const char*)(A + (size_t)pm * 256 * lda); b = (const char*)(Bt + (size_t)pn * 256 * ldb); }
    __device__ __forceinline__ void epi(const f32x4 (&acc)[2][2][4][2], int u, int wr, int wc, int fr, int fq) const {
        int pm, pn; pg8::tile_of(u, nM, nN, pm, pn);
        const int row0 = pm * 256 + wr * 64 + fr, col0 = pn * 256 + wc * 32 + 8 * fq;
#pragma unroll
        for (int ai = 0; ai < 2; ++ai)
#pragma unroll
            for (int m = 0; m < 4; ++m) { bf16* rowp = O + (size_t)(row0 + ai * 128 + m * 16) * ldc + col0;
#pragma unroll
                for (int bj = 0; bj < 2; ++bj) pg8::st8(rowp + bj * 128, acc[ai][bj][m][0], acc[ai][bj][m][1]); }
    }
};
struct ProbOut {
    static constexpr bool GATHER = false; static constexpr bool PERM = false;
    int K, lda, ldb, nunits; const bf16* A; const bf16* Bt; const float* h; const float* gate; float* pre;
    __device__ __forceinline__ void locate(int u, const char*& a, const char*& b) const { int pm, pn; pg8::tile_of(u, 32, 8, pm, pn); a = (const char*)(A + (size_t)pm * 256 * lda); b = (const char*)(Bt + (size_t)pn * 256 * ldb); }
    __device__ __forceinline__ void epi(const f32x4 (&acc)[2][2][4][2], int u, int wr, int wc, int fr, int fq) const {
        int pm, pn; pg8::tile_of(u, 32, 8, pm, pn);
        const int row0 = pm * 256 + wr * 64 + fr, col0 = pn * 256 + wc * 32 + 4 * fq;
        const float* g = gate + (size_t)(pm >> 3) * (6 * D);
        f32x4 gv[2][2];
#pragma unroll
        for (int bj = 0; bj < 2; ++bj)
#pragma unroll
            for (int n = 0; n < 2; ++n) gv[bj][n] = *(const f32x4*)(g + col0 + bj * 128 + n * 16);
#pragma unroll
        for (int ai = 0; ai < 2; ++ai)
#pragma unroll
            for (int m = 0; m < 4; ++m) { const size_t off = (size_t)(row0 + ai * 128 + m * 16) * D + col0;
#pragma unroll
                for (int bj = 0; bj < 2; ++bj)
#pragma unroll
                    for (int n = 0; n < 2; ++n) { const f32x4 hv = *(const f32x4*)(h + off + bj * 128 + n * 16);
                        *(f32x4*)(pre + off + bj * 128 + n * 16) = hv * DN_ALPHA + gv[bj][n] * acc[ai][bj][m][n]; } }
    }
};
struct ProbMoe1 {
    static constexpr bool GATHER = true; static constexpr bool PERM = true;
    int K, lda, ldb, nunits; const bf16* U2; const int* IDX; const bf16* W13; bf16* HDN;
    __device__ __forceinline__ void map(int u, int& rt, int& pn) const { const int b = u & 3, q = u >> 2; pn = q % 11; rt = (q / 11) * 4 + b; }
    __device__ __forceinline__ void locate(int u, const char*& a, const char*& b) const { int rt, pn; map(u, rt, pn); a = (const char*)U2; b = (const char*)(W13 + (size_t)(rt >> 2) * (2 * FF * D) + (size_t)pn * 256 * D); }
    __device__ __forceinline__ void aoffs(int u, int tid, unsigned (&vo)[2][2]) const { int rt, pn; map(u, rt, pn);
#pragma unroll
        for (int i = 0; i < 2; ++i) { int R, C; pg8::stage_rc(tid * 16 + i * 8192, R, C);
#pragma unroll
            for (int h = 0; h < 2; ++h) { const int row = (rt & 3) * SEQ + IDX[rt * CAP + h * 128 + R]; vo[h][i] = (unsigned)(row * D + C) * 2u; } } }
    __device__ __forceinline__ void epi(const f32x4 (&acc)[2][2][4][2], int u, int wr, int wc, int fr, int fq) const {
        int rt, pn; map(u, rt, pn);
        const int row0 = rt * 256 + wr * 64 + fr, col0 = pn * 128 + wc * 32 + 8 * fq;
#pragma unroll
        for (int ai = 0; ai < 2; ++ai)
#pragma unroll
            for (int m = 0; m < 4; ++m) { bf16* rowp = HDN + (size_t)(row0 + ai * 128 + m * 16) * FF + col0;
                f32x4 v[2];
#pragma unroll
                for (int n = 0; n < 2; ++n) { const f32x4 a = acc[ai][0][m][n], g = acc[ai][1][m][n];
#pragma unroll
                    for (int j = 0; j < 4; ++j) v[n][j] = a[j] / (1.f + __expf(-a[j])) * g[j]; }
                pg8::st8(rowp, v[0], v[1]); }
    }
};
struct ProbMoe2 {
    static constexpr bool GATHER = false; static constexpr bool PERM = true;
    int K, lda, ldb, nunits; const bf16* HDN; const bf16* W2; const float* gate; bf16* YE;
    __device__ __forceinline__ void map(int u, int& rt, int& pn) const { const int b = u & 3, q = u >> 2; pn = q & 7; rt = (q >> 3) * 4 + b; }
    __device__ __forceinline__ void locate(int u, const char*& a, const char*& b) const { int rt, pn; map(u, rt, pn); a = (const char*)(HDN + (size_t)rt * 256 * FF); b = (const char*)(W2 + (size_t)(rt >> 2) * (D * FF) + (size_t)pn * 256 * FF); }
    __device__ __forceinline__ void epi(const f32x4 (&acc)[2][2][4][2], int u, int wr, int wc, int fr, int fq) const {
        int rt, pn; map(u, rt, pn);
        const int row0 = rt * 256 + wr * 64 + fr, col0 = pn * 256 + wc * 32 + 8 * fq;
#pragma unroll
        for (int ai = 0; ai < 2; ++ai)
#pragma unroll
            for (int m = 0; m < 4; ++m) { const int row = row0 + ai * 128 + m * 16; const float gt = gate[row]; bf16* rowp = YE + (size_t)row * D + col0;
#pragma unroll
                for (int bj = 0; bj < 2; ++bj) pg8::st8(rowp + bj * 128, acc[ai][bj][m][0] * gt, acc[ai][bj][m][1] * gt); }
    }
};
struct ProbF1 {
    static constexpr bool GATHER = false; static constexpr bool PERM = true;
    int K, lda, ldb, nunits; const bf16* CS; const bf16* P1; bf16* T1;
    __device__ __forceinline__ void map(int u, int& bg, int& pm, int& pn) const { pn = u & 7; pm = (u >> 3) & 1; bg = u >> 4; }
    __device__ __forceinline__ void locate(int u, const char*& a, const char*& b) const { int bg, pm, pn; map(u, bg, pm, pn);
        a = (const char*)(CS + (size_t)pm * 256 * 256); b = (const char*)(P1 + ((size_t)(bg >> 2) * SEQ + (size_t)pn * 256) * IN_CD + HY3 + (bg & 3) * 256); }
    __device__ __forceinline__ void epi(const f32x4 (&acc)[2][2][4][2], int u, int wr, int wc, int fr, int fq) const {
        int bg, pm, pn; map(u, bg, pm, pn);
        const int k20 = wr * 64 + fr, col0 = pn * 256 + wc * 32 + 8 * fq;
#pragma unroll
        for (int ai = 0; ai < 2; ++ai)
#pragma unroll
            for (int m = 0; m < 4; ++m) { const int k2 = k20 + ai * 128 + m * 16; bf16* rowp = T1 + (((size_t)bg * 256 + k2) * 2 + pm) * SEQ + col0;
#pragma unroll
                for (int bj = 0; bj < 2; ++bj) pg8::st8(rowp + bj * 128, acc[ai][bj][m][0], acc[ai][bj][m][1]); }
    }
};
struct ProbF2 {
    static constexpr bool GATHER = false; static constexpr bool PERM = true;
    int K, lda, ldb, nunits; const bf16* CSL; const bf16* T1; bf16* CAT;
    __device__ __forceinline__ void locate(int u, const char*& a, const char*& b) const { const int pm = u & 7, bg = u >> 3; a = (const char*)(CSL + (size_t)pm * 256 * 4096); b = (const char*)(T1 + (size_t)bg * 256 * 4096); }
    __device__ __forceinline__ void epi(const f32x4 (&acc)[2][2][4][2], int u, int wr, int wc, int fr, int fq) const {
        const int pm = u & 7, bg = u >> 3;
        const int row0 = (bg >> 2) * SEQ + pm * 256 + wr * 64 + fr, col0 = 1024 + (bg & 3) * 256 + wc * 32 + 8 * fq;
#pragma unroll
        for (int ai = 0; ai < 2; ++ai)
#pragma unroll
            for (int m = 0; m < 4; ++m) { bf16* rowp = CAT + (size_t)(row0 + ai * 128 + m * 16) * D + col0;
#pragma unroll
                for (int bj = 0; bj < 2; ++bj) pg8::st8(rowp + bj * 128, acc[ai][bj][m][0], acc[ai][bj][m][1]); }
    }
};

namespace att {
typedef short v4i16_t __attribute__((ext_vector_type(4)));
__device__ __forceinline__ s16x4 vtr(const LAS unsigned char* p) { return __builtin_bit_cast(s16x4, __builtin_amdgcn_ds_read_tr16_b64_v4i16((LAS v4i16_t*)p)); }
constexpr int VS = 320;
struct Tensors { const bf16* P; const bf16* KV; const bf16* KPE; const float* rpb; bf16* CAT; };

template <int MODE>
__device__ __forceinline__ void attn_unit(LAS unsigned char* lds, const Tensors& T, int unit) {
    constexpr int DK = MODE == 0 ? 192 : 128, NS = DK / 16, KCH = DK / 8, KS = DK * 2 + 16;
    constexpr int KBYTES = 64 * KS, VBYTES = 64 * VS, BUF = KBYTES + VBYTES;
    constexpr int NKC = (64 * KCH) / NTHR;
    const int tid = tid_opaque(), wave = __builtin_amdgcn_readfirstlane(tid >> 6), lane = tid & 63, l32 = lane & 31, hf = lane >> 5;
    const int b = unit >> 6, h = (unit >> 3) & 7, sub = unit & 7;
    LAS float* rpb_l = (LAS float*)(lds + 2 * BUF);
    int qrow, r = 0, qc = 0, krlo = 0, nkt;
    if (MODE == 0) { qrow = b * SEQ + sub * 256 + wave * 32 + l32; nkt = 36; }
    else { r = sub * 4 + (wave >> 1); qc = (wave & 1) * 32 + l32; qrow = b * SEQ + r * GW + qc;
        const int r0 = sub * 4, r3 = r0 + 3; krlo = r0 - 4 < 0 ? 0 : (r0 - 4 > 24 ? 24 : r0 - 4); const int rs3 = r3 - 4 < 0 ? 0 : (r3 - 4 > 24 ? 24 : r3 - 4);
        nkt = 4 + (rs3 + 8 - krlo); }
    const int rs = r - 4 < 0 ? 0 : (r - 4 > 24 ? 24 : r - 4);
    const int cs = qc - 8 < 0 ? 0 : (qc - 8 > 48 ? 48 : qc - 8);
    bf16x8 qf[NS];
    { const bf16* qp = T.P + (size_t)qrow * IN_AB_PAD + (MODE == 0 ? h * 192 : OFF_QNA + h * 128) + 8 * hf;
#pragma unroll
      for (int s = 0; s < NS; ++s) qf[s] = *(const bf16x8*)(qp + 16 * s); }
    if (MODE == 1) { for (int i = tid; i < 15 * 31; i += NTHR) rpb_l[i] = T.rpb[h * 465 + i]; }
    u32x4 kreg[NKC], vreg[2];
    auto key_row = [&](int kt, int rr) -> int {
        if (MODE == 0) return kt < 32 ? b * SEQ + kt * 64 + rr : MLAT + b * LC + (kt - 32) * 64 + rr;
        return kt < 4 ? MLAT + b * LC + kt * 64 + rr : b * SEQ + (krlo + kt - 4) * GW + rr;
    };
    auto load_tile = [&](int kt) {
#pragma unroll
        for (int i = 0; i < NKC; ++i) { const int ci = tid + i * NTHR, rr = ci / KCH, c = ci % KCH; const int row = key_row(kt, rr);
            const bf16* src;
            if (MODE == 0) src = c < 16 ? T.KV + (size_t)row * D + h * 256 + c * 8 : T.KPE + (size_t)row * 64 + (c - 16) * 8;
            else src = T.P + (size_t)row * IN_AB_PAD + OFF_KNA + h * 128 + c * 8;
            kreg[i] = *(const u32x4*)src; }
#pragma unroll
        for (int i = 0; i < 2; ++i) { const int ci = tid + i * NTHR, rr = ci >> 4, c = ci & 15; const int row = key_row(kt, rr);
            const bf16* src = MODE == 0 ? T.KV + (size_t)row * D + h * 256 + 128 + c * 8 : T.P + (size_t)row * IN_AB_PAD + OFF_VNA + h * 128 + c * 8;
            vreg[i] = *(const u32x4*)src; }
    };
    auto store_tile = [&](int buf) {
        LAS unsigned char* kb = lds + buf * BUF; LAS unsigned char* vb = kb + KBYTES;
#pragma unroll
        for (int i = 0; i < NKC; ++i) { const int ci = tid + i * NTHR, rr = ci / KCH, c = ci % KCH; *(LAS u32x4*)(kb + rr * KS + c * 16) = kreg[i]; }
#pragma unroll
        for (int i = 0; i < 2; ++i) { const int ci = tid + i * NTHR, rr = ci >> 4, c = ci & 15; *(LAS u32x4*)(vb + rr * VS + c * 16) = vreg[i]; }
    };
    f32x16 o[4];
#pragma unroll
    for (int c = 0; c < 4; ++c)
#pragma unroll
        for (int i = 0; i < 16; ++i) o[c][i] = 0.f;
    float m_run = -1e30f, l_run = 0.f;
    const float sc2 = (MODE == 0 ? 0.07216878364870322f : 0.08838834764831845f) * 1.4426950408889634f;
    load_tile(0); store_tile(0); __syncthreads();
    for (int kt = 0; kt < nkt; ++kt) {
        if (kt + 1 < nkt) load_tile(kt + 1);
        const int kr = krlo + kt - 4;
        const bool active = MODE == 0 || kt < 4 || (kr >= rs && kr < rs + 8);
        if (active) {
            const LAS unsigned char* kb = lds + (kt & 1) * BUF; const LAS unsigned char* vb = kb + KBYTES;
#pragma unroll
            for (int kb2 = 0; kb2 < 2; ++kb2) {
                f32x16 sc;
#pragma unroll
                for (int i = 0; i < 16; ++i) sc[i] = 0.f;
#pragma unroll
                for (int s = 0; s < NS; ++s) { const bf16x8 kf = *(const LAS bf16x8*)(kb + (32 * kb2 + l32) * KS + (16 * s + 8 * hf) * 2);
                    sc = __builtin_amdgcn_mfma_f32_32x32x16_bf16(kf, qf[s], sc, 0, 0, 0); }
                float mx = -1e30f;
#pragma unroll
                for (int i = 0; i < 16; ++i) {
                    float v = sc[i] * sc2;
                    if (MODE == 1 && kt >= 4) { const int kc = 32 * kb2 + 8 * (i >> 2) + 4 * hf + (i & 3); const int dcl = kc - cs; const bool ok = (unsigned)dcl < 16u;
                        int bi = (kr - r + 7) * 31 + (kc - qc + 15); bi = ok ? bi : 0;
                        v = ok ? v + rpb_l[bi] * 1.4426950408889634f : -1e30f; }
                    sc[i] = v; mx = fmaxf(mx, v); }
                mx = fmaxf(mx, __shfl_xor(mx, 32));
                const float m_new = fmaxf(m_run, mx), alpha = __builtin_amdgcn_exp2f(m_run - m_new);
                m_run = m_new;
                float ps = 0.f;
#pragma unroll
                for (int i = 0; i < 16; ++i) { const float p = __builtin_amdgcn_exp2f(sc[i] - m_new); sc[i] = p; ps += p; }
                l_run = l_run * alpha + ps;
                if (__builtin_amdgcn_ballot_w64(alpha != 1.f) != 0ull) {
#pragma unroll
                    for (int c = 0; c < 4; ++c)
#pragma unroll
                        for (int i = 0; i < 16; ++i) o[c][i] *= alpha; }
#pragma unroll
                for (int s2 = 0; s2 < 2; ++s2) {
                    u32x4 pw; pw.x = cvtpk(sc[8 * s2 + 0], sc[8 * s2 + 1]); pw.y = cvtpk(sc[8 * s2 + 2], sc[8 * s2 + 3]);
                    pw.z = cvtpk(sc[8 * s2 + 4], sc[8 * s2 + 5]); pw.w = cvtpk(sc[8 * s2 + 6], sc[8 * s2 + 7]);
                    const bf16x8 pf = __builtin_bit_cast(bf16x8, pw);
                    const LAS unsigned char* vrow = vb + (32 * kb2 + 16 * s2 + 4 * hf + ((lane & 15) >> 2)) * VS + (16 * ((lane >> 4) & 1) + 4 * (lane & 3)) * 2;
#pragma unroll
                    for (int c = 0; c < 4; ++c) {
                        const s16x4 v0 = vtr(vrow + c * 64), v1 = vtr(vrow + 8 * VS + c * 64);
                        const bf16x8 vf = {v0[0], v0[1], v0[2], v0[3], v1[0], v1[1], v1[2], v1[3]};
                        o[c] = __builtin_amdgcn_mfma_f32_32x32x16_bf16(vf, pf, o[c], 0, 0, 0); }
                }
            }
        }
        if (kt + 1 < nkt) store_tile((kt + 1) & 1);
        __syncthreads();
    }
    const float linv = 1.f / (l_run + __shfl_xor(l_run, 32));
    bf16* op = T.CAT + (size_t)qrow * D + (MODE == 0 ? h * 128 : 1024 + h * 128) + 4 * hf;
#pragma unroll
    for (int c = 0; c < 4; ++c)
#pragma unroll
        for (int g = 0; g < 4; ++g) { u32x2 w; w.x = cvtpk(o[c][4 * g] * linv, o[c][4 * g + 1] * linv); w.y = cvtpk(o[c][4 * g + 2] * linv, o[c][4 * g + 3] * linv);
            *(u32x2*)(op + 32 * c + 8 * g) = w; }
}
}

namespace hy {
constexpr int ZROW = 4800;
constexpr int Z_BYTES = 16 * ZROW;
constexpr int HR_OFF = 76800;
constexpr int HR_CH = 16384 + 64, HR_C1 = 8192 + 64;
constexpr int XROW = 4096 + 16;
constexpr int HR_BYTES = 16 * XROW;
static_assert(HR_OFF + HR_BYTES <= LDS_MAIN && HR_OFF >= Z_BYTES && HR_BYTES >= 4 * HR_CH, "hyena LDS map");

__device__ __forceinline__ void load_rows(LAS unsigned char* lds, const bf16* ST, int part, int c0, bool zlayout) {
    const int tid = tid_opaque();
#pragma unroll
    for (int i = 0; i < 8; ++i) { const int ci = tid + i * NTHR, row = ci >> 8, cc = ci & 255, ch = row >> 2, b = row & 3;
        const u32x4 v = *(const u32x4*)(ST + ((size_t)(b * HY3 + part * HYW + c0 + ch) * SEQ + cc * 8));
        if (zlayout) *(LAS u32x4*)(lds + row * ZROW + (cc >> 3) * 144 + (cc & 7) * 16) = v;
        else *(LAS u32x4*)(lds + HR_OFF + row * XROW + cc * 16) = v; }
}
__device__ __forceinline__ void load_hr(LAS unsigned char* lds, const bf16* HRg, int o, int c0) {
    const int tid = tid_opaque();
#pragma unroll
    for (int i = 0; i < 4; ++i) { const int ci = tid + i * NTHR, ch = ci >> 9, cc = ci & 511;
        const unsigned* src = (const unsigned*)(HRg + ((size_t)(o * HYW + c0 + ch) * 4096 + cc * 8));
        const u32x4 v = *(const u32x4*)src; const unsigned nx = cc == 511 ? 0u : src[4];
        *(LAS u32x4*)(lds + HR_OFF + ch * HR_CH + cc * 16) = v;
        u32x4 s; s.x = (v.x >> 16) | (v.y << 16); s.y = (v.y >> 16) | (v.z << 16); s.z = (v.z >> 16) | (v.w << 16); s.w = (v.w >> 16) | (nx << 16);
        *(LAS u32x4*)(lds + HR_OFF + ch * HR_CH + HR_C1 + cc * 16) = s; }
}
__device__ __forceinline__ void conv_load(const LAS unsigned char* hrc, const LAS unsigned char* zl, int it, int xb, int il, u32x4& a, u32x4 (&b)[4]) {
    const int d = (it >> 2) - 31, k0 = (it & 3) * 16;
    const int x0 = xb - 64 * d + k0;
    const LAS unsigned* ap = (const LAS unsigned*)(hrc + (x0 & 1) * HR_C1 + (x0 >> 1) * 4);
    a.x = ap[0]; a.y = ap[1]; a.z = ap[2]; a.w = ap[3];
#pragma unroll
    for (int n = 0; n < 4; ++n) { const int j = 8 * n + il - d; const int jc = (unsigned)j < 32u ? j : 32;
        b[n] = *(const LAS u32x4*)(zl + jc * 144 + k0 * 2); }
}
__device__ __forceinline__ void conv_step(f32x16 (&acc)[4], int it, const u32x4& a, const u32x4 (&b)[4]) {
    const int d = (it >> 2) - 31, ilo = d > 0 ? d : 0, ihi = d < 0 ? 31 + d : 31;
    const bf16x8 af = __builtin_bit_cast(bf16x8, a);
#pragma unroll
    for (int n = 0; n < 4; ++n) if (8 * n + 7 >= ilo && 8 * n <= ihi) acc[n] = __builtin_amdgcn_mfma_f32_32x32x16_bf16(af, __builtin_bit_cast(bf16x8, b[n]), acc[n], 0, 0, 0);
}
__device__ __forceinline__ void conv_mma(LAS unsigned char* lds, f32x16 (&acc)[4], int wave, int lane) {
    const int ch = wave >> 1, a0 = (wave & 1) * 32, l32 = lane & 31, hf = lane >> 5, il = l32 >> 2, b = l32 & 3;
    const LAS unsigned char* hrc = lds + HR_OFF + ch * HR_CH;
    const LAS unsigned char* zl = lds + (ch * 4 + b) * ZROW + hf * 16;
    const int xb = 2048 - a0 - l32 + 8 * hf;
#pragma unroll
    for (int n = 0; n < 4; ++n)
#pragma unroll
        for (int i = 0; i < 16; ++i) acc[n][i] = 0.f;
    u32x4 fa0, fb0[4], fa1, fb1[4];
    conv_load(hrc, zl, 0, xb, il, fa0, fb0);
    for (int it = 0; it < 252; it += 2) {
        conv_load(hrc, zl, it + 1, xb, il, fa1, fb1);
        conv_step(acc, it, fa0, fb0);
        conv_load(hrc, zl, it + 2 < 252 ? it + 2 : 251, xb, il, fa0, fb0);
        conv_step(acc, it + 1, fa1, fb1);
    }
}
__device__ __forceinline__ void gate_epi(LAS unsigned char* lds, f32x16 (&acc)[4], float skip, int wave, int lane) {
    const int ch = wave >> 1, a0 = (wave & 1) * 32, l32 = lane & 31, hf = lane >> 5, il = l32 >> 2, b = l32 & 3;
#pragma unroll
    for (int n = 0; n < 4; ++n)
#pragma unroll
        for (int g = 0; g < 4; ++g) { const int i = 8 * n + il, ao = a0 + 8 * g + 4 * hf;
            const u32x2 zw = *(const LAS u32x2*)(lds + (ch * 4 + b) * ZROW + i * 144 + ao * 2);
            const u32x2 xw = *(const LAS u32x2*)(lds + HR_OFF + (ch * 4 + b) * XROW + (64 * i + ao) * 2);
            acc[n][4 * g + 0] = bflo(xw.x) * (acc[n][4 * g + 0] + skip * bflo(zw.x));
            acc[n][4 * g + 1] = bfhi(xw.x) * (acc[n][4 * g + 1] + skip * bfhi(zw.x));
            acc[n][4 * g + 2] = bflo(xw.y) * (acc[n][4 * g + 2] + skip * bflo(zw.y));
            acc[n][4 * g + 3] = bfhi(xw.y) * (acc[n][4 * g + 3] + skip * bfhi(zw.y)); }
}
__device__ __forceinline__ void hyena_unit(LAS unsigned char* lds, const bf16* ST, const bf16* HRg, const float* skip, bf16* CAT, int unit) {
    const int tid = tid_opaque(), wave = __builtin_amdgcn_readfirstlane(tid >> 6), lane = tid & 63;
    const int c0 = unit * 4, ch = wave >> 1, a0 = (wave & 1) * 32, l32 = lane & 31, hf = lane >> 5, il = l32 >> 2, b = l32 & 3;
    f32x16 acc[4];
    load_rows(lds, ST, 0, c0, true); load_hr(lds, HRg, 0, c0);
    if (tid < 128) *(LAS u32x4*)(lds + (tid >> 3) * ZROW + 32 * 144 + (tid & 7) * 16) = (u32x4){0u, 0u, 0u, 0u};
    __syncthreads();
    conv_mma(lds, acc, wave, lane);
    __syncthreads();
    load_rows(lds, ST, 1, c0, false);
    __syncthreads();
    gate_epi(lds, acc, skip[c0 + ch], wave, lane);
    __syncthreads();
#pragma unroll
    for (int n = 0; n < 4; ++n)
#pragma unroll
        for (int g = 0; g < 4; ++g) { const int i = 8 * n + il, ao = a0 + 8 * g + 4 * hf;
            u32x2 w; w.x = cvtpk(acc[n][4 * g], acc[n][4 * g + 1]); w.y = cvtpk(acc[n][4 * g + 2], acc[n][4 * g + 3]);
            *(LAS u32x2*)(lds + (ch * 4 + b) * ZROW + i * 144 + ao * 2) = w; }
    load_hr(lds, HRg, 1, c0);
    __syncthreads();
    conv_mma(lds, acc, wave, lane);
    __syncthreads();
    load_rows(lds, ST, 2, c0, false);
    __syncthreads();
    gate_epi(lds, acc, skip[HYW + c0 + ch], wave, lane);
    __syncthreads();
    LAS bf16* Y = (LAS bf16*)lds;
#pragma unroll
    for (int n = 0; n < 4; ++n)
#pragma unroll
        for (int e = 0; e < 16; ++e) { const int t = 64 * (8 * n + il) + a0 + 8 * (e >> 2) + 4 * hf + (e & 3);
            Y[(b * SEQ + t) * 4 + ch] = (bf16)f2bf(acc[n][e]); }
    __syncthreads();
#pragma unroll 4
    for (int i = 0; i < 16; ++i) { const int it = tid + i * NTHR; const u32x2 v = *(const LAS u32x2*)(lds + it * 8);
        *(u32x2*)(CAT + (size_t)it * D + c0) = v; }
    __syncthreads();
}
}

__device__ __forceinline__ void prep_item(LAS unsigned char* scr, const bf16* P1, const float* cw, const float* cb, bf16* ST, int item, int lane) {
    const int ct = item % 48, tt = (item / 48) & 31, b = item / (48 * 32), t0 = tt * 64, c30 = ct * 64;
#pragma unroll
    for (int i = 0; i < 9; ++i) { const int ci = lane + i * 64; if (ci < 66 * 8) { const int rr = ci >> 3, cc = ci & 7, t = t0 - 1 + rr;
        u32x4 v = (u32x4){0u, 0u, 0u, 0u};
        if (t >= 0 && t < SEQ) v = *(const u32x4*)(P1 + ((size_t)(b * SEQ + t) * IN_CD + c30 + cc * 8));
        *(LAS u32x4*)(scr + rr * 144 + cc * 16) = v; } }
    LDS_WAIT(); asm volatile("" ::: "memory");
    const LAS bf16* tile = (const LAS bf16*)scr;
    for (int c = 0; c < 64; ++c) { const int c3 = c30 + c;
        const float w0 = cw[c3], w1 = cw[HY3 + c3], w2 = cw[2 * HY3 + c3], bb = cb[c3];
        const float v = bb + w0 * bf2f(tile[lane * 72 + c]) + w1 * bf2f(tile[(lane + 1) * 72 + c]) + w2 * bf2f(tile[(lane + 2) * 72 + c]);
        ST[(size_t)(b * HY3 + c3) * SEQ + t0 + lane] = (bf16)f2bf(v); }
    LDS_WAIT(); asm volatile("" ::: "memory");
}

__device__ __forceinline__ void transpose_item(const float* W, int N, bf16* WT, int ldt, int k0, int n0, int drow0, LAS float* scr, int lane) {
#pragma unroll 8
    for (int i = 0; i < 32; ++i) { const int kk = 2 * i + (lane >> 5); scr[kk * 33 + (lane & 31)] = W[(size_t)(k0 + kk) * N + n0 + (lane & 31)]; }
    LDS_WAIT(); asm volatile("" ::: "memory");
    const int c = lane & 7;
#pragma unroll
    for (int j = 0; j < 4; ++j) { const int n = (lane >> 3) + 8 * j; const LAS float* s = scr + (8 * c) * 33 + n;
        u32x4 o; o.x = pk2(s[0 * 33], s[1 * 33]); o.y = pk2(s[2 * 33], s[3 * 33]); o.z = pk2(s[4 * 33], s[5 * 33]); o.w = pk2(s[6 * 33], s[7 * 33]);
        *(u32x4*)(WT + (size_t)(drow0 + n) * ldt + k0 + 8 * c) = o; }
    LDS_WAIT(); asm volatile("" ::: "memory");
}

struct Args { const float* in[31]; float* out; unsigned char* ws; int ph_lo, ph_hi; };
enum { I_X = 0, I_C, I_CTX, I_CCTX, I_ADAW, I_ADAB, I_LN1G, I_LN1B, I_LN2G, I_LN2B, I_ROUTER, I_W1, I_W3, I_W2, I_ABIN, I_KVNORM, I_UKV, I_RPB, I_ABOUT,
       I_CDIN, I_CONVW, I_CONVB, I_FW1, I_FB1, I_FF1, I_FW2, I_FB2, I_FF2, I_FW3, I_SKIP, I_CDOUT };
constexpr int NPHASE = 21;
typedef const char __attribute__((address_space(4)))* kptr_t;
__device__ __forceinline__ const float* kin(int i) { kptr_t ka = (kptr_t)__builtin_amdgcn_kernarg_segment_ptr(); int off = i * 8; asm volatile("" : "+s"(off)); return *(const float* const __attribute__((address_space(4)))*)(ka + off); }
__device__ __forceinline__ float* kout() { kptr_t ka = (kptr_t)__builtin_amdgcn_kernarg_segment_ptr(); int off = 31 * 8; asm volatile("" : "+s"(off)); return *(float* const __attribute__((address_space(4)))*)(ka + off); }
__device__ __forceinline__ unsigned char* kws() { kptr_t ka = (kptr_t)__builtin_amdgcn_kernarg_segment_ptr(); int off = 32 * 8; asm volatile("" : "+s"(off)); return *(unsigned char* const __attribute__((address_space(4)))*)(ka + off); }
static_assert(sizeof(Args) == 33 * 8 + 8, "Args layout");

__device__ __forceinline__ void ada_phase(LAS unsigned char* lds, const Args& A, int vcu, int G) {
    const int tid = tid_opaque();
    LAS float* sil = (LAS float*)lds; LAS float* part = sil + 5 * D;
    float* ADA = (float*)(kws() + WS_ADA);
    for (int i = tid; i < 5 * D; i += NTHR) { const int r = i / D, k = i % D; const float x = r < 4 ? kin(I_C)[r * D + k] : kin(I_CCTX)[k]; sil[i] = x / (1.f + expf(-x)); }
    __syncthreads();
    const int kg = tid >> 4, c4 = tid & 15;
    for (int unit = vcu; unit < 384; unit += G) {
        const int l = unit / 192, col0 = (unit % 192) * 64;
        f32x4 acc[5];
#pragma unroll
        for (int r = 0; r < 5; ++r) acc[r] = (f32x4){0.f, 0.f, 0.f, 0.f};
        const float* W = kin(I_ADAW) + (size_t)l * D * (6 * D) + col0 + 4 * c4;
#pragma unroll 8
        for (int i = 0; i < 64; ++i) { const int row = kg * 64 + i; const f32x4 w = *(const f32x4*)(W + (size_t)row * (6 * D));
#pragma unroll
            for (int r = 0; r < 5; ++r) acc[r] += w * sil[r * D + row]; }
#pragma unroll
        for (int r = 0; r < 5; ++r) *(LAS f32x4*)(part + ((kg * 16 + c4) * 5 + r) * 4) = acc[r];
        __syncthreads();
        if (tid < 320) { const int r = tid >> 6, col = tid & 63; float s = 0.f;
            for (int g = 0; g < 32; ++g) s += part[((g * 16 + (col >> 2)) * 5 + r) * 4 + (col & 3)];
            ADA[(size_t)(l * 5 + r) * (6 * D) + col0 + col] = s + kin(I_ADAB)[l * 6 * D + col0 + col]; }
        __syncthreads();
    }
}
__device__ __forceinline__ void filt_phase(LAS unsigned char* lds, const Args& A, int vcu, int G) {
    const int tid = tid_opaque(), wave = __builtin_amdgcn_readfirstlane(tid >> 6), lane = tid & 63;
    LAS float* zf = (LAS float*)lds;
    LAS float* h1 = zf + 64 * 33;
    LAS float* h2 = h1 + 64 * 65;
    bf16* HRg = (bf16*)(kws() + WS_HR);
    const float* fw1 = kin(I_FW1); const float* fb1 = kin(I_FB1); const float* ff1 = kin(I_FF1);
    const float* fw2 = kin(I_FW2); const float* fb2 = kin(I_FB2); const float* ff2 = kin(I_FF2); const float* fw3 = kin(I_FW3);
    for (int unit = vcu; unit < 256; unit += G) {
        const int lb = unit >> 3, cbk = unit & 7, l = lb * 64 + lane;
        const float t01 = (float)l / 2047.f, w = 6.283185307179586f * (float)l / 2048.f;
        for (int f = wave; f < 33; f += 8) { float v;
            if (f == 0) v = t01; else { const int j = (f - 1) & 15; const float band = 1e-4f + (float)j * ((15.f - 1e-4f) / 15.f); v = f <= 16 ? cosf(w * band) : -sinf(w * band); }
            zf[lane * 33 + f] = v; }
        __syncthreads();
        { float a[8];
#pragma unroll
          for (int i = 0; i < 8; ++i) a[i] = fb1[wave * 8 + i];
#pragma unroll 1
          for (int f = 0; f < 33; ++f) { const float z = zf[lane * 33 + f];
#pragma unroll
              for (int i = 0; i < 8; ++i) a[i] += z * fw1[f * 64 + wave * 8 + i]; }
#pragma unroll
          for (int i = 0; i < 8; ++i) h1[lane * 65 + wave * 8 + i] = sinf(ff1[wave * 8 + i] * a[i]); }
        __syncthreads();
        { float a[8];
#pragma unroll
          for (int i = 0; i < 8; ++i) a[i] = fb2[wave * 8 + i];
#pragma unroll 1
          for (int f = 0; f < 64; ++f) { const float z = h1[lane * 65 + f];
#pragma unroll
              for (int i = 0; i < 8; ++i) a[i] += z * fw2[f * 64 + wave * 8 + i]; }
#pragma unroll
          for (int i = 0; i < 8; ++i) h2[lane * 65 + wave * 8 + i] = sinf(ff2[wave * 8 + i] * a[i]); }
        __syncthreads();
        for (int cg = 0; cg < 4; ++cg) {
            const int col0 = cbk * 512 + wave * 64 + cg * 16;
            float acc[16];
#pragma unroll
            for (int i = 0; i < 16; ++i) acc[i] = 0.f;
#pragma unroll 1
            for (int j = 0; j < 64; ++j) { const float hv = h2[lane * 65 + j]; const float* wr = fw3 + (size_t)j * 4096 + col0;
#pragma unroll
                for (int i = 0; i < 16; ++i) acc[i] += hv * wr[i]; }
            const int o = col0 >> 11, dir = (col0 >> 10) & 1, cbase = col0 & 1023;
#pragma unroll
            for (int i = 0; i < 16; ++i) { const int c = cbase + i;
                const float delta = fabsf(-3.0701134573253946f + (float)c * ((-15.350567286626973f + 3.0701134573253946f) / 1023.f));
                const float v = acc[i] * expf(-t01 * delta);
                bf16* row = HRg + (size_t)(o * HYW + c) * 4096;
                if (dir == 0) row[2048 - l] = (bf16)f2bf(v); else row[l == 0 ? 0 : 2048 + l] = l == 0 ? (bf16)0 : (bf16)f2bf(v); }
        }
        __syncthreads();
    }
}
__device__ __forceinline__ void convert_phase(LAS unsigned char* lds, const Args& A, int vcu, int G) {
    const int tid = tid_opaque(), wave = __builtin_amdgcn_readfirstlane(tid >> 6), lane = tid & 63;
    LAS float* scr = (LAS float*)(lds + wave * 16384);
    const int gw = vcu * NWAVES + wave, NGW = G * NWAVES;
    unsigned char* ws = kws();
    constexpr int N0 = 32 * 162, N1 = 8 * 64, N2 = 32 * 64, N3 = 32 * 128, N4 = 32 * 64, NEI = 32 * 44, N5 = 32 * NEI, N6 = N5, N7 = 32 * (22 * 64);
    constexpr int NIT = N0 + N1 + N2 + N3 + N4 + N5 + N6 + N7;
    for (int it = gw; it < NIT; it += NGW) {
        int r = it;
        if (r < N5) { const int le = r / NEI, q = r % NEI, kb = q / 44, nb = q % 44, f0 = nb * 32;
            transpose_item(kin(I_W1) + (size_t)le * D * FF, FF, (bf16*)(ws + WS_W13) + (size_t)le * (2 * FF * D), D, kb * 64, f0, (f0 >> 7) * 256 + (f0 & 127), scr, lane); continue; } r -= N5;
        if (r < N6) { const int le = r / NEI, q = r % NEI, kb = q / 44, nb = q % 44, f0 = nb * 32;
            transpose_item(kin(I_W3) + (size_t)le * D * FF, FF, (bf16*)(ws + WS_W13) + (size_t)le * (2 * FF * D), D, kb * 64, f0, (f0 >> 7) * 256 + 128 + (f0 & 127), scr, lane); continue; } r -= N6;
        if (r < N7) { const int le = r / NEI, q = r % NEI, kb = q / 64, nb = q % 64;
            transpose_item(kin(I_W2) + (size_t)le * FF * D, D, (bf16*)(ws + WS_W2) + (size_t)le * (D * FF), FF, kb * 64, nb * 32, nb * 32, scr, lane); continue; } r -= N7;
        if (r < N0) { transpose_item(kin(I_ABIN), IN_AB, (bf16*)(ws + WS_WAB), D, (r / 162) * 64, (r % 162) * 32, (r % 162) * 32, scr, lane); continue; } r -= N0;
        if (r < N1) { transpose_item(kin(I_UKV), D, (bf16*)(ws + WS_WUKV), KVR, (r / 64) * 64, (r % 64) * 32, (r % 64) * 32, scr, lane); continue; } r -= N1;
        if (r < N2) { transpose_item(kin(I_ABOUT), D, (bf16*)(ws + WS_WABO), D, (r / 64) * 64, (r % 64) * 32, (r % 64) * 32, scr, lane); continue; } r -= N2;
        if (r < N3) { transpose_item(kin(I_CDIN), IN_CD, (bf16*)(ws + WS_WCD), D, (r / 128) * 64, (r % 128) * 32, (r % 128) * 32, scr, lane); continue; } r -= N3;
        transpose_item(kin(I_CDOUT), D, (bf16*)(ws + WS_WCDO), D, (r / 64) * 64, (r % 64) * 32, (r % 64) * 32, scr, lane);
    }
    const size_t gt = (size_t)vcu * NTHR + tid, NGT = (size_t)G * NTHR;
    { u32x4* z = (u32x4*)(ws + WS_WAB + (size_t)IN_AB * D * 2); for (size_t i = gt; i < (size_t)(IN_AB_PAD - IN_AB) * D * 2 / 16; i += NGT) z[i] = (u32x4){0u, 0u, 0u, 0u}; }
    { unsigned* cs = (unsigned*)(ws + WS_CS256);
      for (size_t i = gt; i < 512 * 128; i += NGT) { const int row = (int)(i >> 7), n = (int)(i & 127) * 2, k2 = row & 255; const bool sn = row >= 256;
          const float a0 = (float)((k2 * n) & 255) * (1.f / 128.f), a1 = (float)((k2 * (n + 1)) & 255) * (1.f / 128.f);
          cs[i] = pk2((sn ? sinpif(a0) : cospif(a0)) * 0.0625f, (sn ? sinpif(a1) : cospif(a1)) * 0.0625f); } }
    { unsigned* cl = (unsigned*)(ws + WS_CSL);
      const float nrm = 0.022097086912079608f;
      for (size_t i = gt; i < (size_t)2048 * 2048; i += NGT) { const int k1 = (int)(i >> 11), j = (int)(i & 2047) * 2; const bool sn = j >= 2048; const int t = j & 2047;
          const float a0 = (float)((k1 * t) & 2047) * (1.f / 1024.f), a1 = (float)((k1 * (t + 1)) & 2047) * (1.f / 1024.f);
          cl[i] = pk2((sn ? -sinpif(a0) : cospif(a0)) * nrm, (sn ? -sinpif(a1) : cospif(a1)) * nrm); } }
}
__device__ __forceinline__ void mod_row(const float* xrow, const float* shift, const float* scale, bf16* orow, int lane) {
#pragma unroll
    for (int j = 0; j < 8; ++j) { const int c = 4 * lane + 256 * j; const f32x4 x = *(const f32x4*)(xrow + c), sh = *(const f32x4*)(shift + c), sc = *(const f32x4*)(scale + c);
        const f32x4 u = x * (sc + 1.f) + sh; u32x2 w; w.x = pk2(u[0], u[1]); w.y = pk2(u[2], u[3]); *(u32x2*)(orow + c) = w; }
}
__device__ __forceinline__ void modulate_phase(const Args& A, int vcu, int G) {
    const int tid = tid_opaque(), lane = tid & 63, gw = vcu * NWAVES + __builtin_amdgcn_readfirstlane(tid >> 6), NGW = G * NWAVES;
    const float* ADA = (const float*)(kws() + WS_ADA); bf16* U = (bf16*)(kws() + WS_UALL); const float* X = kin(I_X); const float* CT = kin(I_CTX);
    for (int row = gw; row < MALL; row += NGW) {
        if (row < MLAT) { const int b = row >> 11; mod_row(X + (size_t)row * D, ADA + (size_t)b * 6 * D, ADA + (size_t)b * 6 * D + D, U + (size_t)row * D, lane); }
        else mod_row(CT + (size_t)(row - MLAT) * D, ADA + (size_t)4 * 6 * D, ADA + (size_t)4 * 6 * D + D, U + (size_t)row * D, lane);
    }
}
__device__ __forceinline__ void postproj_phase(const Args& A, int vcu, int G) {
    const int tid = tid_opaque(), lane = tid & 63, gw = vcu * NWAVES + __builtin_amdgcn_readfirstlane(tid >> 6), NGW = G * NWAVES;
    bf16* P = (bf16*)(kws() + WS_P); bf16* CK = (bf16*)(kws() + WS_CKVN); bf16* KPE = (bf16*)(kws() + WS_KPE); const float* kvn = kin(I_KVNORM);
    const int fi = lane & 31;
    const float inv = exp2f(-(float)(fi & 15) * (13.287712379549449f / 16.f));
    for (int row = gw; row < MALL; row += NGW) {
        bf16* pr = P + (size_t)row * IN_AB_PAD;
        { const u32x4 w = *(const u32x4*)(pr + OFF_CKV + 8 * lane); float x[8] = {bflo(w.x), bfhi(w.x), bflo(w.y), bfhi(w.y), bflo(w.z), bfhi(w.z), bflo(w.w), bfhi(w.w)};
          float ss = 0.f;
#pragma unroll
          for (int i = 0; i < 8; ++i) ss += x[i] * x[i];
          const float rstd = 1.f / sqrtf(wave_sum(ss) * (1.f / KVR) + LN_EPS);
          const f32x4 g0 = *(const f32x4*)(kvn + 8 * lane), g1 = *(const f32x4*)(kvn + 8 * lane + 4);
          u32x4 o; o.x = pk2(x[0] * rstd * g0[0], x[1] * rstd * g0[1]); o.y = pk2(x[2] * rstd * g0[2], x[3] * rstd * g0[3]);
          o.z = pk2(x[4] * rstd * g1[0], x[5] * rstd * g1[1]); o.w = pk2(x[6] * rstd * g1[2], x[7] * rstd * g1[3]);
          *(u32x4*)(CK + (size_t)row * KVR + 8 * lane) = o; }
        if (row < MLAT) {
            const int t = row & 2047; const float pos = (float)(fi < 16 ? (t >> 6) : (t & 63)); float sn, cs; sincosf(pos * inv, &sn, &cs);
            if (lane < 32) { const float t1 = bf2f(pr[OFF_KPE + fi]), t2 = bf2f(pr[OFF_KPE + 32 + fi]);
                KPE[(size_t)row * 64 + fi] = (bf16)f2bf(t1 * cs - t2 * sn); KPE[(size_t)row * 64 + 32 + fi] = (bf16)f2bf(t2 * cs + t1 * sn); }
#pragma unroll
            for (int q = 0; q < 4; ++q) { const int h = 2 * q + (lane >> 5); bf16* qp = pr + h * 192 + 128;
                const float t1 = bf2f(qp[fi]), t2 = bf2f(qp[32 + fi]); qp[fi] = (bf16)f2bf(t1 * cs - t2 * sn); qp[32 + fi] = (bf16)f2bf(t2 * cs + t1 * sn); }
        } else KPE[(size_t)row * 64 + lane] = pr[OFF_KPE + lane];
    }
}
__device__ __forceinline__ void ln1_phase(LAS unsigned char* lds, int l, int vcu, int G) {
    const int tid = tid_opaque(), lane = tid & 63, gw = vcu * NWAVES + __builtin_amdgcn_readfirstlane(tid >> 6), NGW = G * NWAVES;
    LAS float* rt = (LAS float*)lds;
    unsigned char* ws = kws();
    { const float* router = kin(I_ROUTER) + (size_t)l * D * NE;
      for (int i = tid; i < 4 * D; i += NTHR) { const int c = i & (D - 1), q = i >> 11; const f32x4 v = *(const f32x4*)(router + (size_t)c * NE + 4 * q);
          rt[(4 * q + 0) * D + c] = v[0]; rt[(4 * q + 1) * D + c] = v[1]; rt[(4 * q + 2) * D + c] = v[2]; rt[(4 * q + 3) * D + c] = v[3]; } }
    __syncthreads();
    const float* PRE = (const float*)(ws + WS_PRE); float* H1 = (float*)(ws + WS_H1); bf16* U2 = (bf16*)(ws + WS_U2); float* AFF = (float*)(ws + WS_AFF);
    const float* g = kin(I_LN1G) + l * D; const float* bb = kin(I_LN1B) + l * D; const float* ADA = (const float*)(ws + WS_ADA) + (size_t)l * 5 * 6 * D;
    for (int rp = gw; rp < MLAT / 2; rp += NGW) {
        const int row0 = rp * 2, b = row0 >> 11;
        const float* ada = ADA + (size_t)b * 6 * D;
        f32x4 v[2][8];
#pragma unroll
        for (int rr = 0; rr < 2; ++rr)
#pragma unroll
            for (int j = 0; j < 8; ++j) v[rr][j] = *(const f32x4*)(PRE + (size_t)(row0 + rr) * D + 4 * lane + 256 * j);
#pragma unroll
        for (int rr = 0; rr < 2; ++rr) { float s = 0.f;
#pragma unroll
            for (int j = 0; j < 8; ++j) s += (v[rr][j][0] + v[rr][j][1]) + (v[rr][j][2] + v[rr][j][3]);
            const float mean = wave_sum(s) * (1.f / D); float q = 0.f;
#pragma unroll
            for (int j = 0; j < 8; ++j) { v[rr][j] = v[rr][j] - mean; q += (v[rr][j][0] * v[rr][j][0] + v[rr][j][1] * v[rr][j][1]) + (v[rr][j][2] * v[rr][j][2] + v[rr][j][3] * v[rr][j][3]); }
            const float rstd = 1.f / sqrtf(wave_sum(q) * (1.f / D) + LN_EPS);
#pragma unroll
            for (int j = 0; j < 8; ++j) { const int c = 4 * lane + 256 * j;
                const f32x4 hv = v[rr][j] * rstd * *(const f32x4*)(g + c) + *(const f32x4*)(bb + c);
                *(f32x4*)(H1 + (size_t)(row0 + rr) * D + c) = hv;
                const f32x4 u = hv * (*(const f32x4*)(ada + 4 * D + c) + 1.f) + *(const f32x4*)(ada + 3 * D + c);
                u32x2 w; w.x = pk2(u[0], u[1]); w.y = pk2(u[2], u[3]); *(u32x2*)(U2 + (size_t)(row0 + rr) * D + c) = w;
                v[rr][j] = u; } }
        float a[32];
#pragma unroll
        for (int e = 0; e < NE; ++e) { float a0 = 0.f, a1 = 0.f;
#pragma unroll
            for (int j = 0; j < 8; ++j) { const f32x4 r4 = *(const LAS f32x4*)(rt + e * D + 4 * lane + 256 * j);
                a0 += (v[0][j][0] * r4[0] + v[0][j][1] * r4[1]) + (v[0][j][2] * r4[2] + v[0][j][3] * r4[3]);
                a1 += (v[1][j][0] * r4[0] + v[1][j][1] * r4[1]) + (v[1][j][2] * r4[2] + v[1][j][3] * r4[3]); }
            a[e] = a0; a[16 + e] = a1; __builtin_amdgcn_sched_barrier(0); }
#pragma unroll
        for (int i = 0; i < 16; ++i) { const bool up = (lane & 32) != 0; const float snd = up ? a[i] : a[i + 16], kp = up ? a[i + 16] : a[i]; a[i] = kp + __shfl_xor(snd, 32); }
#pragma unroll
        for (int i = 0; i < 8; ++i) { const bool up = (lane & 16) != 0; const float snd = up ? a[i] : a[i + 8], kp = up ? a[i + 8] : a[i]; a[i] = kp + __shfl_xor(snd, 16); }
#pragma unroll
        for (int i = 0; i < 4; ++i) { const bool up = (lane & 8) != 0; const float snd = up ? a[i] : a[i + 4], kp = up ? a[i + 4] : a[i]; a[i] = kp + __shfl_xor(snd, 8); }
#pragma unroll
        for (int i = 0; i < 2; ++i) { const bool up = (lane & 4) != 0; const float snd = up ? a[i] : a[i + 2], kp = up ? a[i + 2] : a[i]; a[i] = kp + __shfl_xor(snd, 4); }
        { const bool up = (lane & 2) != 0; const float snd = up ? a[0] : a[1], kp = up ? a[1] : a[0]; a[0] = kp + __shfl_xor(snd, 2); }
        float lg = a[0] + __shfl_xor(a[0], 1);
        float mx = lg;
#pragma unroll
        for (int o = 2; o < 32; o <<= 1) mx = fmaxf(mx, __shfl_xor(mx, o));
        const float ex = expf(lg - mx); float den = ex;
#pragma unroll
        for (int o = 2; o < 32; o <<= 1) den += __shfl_xor(den, o);
        if ((lane & 1) == 0) { const int rr = lane >> 5, e = (lane >> 1) & 15, t = (row0 + rr) & 2047; AFF[(size_t)(b * NE + e) * SEQ + t] = ex / den; }
    }
}
__device__ __forceinline__ void topk_phase(LAS unsigned char* lds, const Args& A, int vcu, int G) {
    const int tid = tid_opaque(), wave = __builtin_amdgcn_readfirstlane(tid >> 6), lane = tid & 63;
    LAS unsigned long long* keys = (LAS unsigned long long*)lds;
    const float* AFF = (const float*)(kws() + WS_AFF); int* IDX = (int*)(kws() + WS_IDX); float* GATE = (float*)(kws() + WS_GATE); int* INV = (int*)(kws() + WS_INV);
    for (int unit = vcu; unit < NRT; unit += G) {
        const int e = unit >> 2, b = unit & 3;
        for (int i = tid; i < SEQ; i += NTHR) keys[i] = ((unsigned long long)__builtin_bit_cast(unsigned, AFF[(size_t)(b * NE + e) * SEQ + i]) << 32) | (unsigned)(2047 - i);
        __syncthreads();
        for (int k = 2; k <= SEQ; k <<= 1)
            for (int j = k >> 1; j > 0; j >>= 1) {
                for (int i = tid; i < SEQ; i += NTHR) { const int x = i ^ j; if (x > i) { const unsigned long long a = keys[i], c = keys[x]; const bool asc = (i & k) == 0;
                    if ((a > c) == asc) { keys[i] = c; keys[x] = a; } } }
                __syncthreads(); }
        for (int p = tid; p < SEQ; p += NTHR) { const unsigned long long kk = keys[p]; const int idx = 2047 - (int)(unsigned)(kk & 0xffffffffu), slot = 2047 - p;
            INV[(size_t)(b * SEQ + idx) * NE + e] = slot < CAP ? slot : -1;
            if (slot < CAP) { IDX[unit * CAP + slot] = idx; GATE[unit * CAP + slot] = __builtin_bit_cast(float, (unsigned)(kk >> 32)); } }
        __syncthreads();
    }
}
__device__ __forceinline__ void ln2_phase(int l, int vcu, int G) {
    const int tid = tid_opaque(), lane = tid & 63, gw = vcu * NWAVES + __builtin_amdgcn_readfirstlane(tid >> 6), NGW = G * NWAVES;
    unsigned char* ws = kws();
    const float* H1 = (const float*)(ws + WS_H1); const bf16* YE = (const bf16*)(ws + WS_YE); const int* INV = (const int*)(ws + WS_INV);
    float* out = l == 0 ? (float*)(ws + WS_H2) : kout(); bf16* U = (bf16*)(ws + WS_UALL);
    const float* g = kin(I_LN2G) + l * D; const float* bb = kin(I_LN2B) + l * D; const float* ADA = (const float*)(ws + WS_ADA);
    int inv_n = (gw < MLAT && lane < NE) ? INV[(size_t)gw * NE + lane] : -1;
    for (int row = gw; row < MLAT; row += NGW) {
        const int b = row >> 11; const int inv = inv_n;
        if (row + NGW < MLAT && lane < NE) inv_n = INV[(size_t)(row + NGW) * NE + lane];
        const float* ada = ADA + (size_t)(l * 5 + b) * 6 * D;
        f32x4 v[8];
#pragma unroll
        for (int j = 0; j < 8; ++j) v[j] = *(const f32x4*)(H1 + (size_t)row * D + 4 * lane + 256 * j);
        f32x4 m[8];
#pragma unroll
        for (int j = 0; j < 8; ++j) m[j] = (f32x4){0.f, 0.f, 0.f, 0.f};
        unsigned mask = (unsigned)__builtin_amdgcn_ballot_w64(inv >= 0) & 0xffffu;
        while (mask) {
            const int e0 = __builtin_ctz(mask); mask &= mask - 1; const bool two = mask != 0u; const int e1 = two ? __builtin_ctz(mask) : e0; if (two) mask &= mask - 1;
            const int s0 = __builtin_amdgcn_readlane(inv, e0), s1 = __builtin_amdgcn_readlane(inv, e1);
            const bf16* y0 = YE + (size_t)((e0 * 4 + b) * CAP + s0) * D + 4 * lane; const bf16* y1 = YE + (size_t)((e1 * 4 + b) * CAP + s1) * D + 4 * lane;
            u32x2 w0[8], w1[8];
#pragma unroll
            for (int j = 0; j < 8; ++j) { w0[j] = *(const u32x2*)(y0 + 256 * j); w1[j] = *(const u32x2*)(y1 + 256 * j); }
            const float f1 = two ? 1.f : 0.f;
#pragma unroll
            for (int j = 0; j < 8; ++j) { m[j][0] += bflo(w0[j].x) + f1 * bflo(w1[j].x); m[j][1] += bfhi(w0[j].x) + f1 * bfhi(w1[j].x); m[j][2] += bflo(w0[j].y) + f1 * bflo(w1[j].y); m[j][3] += bfhi(w0[j].y) + f1 * bfhi(w1[j].y); }
        }
        float s = 0.f;
#pragma unroll
        for (int j = 0; j < 8; ++j) { const int c = 4 * lane + 256 * j; v[j] = v[j] * DN_ALPHA + *(const f32x4*)(ada + 5 * D + c) * m[j]; s += (v[j][0] + v[j][1]) + (v[j][2] + v[j][3]); }
        const float mean = wave_sum(s) * (1.f / D); float q = 0.f;
#pragma unroll
        for (int j = 0; j < 8; ++j) { v[j] = v[j] - mean; q += (v[j][0] * v[j][0] + v[j][1] * v[j][1]) + (v[j][2] * v[j][2] + v[j][3] * v[j][3]); }
        const float rstd = 1.f / sqrtf(wave_sum(q) * (1.f / D) + LN_EPS);
        const float* ada1 = ADA + (size_t)(5 + b) * 6 * D;
#pragma unroll
        for (int j = 0; j < 8; ++j) { const int c = 4 * lane + 256 * j;
            const f32x4 hv = v[j] * rstd * *(const f32x4*)(g + c) + *(const f32x4*)(bb + c);
            *(f32x4*)(out + (size_t)row * D + c) = hv;
            if (l == 0) { const f32x4 u = hv * (*(const f32x4*)(ada1 + D + c) + 1.f) + *(const f32x4*)(ada1 + c); u32x2 w; w.x = pk2(u[0], u[1]); w.y = pk2(u[2], u[3]); *(u32x2*)(U + (size_t)row * D + c) = w; } }
    }
}

__global__ void __launch_bounds__(NTHR, 2) mk_fwd(Args A) {
    extern __shared__ __attribute__((aligned(16))) unsigned char lds_raw[];
    LAS unsigned char* lds = (LAS unsigned char*)lds_raw;
    volatile LAS unsigned* MISC = (volatile LAS unsigned*)(lds + LDS_MISC);
    const int G = gridDim.x; const int bx = blockIdx.x; const int vcu = (G % 8 == 0) ? (bx % 8) * (G / 8) + bx / 8 : bx;
    if (threadIdx.x < 16) MISC[threadIdx.x] = 0u;
    __syncthreads();
#if MK_LAUNCH_PER_PHASE
#define GRID_BAR() do { } while (0)
#else
    XcdBarrier bar = xcd_barrier_post((unsigned*)(kws() + WS_CTL) + 4096, MISC + 8);
#define GRID_BAR() xcd_barrier(bar)
#endif
    const int lo = A.ph_lo, hi = A.ph_hi;
#ifndef PH_MASK
#define PH_MASK 0xFFFFFFFFu
#endif
#define IN(k) ((((PH_MASK) >> (k)) & 1u) && lo <= (k) && (k) < hi)
#define SEAM(k) do { if ((k) + 1 < hi) GRID_BAR(); } while (0)
#ifndef PROBE_DUP
#define PROBE_DUP 0u
#endif
#define REP(k) for (int rep_ = 0; rep_ < (int)(((PROBE_DUP) >> (k)) & 1u) + 1; ++rep_)

    #ifndef PX_PARTS
#define PX_PARTS 3
#endif
#ifndef P0_PARTS
#define P0_PARTS 7
#endif
    if (IN(0)) REP(0) { if (P0_PARTS & 1) ada_phase(lds, A, vcu, G); if (P0_PARTS & 2) filt_phase(lds, A, vcu, G); if (P0_PARTS & 4) convert_phase(lds, A, vcu, G); SEAM(0); }

    {

            if (IN(1)) REP(1) { modulate_phase(A, vcu, G); SEAM(1); }
            if (IN(2)) REP(2) { ProbPlain P{2048, 2048, 2048, 36 * 21, (const bf16*)(kws() + WS_UALL), (const bf16*)(kws() + WS_WAB), (bf16*)(kws() + WS_P), IN_AB_PAD, 36, 21};
                pg8::gemm_phase(lds, P, vcu, G); SEAM(2); }
            if (IN(3)) REP(3) { postproj_phase(A, vcu, G); SEAM(3); }
            if (IN(4)) REP(4) { ProbPlain P{512, 512, 512, 36 * 8, (const bf16*)(kws() + WS_CKVN), (const bf16*)(kws() + WS_WUKV), (bf16*)(kws() + WS_KV), D, 36, 8};
                pg8::gemm_phase(lds, P, vcu, G); SEAM(4); }
            if (IN(5)) REP(5) { const att::Tensors T{(const bf16*)(kws() + WS_P), (const bf16*)(kws() + WS_KV), (const bf16*)(kws() + WS_KPE), kin(I_RPB), (bf16*)(kws() + WS_CAT)};
                for (int u = vcu; u < 256; u += G) att::attn_unit<0>(lds, T, u);
                for (int u = vcu; u < 256; u += G) att::attn_unit<1>(lds, T, u);
                SEAM(5); }
    }
#define COMMON_PHASES(l, cb) \
        if (IN(cb)) REP(cb) { ProbOut P{2048, 2048, 2048, 256, (const bf16*)(kws() + WS_CAT), (const bf16*)(kws() + (l == 0 ? WS_WABO : WS_WCDO)), l == 0 ? kin(I_X) : (const float*)(kws() + WS_H2), \
                               (const float*)(kws() + WS_ADA) + (size_t)l * 5 * 6 * D + 2 * D, (float*)(kws() + WS_PRE)}; \
            pg8::gemm_phase(lds, P, vcu, G); SEAM(cb); } \
        if (IN(cb + 1)) REP(cb + 1) { ln1_phase(lds, l, vcu, G); SEAM(cb + 1); } \
        if (IN(cb + 2)) REP(cb + 2) { topk_phase(lds, A, vcu, G); SEAM(cb + 2); } \
        if (IN(cb + 3)) REP(cb + 3) { ProbMoe1 P{2048, 2048, 2048, 704, (const bf16*)(kws() + WS_U2), (const int*)(kws() + WS_IDX), (const bf16*)(kws() + WS_W13) + (size_t)l * 16 * (2 * FF * D), (bf16*)(kws() + WS_HDN)}; \
            pg8::gemm_phase(lds, P, vcu, G); SEAM(cb + 3); } \
        if (IN(cb + 4)) REP(cb + 4) { ProbMoe2 P{FF, FF, FF, 512, (const bf16*)(kws() + WS_HDN), (const bf16*)(kws() + WS_W2) + (size_t)l * 16 * (D * FF), (const float*)(kws() + WS_GATE), (bf16*)(kws() + WS_YE)}; \
            pg8::gemm_phase(lds, P, vcu, G); SEAM(cb + 4); } \
        if (IN(cb + 5)) REP(cb + 5) { ln2_phase(l, vcu, G); SEAM(cb + 5); }
    COMMON_PHASES(0, 6)
    {

            if (IN(12)) REP(12) { ProbPlain P{2048, 2048, 2048, 32 * 16, (const bf16*)(kws() + WS_UALL), (const bf16*)(kws() + WS_WCD), (bf16*)(kws() + WS_P), IN_CD, 32, 16};
                pg8::gemm_phase(lds, P, vcu, G); SEAM(12); }
            if (IN(13)) REP(13) {
                if (PX_PARTS & 1) { const int tid = tid_opaque(), lane = tid & 63, wave = __builtin_amdgcn_readfirstlane(tid >> 6);
                    for (int it = vcu * NWAVES + wave; it < NB * 32 * 48; it += G * NWAVES) prep_item(lds + wave * 9600, (const bf16*)(kws() + WS_P), kin(I_CONVW), kin(I_CONVB), (bf16*)(kws() + WS_ST), it, lane); }
                __syncthreads();
                ProbF1 P{256, 256, IN_CD, 256, (const bf16*)(kws() + WS_CS256), (const bf16*)(kws() + WS_P), (bf16*)(kws() + WS_T1)};
                if (PX_PARTS & 2) pg8::gemm_phase(lds, P, vcu, G); SEAM(13); }
            if (IN(14)) REP(14) {
                if ((PX_PARTS & 1) && vcu < 128) { ProbF2 P{4096, 4096, 4096, 128, (const bf16*)(kws() + WS_CSL), (const bf16*)(kws() + WS_T1), (bf16*)(kws() + WS_CAT)}; pg8::gemm_phase(lds, P, vcu, 128); }
                { const int hs = G > 128 ? G - 128 : G, h0 = G > 128 ? vcu - 128 : vcu;
                  if ((PX_PARTS & 2) && h0 >= 0) for (int u = h0; u < 256; u += hs) hy::hyena_unit(lds, (const bf16*)(kws() + WS_ST), (const bf16*)(kws() + WS_HR), kin(I_SKIP), (bf16*)(kws() + WS_CAT), u); }
                SEAM(14); }
    }
    COMMON_PHASES(1, 15)
#undef COMMON_PHASES
#undef IN
#undef SEAM
}

extern "C" void kernel_launch(void* const* d_in, const int* in_sizes, int n_in, void* d_out, int out_size, void* d_ws, size_t ws_size, hipStream_t stream) {
    static int grid = 0;
    if (grid == 0) {
        if (n_in != 31 || out_size != MLAT * D || ws_size < WS_END) { fprintf(stderr, "kernel_launch: unexpected shapes (n_in %d, out %d, ws %zu < %zu)\n", n_in, out_size, ws_size, (size_t)WS_END); grid = -1; return; }
        int dev = 0, cus = 0, per_cu = 0;
        if (hipGetDevice(&dev) != hipSuccess || hipDeviceGetAttribute(&cus, hipDeviceAttributeMultiprocessorCount, dev) != hipSuccess) { grid = -1; return; }
        if (hipFuncSetAttribute((const void*)mk_fwd, hipFuncAttributeMaxDynamicSharedMemorySize, LDS_BYTES) != hipSuccess) { fprintf(stderr, "kernel_launch: hipFuncSetAttribute failed\n"); grid = -1; return; }
        if (hipOccupancyMaxActiveBlocksPerMultiprocessor(&per_cu, (const void*)mk_fwd, NTHR, LDS_BYTES) != hipSuccess || per_cu < 1) { fprintf(stderr, "kernel_launch: occupancy query says %d\n", per_cu); }
        (void)hipGetLastError();
        grid = cus;
    }
    if (grid < 0) return;
    (void)hipMemsetAsync((char*)d_ws + WS_CTL, 0, CTL_ZERO_BYTES, stream);
    Args a{};
    for (int i = 0; i < 31; ++i) a.in[i] = (const float*)d_in[i];
    a.out = (float*)d_out; a.ws = (unsigned char*)d_ws;
#if MK_LAUNCH_PER_PHASE
    for (int ph = 0; ph < NPHASE; ++ph) { a.ph_lo = ph; a.ph_hi = ph + 1; hipLaunchKernelGGL(mk_fwd, dim3(grid), dim3(NTHR), LDS_BYTES, stream, a); }
#else
    a.ph_lo = 0; a.ph_hi = NPHASE;
    hipLaunchKernelGGL(mk_fwd, dim3(grid), dim3(NTHR), LDS_BYTES, stream, a);
#endif
}
```

```cpp
#include <hip/hip_runtime.h>
#include <cstdio>
#include <cstdint>

#ifndef MK_LAUNCH_PER_PHASE
#define MK_LAUNCH_PER_PHASE 0
#endif

#define GAS __attribute__((address_space(1)))
#define LAS __attribute__((address_space(3)))
typedef unsigned short bf16;
typedef short bf16x8 __attribute__((ext_vector_type(8)));
typedef short s16x4 __attribute__((ext_vector_type(4)));
typedef float f32x4 __attribute__((ext_vector_type(4)));
typedef float f32x2 __attribute__((ext_vector_type(2)));
typedef float f32x16 __attribute__((ext_vector_type(16)));
typedef unsigned u32x4 __attribute__((ext_vector_type(4)));
typedef unsigned u32x2 __attribute__((ext_vector_type(2)));
#define RLX_AGENT __ATOMIC_RELAXED, __HIP_MEMORY_SCOPE_AGENT
#define LDS_WAIT() asm volatile("s_waitcnt lgkmcnt(0)" ::: "memory")
#define VM_WAIT() asm volatile("s_waitcnt vmcnt(0)" ::: "memory")

constexpr int D = 2048, NB = 4, SEQ = 2048, LC = 256, GW = 64;
constexpr int MLAT = NB * SEQ, MCTX = NB * LC, MALL = MLAT + MCTX;
constexpr int IN_AB = 5184, IN_AB_PAD = 5376;
constexpr int OFF_CKV = 1536, OFF_KPE = 2048, OFF_QNA = 2112, OFF_KNA = 3136, OFF_VNA = 4160;
constexpr int KVR = 512, NH = 8;
constexpr int FF = 1408, NE = 16, CAP = 256, NRT = NE * NB;
constexpr int IN_CD = 4096, HYW = 1024, HY3 = 3072;
constexpr float LN_EPS = 1e-6f;
constexpr float DN_ALPHA = 1.41421356237f;
constexpr int NWAVES = 8, NTHR = 512;

constexpr size_t MiB = 1u << 20;
constexpr size_t WS_CTL = 0, CTL_ZERO_BYTES = 1 * MiB;
constexpr size_t WS_ADA = 1 * MiB;
constexpr size_t WS_AFF = 2 * MiB;
constexpr size_t WS_IDX = 3 * MiB;
constexpr size_t WS_GATE = WS_IDX + 64 * 1024;
constexpr size_t WS_INV = 4 * MiB;
constexpr size_t WS_CS256 = 5 * MiB;
constexpr size_t WS_DBG = 6 * MiB;
constexpr size_t WS_WAB = 8 * MiB;
constexpr size_t WS_WUKV = 30 * MiB;
constexpr size_t WS_WABO = 32 * MiB;
constexpr size_t WS_WCD = 40 * MiB;
constexpr size_t WS_WCDO = 56 * MiB;
constexpr size_t WS_CSL = 64 * MiB;
constexpr size_t WS_HR = 80 * MiB;
constexpr size_t W13_E = (size_t)2 * FF * D * 2;
constexpr size_t W2_E = (size_t)D * FF * 2;
constexpr size_t WS_W13 = 96 * MiB;
constexpr size_t WS_W2 = WS_W13 + 32 * W13_E;
constexpr size_t WS_UALL = WS_W2 + 32 * W2_E;
constexpr size_t WS_P = WS_UALL + (size_t)MALL * D * 2;
constexpr size_t WS_CKVN = WS_P + (size_t)MALL * IN_AB_PAD * 2;
constexpr size_t WS_KPE = WS_CKVN + (size_t)MALL * KVR * 2;
constexpr size_t WS_KV = WS_KPE + (size_t)MALL * 64 * 2;
constexpr size_t WS_ST = WS_KV;
constexpr size_t WS_CAT = WS_KV + (size_t)NB * HY3 * SEQ * 2;
constexpr size_t WS_PRE = WS_CAT + (size_t)MLAT * D * 2;
constexpr size_t WS_H1 = WS_PRE + (size_t)MLAT * D * 4;
constexpr size_t WS_H2 = WS_H1 + (size_t)MLAT * D * 4;
constexpr size_t WS_U2 = WS_H2 + (size_t)MLAT * D * 4;
constexpr size_t WS_XE = WS_U2 + (size_t)MLAT * D * 2;
constexpr size_t WS_HDN = WS_XE + (size_t)NRT * CAP * D * 2;
constexpr size_t WS_YE = WS_HDN + (size_t)NRT * CAP * FF * 2;
constexpr size_t WS_T1 = WS_YE + (size_t)NRT * CAP * D * 2;
constexpr size_t WS_END = WS_T1 + (size_t)16 * 256 * 2 * 2048 * 2;
static_assert(WS_WAB + (size_t)IN_AB_PAD * D * 2 <= WS_WUKV && WS_HR + (size_t)2 * 1024 * 4096 * 2 <= WS_W13, "ws map");
static_assert(WS_END < (size_t)1400 * MiB, "ws map too large");

constexpr int LDS_MAIN = 151552;
constexpr int LDS_MISC = LDS_MAIN;
constexpr int LDS_BYTES = LDS_MAIN + 64;

__device__ __forceinline__ unsigned f2bf(float f) { unsigned u = __builtin_bit_cast(unsigned, f); return (u + 0x7fffu + ((u >> 16) & 1u)) >> 16; }
__device__ __forceinline__ unsigned pk2(float lo, float hi) { return f2bf(lo) | (f2bf(hi) << 16); }
__device__ __forceinline__ float bf2f(unsigned b) { return __builtin_bit_cast(float, b << 16); }
__device__ __forceinline__ float bflo(unsigned w) { return __builtin_bit_cast(float, w << 16); }
__device__ __forceinline__ float bfhi(unsigned w) { return __builtin_bit_cast(float, w & 0xffff0000u); }
__device__ __forceinline__ unsigned cvt_pk_bf16(float lo, float hi) { unsigned r; asm volatile("v_cvt_pk_bf16_f32 %0, %1, %2" : "=v"(r) : "v"(lo), "v"(hi)); return r; }
__device__ __forceinline__ float wave_sum(float v) {
#pragma unroll
    for (int o = 1; o < 64; o <<= 1) v += __shfl_xor(v, o);
    return v;
}
__device__ __forceinline__ int tid_opaque() { int t = threadIdx.x; asm volatile("" : "+v"(t)); return t; }
__device__ __forceinline__ float silu_f(float x) { return x / (1.f + __expf(-x)); }

#define XB_TMO      128
#define XB_XCNT(j)  (256  + 64 * (j))
#define XB_XSUB(j)  (1280 + 64 * (j))
#define XB_XGEN(j)  (2304 + 64 * (j))
#define XB_TOP      3328
#define XB_TOPGEN   3392
#define XCD_BAR_WORDS 3456
#define XB_SPIN_CAP (1u << 18)
__device__ __forceinline__ unsigned xb_ld(unsigned* p)              { return __hip_atomic_load(p, __ATOMIC_RELAXED, __HIP_MEMORY_SCOPE_AGENT); }
__device__ __forceinline__ unsigned xb_add(unsigned* p, unsigned v) { return __hip_atomic_fetch_add(p, v, __ATOMIC_RELAXED, __HIP_MEMORY_SCOPE_AGENT); }
__device__ __forceinline__ unsigned xb_xcc_id() { return (unsigned)__builtin_amdgcn_s_getreg((3 << 11) | 20) & 0xFu; }
#define XB_SPIN(cond, bar) do { unsigned _sp = 0; while (cond) { __builtin_amdgcn_s_sleep(1); \
    if ((++_sp & 255u) == 0u) { if (xb_ld(&(bar)[XB_TMO])) break; if (_sp > XB_SPIN_CAP) { atomicAdd(&(bar)[XB_TMO], 1u); break; } } } } while (0)
struct XcdBarrier { unsigned* bar; unsigned x; volatile LAS unsigned* st; };
__device__ __forceinline__ XcdBarrier xcd_barrier_post(unsigned* bar, volatile LAS unsigned* st) {
    XcdBarrier b; b.bar = bar; b.x = xb_xcc_id(); b.st = st;
    if (threadIdx.x == 0) (void)xb_add(&bar[XB_XCNT(b.x)], 1u);
    return b;
}
__device__ __forceinline__ void xcd_barrier_complete(unsigned* bar, unsigned x, unsigned& nloc, unsigned& nx) {
    const unsigned G = gridDim.x * gridDim.y * gridDim.z;
    unsigned sum, cnt, mine, sp = 0u;
    for (;;) {
        sum = 0u; cnt = 0u; mine = 0u;
#pragma unroll
        for (unsigned j = 0; j < 16; ++j) { const unsigned c = xb_ld(&bar[XB_XCNT(j)]); sum += c; cnt += (c > 0u) ? 1u : 0u; mine = (j == x) ? c : mine; }
        if (sum == G) break;
        __builtin_amdgcn_s_sleep(1);
        if ((++sp & 255u) == 0u) { if (xb_ld(&bar[XB_TMO])) break; if (sp > XB_SPIN_CAP) { atomicAdd(&bar[XB_TMO], 1u); break; } }
    }
    nloc = mine > 0u ? mine : 1u; nx = cnt > 0u ? cnt : 1u;
}
__device__ __forceinline__ void xcd_barrier(const XcdBarrier& b) {
    asm volatile("s_waitcnt vmcnt(0)" ::: "memory");
    __syncthreads();
    if (threadIdx.x == 0) {
        unsigned* bar = b.bar;
        __builtin_amdgcn_s_waitcnt(0);
        unsigned nloc = b.st[0], nx = b.st[1];
        if (nloc == 0u) { xcd_barrier_complete(bar, b.x, nloc, nx); b.st[0] = nloc; b.st[1] = nx; }
        const unsigned old = xb_add(&bar[XB_XSUB(b.x)], 1u);
        const unsigned gen = old / nloc;
        if (old + 1u == (gen + 1u) * nloc) {
            __builtin_amdgcn_fence(__ATOMIC_RELEASE, "agent");
            asm volatile("s_waitcnt vmcnt(0)" ::: "memory");
            const unsigned og = xb_add(&bar[XB_TOP], 1u);
            const unsigned tg = og / nx;
            if (og + 1u == (tg + 1u) * nx) xb_add(&bar[XB_TOPGEN], 1u);
            else XB_SPIN(xb_ld(&bar[XB_TOPGEN]) == tg, bar);
            __builtin_amdgcn_fence(__ATOMIC_ACQUIRE, "agent");
            xb_add(&bar[XB_XGEN(b.x)], 1u);
            asm volatile("s_waitcnt vmcnt(0)" ::: "memory");
        } else {
            XB_SPIN(xb_ld(&bar[XB_XGEN(b.x)]) == gen, bar);
            __builtin_amdgcn_fence(__ATOMIC_ACQUIRE, "agent");
            asm volatile("s_waitcnt vmcnt(0)" ::: "memory");
        }
    }
    __syncthreads();
}

namespace pg8 {
constexpr int BM = 256, BK = 64, HALF = 128, HTB = HALF * BK * 2, STAGE_BYTES = 8 * HTB;
__host__ __device__ __forceinline__ int lds_byte(int r, int c) { const int st = (r >> 4) * 2 + (c >> 5), rr = r & 15, cc = c & 31, ob = rr * 64 + cc * 2; return st * 1024 + (ob ^ (((ob >> 9) & 1) << 5)); }
__host__ __device__ __forceinline__ void stage_rc(int b, int& R, int& C) { const int st = b / 1024, sb = b % 1024, swz = sb ^ (((sb >> 9) & 1) << 5); R = (st >> 1) * 16 + swz / 64; C = (st & 1) * 32 + (swz % 64) / 2; }
__host__ __device__ __forceinline__ int perm32(int rho) { const int n = rho >> 4, i = rho & 15; return 8 * (i >> 2) + 4 * n + (i & 3); }

template <class Prob>
__device__ __forceinline__ void gemm_phase(LAS unsigned char* lds, const Prob& P, int u0, int ustride) {
    const int tid = tid_opaque(), wid = __builtin_amdgcn_readfirstlane(tid >> 6), lane = tid & 63, wr = wid >> 2, wc = wid & 3, fr = lane & 15, fq = lane >> 4;
    const int K = P.K, nt = K / BK;
    unsigned voffA[2], voffB[2];
#pragma unroll
    for (int i = 0; i < 2; ++i) { int R, C; stage_rc(tid * 16 + i * 8192, R, C); const int Rb = Prob::PERM ? ((R & ~31) + perm32(R & 31)) : R;
        voffA[i] = (unsigned)(R * P.lda + C) * 2u; voffB[i] = (unsigned)(Rb * P.ldb + C) * 2u; }
    const size_t kstep = (size_t)(BK * 2);
    const size_t hstepA = Prob::GATHER ? (size_t)0 : (size_t)HALF * P.lda * 2, hstepB = (size_t)HALF * P.ldb * 2;
    unsigned gvoC[2][2], gvoN[2][2];
    const unsigned ldsw = (unsigned)wid * 1024u;
    const int aoff = lds_byte(wr * 64 + fr, fq * 8), boff = lds_byte(wc * 32 + fr, fq * 8);
#define PG8_SA(b, h) (((b) * 2 + (h)) * HTB)
#define PG8_SB(b, h) ((4 + (b) * 2 + (h)) * HTB)
#define PG8_STAGE(bufoff, gbase, voff) do { _Pragma("unroll") for (int _i = 0; _i < 2; ++_i) \
        __builtin_amdgcn_global_load_lds((const unsigned*)((const char*)(gbase) + (voff)[_i]), (LAS unsigned*)(lds + (bufoff) + ldsw + _i * 8192), 16, 0, 0); } while (0)
#define PG8_STAGEA(bufoff, gbase, h, NX) do { if constexpr (Prob::GATHER) { if (NX) PG8_STAGE(bufoff, gbase, gvoN[h]); else PG8_STAGE(bufoff, gbase, gvoC[h]); } else PG8_STAGE(bufoff, (gbase) + (h) * hstepA, voffA); } while (0)
#define PG8_LDA(dst, b, h) do { _Pragma("unroll") for (int m = 0; m < 4; ++m) _Pragma("unroll") for (int k = 0; k < 2; ++k) dst[m][k] = *(const LAS bf16x8*)(lds + PG8_SA(b, h) + aoff + m * 2048 + k * 1024); } while (0)
#define PG8_LDB(dst, b, h) do { _Pragma("unroll") for (int n = 0; n < 2; ++n) _Pragma("unroll") for (int k = 0; k < 2; ++k) dst[n][k] = *(const LAS bf16x8*)(lds + PG8_SB(b, h) + boff + n * 2048 + k * 1024); } while (0)
#define PG8_MMA(ai, bj, At, Bt) do { __builtin_amdgcn_s_setprio(1); _Pragma("unroll") for (int m = 0; m < 4; ++m) _Pragma("unroll") for (int n = 0; n < 2; ++n) _Pragma("unroll") for (int k = 0; k < 2; ++k) \
        acc[ai][bj][m][n] = __builtin_amdgcn_mfma_f32_16x16x32_bf16(Bt[n][k], At[m][k], acc[ai][bj][m][n], 0, 0, 0); __builtin_amdgcn_s_setprio(0); } while (0)
#define PG8_WAIT_V(n) asm volatile("s_waitcnt vmcnt(" #n ")" ::: "memory")
#define PG8_WAIT_L(n) asm volatile("s_waitcnt lgkmcnt(" #n ")" ::: "memory")
#define PG8_BAR __builtin_amdgcn_s_barrier()
#define PG8_SCHED __builtin_amdgcn_sched_barrier(0)
    int u = u0;
    if (u >= P.nunits) return;
    f32x4 acc[2][2][4][2];
#pragma unroll
    for (int a = 0; a < 2; ++a)
#pragma unroll
        for (int b = 0; b < 2; ++b)
#pragma unroll
            for (int m = 0; m < 4; ++m)
#pragma unroll
                for (int n = 0; n < 2; ++n) acc[a][b][m][n] = (f32x4){0.f, 0.f, 0.f, 0.f};
    bf16x8 At[4][2], B0[2][2], B1[2][2];
    const char* cA; const char* cB; P.locate(u, cA, cB);
    if constexpr (Prob::GATHER) { P.aoffs(u, tid, gvoC);
#pragma unroll
        for (int h = 0; h < 2; ++h)
#pragma unroll
            for (int i = 0; i < 2; ++i) gvoN[h][i] = gvoC[h][i]; }
    PG8_STAGE(PG8_SB(0, 0), cB, voffB); PG8_STAGE(PG8_SB(0, 1), cB + hstepB, voffB); PG8_STAGEA(PG8_SA(0, 0), cA, 0, false); PG8_STAGEA(PG8_SA(0, 1), cA, 1, false);
    if (wr == 1) PG8_BAR;
    PG8_WAIT_V(2); PG8_BAR;
    PG8_STAGE(PG8_SB(1, 0), cB + kstep, voffB); PG8_STAGEA(PG8_SA(1, 0), cA + kstep, 0, false); PG8_STAGE(PG8_SB(1, 1), cB + hstepB + kstep, voffB);
    PG8_WAIT_V(6); PG8_BAR;
    for (;;) {
        const int un = u + ustride; const bool has_next = un < P.nunits;
        const char* nA = cA; const char* nB = cB; if (has_next) P.locate(un, nA, nB);
        if constexpr (Prob::GATHER) { if (has_next) P.aoffs(un, tid, gvoN); }
        for (int t = 0; t < nt; t += 2) {
            const bool last = (t == nt - 2);
            const char* a1 = cA + (size_t)(t + 1) * kstep;
            const char* a2 = last ? nA : cA + (size_t)(t + 2) * kstep; const char* b2 = last ? nB : cB + (size_t)(t + 2) * kstep;
            const char* a3 = a2 + kstep; const char* b3 = b2 + kstep;
            PG8_LDB(B0, 0, 0); PG8_LDB(B1, 0, 1); PG8_SCHED; PG8_LDA(At, 0, 0); PG8_STAGEA(PG8_SA(1, 1), a1, 1, false);
            PG8_WAIT_V(8); PG8_WAIT_L(0); PG8_BAR; PG8_MMA(0, 0, At, B0); PG8_MMA(0, 1, At, B1); PG8_BAR; PG8_SCHED;
            PG8_LDA(At, 0, 1); PG8_STAGE(PG8_SB(0, 0), b2, voffB); PG8_STAGE(PG8_SB(0, 1), b2 + hstepB, voffB); PG8_STAGEA(PG8_SA(0, 0), a2, 0, last);
            PG8_WAIT_V(8); PG8_WAIT_L(0); PG8_BAR; PG8_MMA(1, 0, At, B0); PG8_MMA(1, 1, At, B1); PG8_BAR; PG8_SCHED;
            PG8_LDB(B0, 1, 0); PG8_LDB(B1, 1, 1); PG8_SCHED; PG8_LDA(At, 1, 0); PG8_STAGEA(PG8_SA(0, 1), a2, 1, last);
            PG8_WAIT_V(8); PG8_WAIT_L(0); PG8_BAR; PG8_MMA(0, 0, At, B0); PG8_MMA(0, 1, At, B1); PG8_BAR; PG8_SCHED;
            PG8_LDA(At, 1, 1); PG8_STAGE(PG8_SB(1, 0), b3, voffB); PG8_STAGE(PG8_SB(1, 1), b3 + hstepB, voffB); PG8_STAGEA(PG8_SA(1, 0), a3, 0, last);
            PG8_WAIT_V(8); PG8_WAIT_L(0); PG8_BAR; PG8_MMA(1, 0, At, B0); PG8_MMA(1, 1, At, B1); PG8_BAR; PG8_SCHED;
        }
        if (wr == 0) PG8_BAR;
        P.epi(acc, u, wr, wc, fr, fq);
        if (!has_next) break;
#pragma unroll
        for (int a = 0; a < 2; ++a)
#pragma unroll
            for (int b = 0; b < 2; ++b)
#pragma unroll
                for (int m = 0; m < 4; ++m)
#pragma unroll
                    for (int n = 0; n < 2; ++n) acc[a][b][m][n] = (f32x4){0.f, 0.f, 0.f, 0.f};
        u = un; cA = nA; cB = nB;
        if constexpr (Prob::GATHER) {
#pragma unroll
            for (int h = 0; h < 2; ++h)
#pragma unroll
                for (int i = 0; i < 2; ++i) gvoC[h][i] = gvoN[h][i]; }
        if (wr == 1) PG8_BAR;
    }
    PG8_WAIT_V(0);
    PG8_BAR;
#undef PG8_SA
#undef PG8_SB
#undef PG8_STAGE
#undef PG8_STAGEA
#undef PG8_LDA
#undef PG8_LDB
#undef PG8_MMA
#undef PG8_WAIT_V
#undef PG8_WAIT_L
#undef PG8_BAR
#undef PG8_SCHED
}
__device__ __forceinline__ void tile_of(int u, int nM, int nN, int& pm, int& pn) {
    const int nig = 8 * nN, g = u / nig, r = u % nig, fm = g * 8, gsz = (nM - fm) < 8 ? (nM - fm) : 8;
    pm = fm + r % gsz; pn = r / gsz;
}
__device__ __forceinline__ void st8(bf16* p, f32x4 v0, f32x4 v1) {
    u32x4 w; w.x = cvt_pk_bf16(v0[0], v0[1]); w.y = cvt_pk_bf16(v0[2], v0[3]); w.z = cvt_pk_bf16(v1[0], v1[1]); w.w = cvt_pk_bf16(v1[2], v1[3]);
    *(u32x4*)p = w;
}
}

typedef __bf16 bf16x2_t __attribute__((ext_vector_type(2)));
__device__ __forceinline__ unsigned cvtpk(float lo, float hi) { f32x2 v = {lo, hi}; bf16x2_t b = __builtin_convertvector(v, bf16x2_t); return __builtin_bit_cast(unsigned, b); }

struct ProbPlain {
    static constexpr bool GATHER = false; static constexpr bool PERM = true;
    int K, lda, ldb, nunits; const bf16* A; const bf16* Bt; bf16* O; int ldc, nM, nN;
    __device__ __forceinline__ void locate(int u, const char*& a, const char*& b) const { int pm, pn; pg8::tile_of(u, nM, nN, pm, pn); a = (const char*)(A + (size_t)pm * 256 * lda); b = (const char*)(Bt + (size_t)pn * 256 * ldb); }
    __device__ __forceinline__ void epi(const f32x4 (&acc)[2][2][4][2], int u, int wr, int wc, int fr, int fq) const {
        int pm, pn; pg8::tile_of(u, nM, nN, pm, pn);
        const int row0 = pm * 256 + wr * 64 + fr, col0 = pn * 256 + wc * 32 + 8 * fq;
#pragma unroll
        for (int ai = 0; ai < 2; ++ai)
#pragma unroll
            for (int m = 0; m < 4; ++m) { bf16* rowp = O + (size_t)(row0 + ai * 128 + m * 16) * ldc + col0;
#pragma unroll
                for (int bj = 0; bj < 2; ++bj) pg8::st8(rowp + bj * 128, acc[ai][bj][m][0], acc[ai][bj][m][1]); }
    }
};
struct ProbOut {
    static constexpr bool GATHER = false; static constexpr bool PERM = false;
    int K, lda, ldb, nunits; const bf16* A; const bf16* Bt; const float* h; const float* gate; float* pre;
    __device__ __forceinline__ void locate(int u, const char*& a, const char*& b) const { int pm, pn; pg8::tile_of(u, 32, 8, pm, pn); a = (const char*)(A + (size_t)pm * 256 * lda); b = (const char*)(Bt + (size_t)pn * 256 * ldb); }
    __device__ __forceinline__ void epi(const f32x4 (&acc)[2][2][4][2], int u, int wr, int wc, int fr, int fq) const {
        int pm, pn; pg8::tile_of(u, 32, 8, pm, pn);
        const int row0 = pm * 256 + wr * 64 + fr, col0 = pn * 256 + wc * 32 + 4 * fq;
        const float* g = gate + (size_t)(pm >> 3) * (6 * D);
        f32x4 gv[2][2];
#pragma unroll
        for (int bj = 0; bj < 2; ++bj)
#pragma unroll
            for (int n = 0; n < 2; ++n) gv[bj][n] = *(const f32x4*)(g + col0 + bj * 128 + n * 16);
#pragma unroll
        for (int ai = 0; ai < 2; ++ai)
#pragma unroll
            for (int m = 0; m < 4; ++m) { const size_t off = (size_t)(row0 + ai * 128 + m * 16) * D + col0;
#pragma unroll
                for (int bj = 0; bj < 2; ++bj)
#pragma unroll
                    for (int n = 0; n < 2; ++n) { const f32x4 hv = *(const f32x4*)(h + off + bj * 128 + n * 16);
                        *(f32x4*)(pre + off + bj * 128 + n * 16) = hv * DN_ALPHA + gv[bj][n] * acc[ai][bj][m][n]; } }
    }
};
struct ProbMoe1 {
    static constexpr bool GATHER = true; static constexpr bool PERM = true;
    int K, lda, ldb, nunits; const bf16* U2; const int* IDX; const bf16* W13; bf16* HDN;
    __device__ __forceinline__ void map(int u, int& rt, int& pn) const { const int b = u & 3, q = u >> 2; pn = q % 11; rt = (q / 11) * 4 + b; }
    __device__ __forceinline__ void locate(int u, const char*& a, const char*& b) const { int rt, pn; map(u, rt, pn); a = (const char*)U2; b = (const char*)(W13 + (size_t)(rt >> 2) * (2 * FF * D) + (size_t)pn * 256 * D); }
    __device__ __forceinline__ void aoffs(int u, int tid, unsigned (&vo)[2][2]) const { int rt, pn; map(u, rt, pn);
#pragma unroll
        for (int i = 0; i < 2; ++i) { int R, C; pg8::stage_rc(tid * 16 + i * 8192, R, C);
#pragma unroll
            for (int h = 0; h < 2; ++h) { const int row = (rt & 3) * SEQ + IDX[rt * CAP + h * 128 + R]; vo[h][i] = (unsigned)(row * D + C) * 2u; } } }
    __device__ __forceinline__ void epi(const f32x4 (&acc)[2][2][4][2], int u, int wr, int wc, int fr, int fq) const {
        int rt, pn; map(u, rt, pn);
        const int row0 = rt * 256 + wr * 64 + fr, col0 = pn * 128 + wc * 32 + 8 * fq;
#pragma unroll
        for (int ai = 0; ai < 2; ++ai)
#pragma unroll
            for (int m = 0; m < 4; ++m) { bf16* rowp = HDN + (size_t)(row0 + ai * 128 + m * 16) * FF + col0;
                f32x4 v[2];
#pragma unroll
                for (int n = 0; n < 2; ++n) { const f32x4 a = acc[ai][0][m][n], g = acc[ai][1][m][n];
#pragma unroll
                    for (int j = 0; j < 4; ++j) v[n][j] = a[j] / (1.f + __expf(-a[j])) * g[j]; }
                pg8::st8(rowp, v[0], v[1]); }
    }
};
struct ProbMoe2 {
    static constexpr bool GATHER = false; static constexpr bool PERM = true;
    int K, lda, ldb, nunits; const bf16* HDN; const bf16* W2; const float* gate; bf16* YE;
    __device__ __forceinline__ void map(int u, int& rt, int& pn) const { const int b = u & 3, q = u >> 2; pn = q & 7; rt = (q >> 3) * 4 + b; }
    __device__ __forceinline__ void locate(int u, const char*& a, const char*& b) const { int rt, pn; map(u, rt, pn); a = (const char*)(HDN + (size_t)rt * 256 * FF); b = (const char*)(W2 + (size_t)(rt >> 2) * (D * FF) + (size_t)pn * 256 * FF); }
    __device__ __forceinline__ void epi(const f32x4 (&acc)[2][2][4][2], int u, int wr, int wc, int fr, int fq) const {
        int rt, pn; map(u, rt, pn);
        const int row0 = rt * 256 + wr * 64 + fr, col0 = pn * 256 + wc * 32 + 8 * fq;
#pragma unroll
        for (int ai = 0; ai < 2; ++ai)
#pragma unroll
            for (int m = 0; m < 4; ++m) { const int row = row0 + ai * 128 + m * 16; const float gt = gate[row]; bf16* rowp = YE + (size_t)row * D + col0;
#pragma unroll
                for (int bj = 0; bj < 2; ++bj) pg8::st8(rowp + bj * 128, acc[ai][bj][m][0] * gt, acc[ai][bj][m][1] * gt); }
    }
};
struct ProbF1 {
    static constexpr bool GATHER = false; static constexpr bool PERM = true;
    int K, lda, ldb, nunits; const bf16* CS; const bf16* P1; bf16* T1;
    __device__ __forceinline__ void map(int u, int& bg, int& pm, int& pn) const { pn = u & 7; pm = (u >> 3) & 1; bg = u >> 4; }
    __device__ __forceinline__ void locate(int u, const char*& a, const char*& b) const { int bg, pm, pn; map(u, bg, pm, pn);
        a = (const char*)(CS + (size_t)pm * 256 * 256); b = (const char*)(P1 + ((size_t)(bg >> 2) * SEQ + (size_t)pn * 256) * IN_CD + HY3 + (bg & 3) * 256); }
    __device__ __forceinline__ void epi(const f32x4 (&acc)[2][2][4][2], int u, int wr, int wc, int fr, int fq) const {
        int bg, pm, pn; map(u, bg, pm, pn);
        const int k20 = wr * 64 + fr, col0 = pn * 256 + wc * 32 + 8 * fq;
#pragma unroll
        for (int ai = 0; ai < 2; ++ai)
#pragma unroll
            for (int m = 0; m < 4; ++m) { const int k2 = k20 + ai * 128 + m * 16; bf16* rowp = T1 + (((size_t)bg * 256 + k2) * 2 + pm) * SEQ + col0;
#pragma unroll
                for (int bj = 0; bj < 2; ++bj) pg8::st8(rowp + bj * 128, acc[ai][bj][m][0], acc[ai][bj][m][1]); }
    }
};
struct ProbF2 {
    static constexpr bool GATHER = false; static constexpr bool PERM = true;
    int K, lda, ldb, nunits; const bf16* CSL; const bf16* T1; bf16* CAT;
    __device__ __forceinline__ void locate(int u, const char*& a, const char*& b) const { const int pm = u & 7, bg = u >> 3; a = (const char*)(CSL + (size_t)pm * 256 * 4096); b = (const char*)(T1 + (size_t)bg * 256 * 4096); }
    __device__ __forceinline__ void epi(const f32x4 (&acc)[2][2][4][2], int u, int wr, int wc, int fr, int fq) const {
        const int pm = u & 7, bg = u >> 3;
        const int row0 = (bg >> 2) * SEQ + pm * 256 + wr * 64 + fr, col0 = 1024 + (bg & 3) * 256 + wc * 32 + 8 * fq;
#pragma unroll
        for (int ai = 0; ai < 2; ++ai)
#pragma unroll
            for (int m = 0; m < 4; ++m) { bf16* rowp = CAT + (size_t)(row0 + ai * 128 + m * 16) * D + col0;
#pragma unroll
                for (int bj = 0; bj < 2; ++bj) pg8::st8(rowp + bj * 128, acc[ai][bj][m][0], acc[ai][bj][m][1]); }
    }
};

namespace att {
typedef short v4i16_t __attribute__((ext_vector_type(4)));
__device__ __forceinline__ s16x4 vtr(const LAS unsigned char* p) { return __builtin_bit_cast(s16x4, __builtin_amdgcn_ds_read_tr16_b64_v4i16((LAS v4i16_t*)p)); }
constexpr int VS = 320;
struct Tensors { const bf16* P; const bf16* KV; const bf16* KPE; const float* rpb; bf16* CAT; };

template <int MODE>
__device__ __forceinline__ void attn_unit(LAS unsigned char* lds, const Tensors& T, int unit) {
    constexpr int DK = MODE == 0 ? 192 : 128, NS = DK / 16, KCH = DK / 8, KS = DK * 2 + 16;
    constexpr int KBYTES = 64 * KS, VBYTES = 64 * VS, BUF = KBYTES + VBYTES;
    constexpr int NKC = (64 * KCH) / NTHR;
    const int tid = tid_opaque(), wave = __builtin_amdgcn_readfirstlane(tid >> 6), lane = tid & 63, l32 = lane & 31, hf = lane >> 5;
    const int b = unit >> 6, h = (unit >> 3) & 7, sub = unit & 7;
    LAS float* rpb_l = (LAS float*)(lds + 2 * BUF);
    int qrow, r = 0, qc = 0, krlo = 0, nkt;
    if (MODE == 0) { qrow = b * SEQ + sub * 256 + wave * 32 + l32; nkt = 36; }
    else { r = sub * 4 + (wave >> 1); qc = (wave & 1) * 32 + l32; qrow = b * SEQ + r * GW + qc;
        const int r0 = sub * 4, r3 = r0 + 3; krlo = r0 - 4 < 0 ? 0 : (r0 - 4 > 24 ? 24 : r0 - 4); const int rs3 = r3 - 4 < 0 ? 0 : (r3 - 4 > 24 ? 24 : r3 - 4);
        nkt = 4 + (rs3 + 8 - krlo); }
    const int rs = r - 4 < 0 ? 0 : (r - 4 > 24 ? 24 : r - 4);
    const int cs = qc - 8 < 0 ? 0 : (qc - 8 > 48 ? 48 : qc - 8);
    bf16x8 qf[NS];
    { const bf16* qp = T.P + (size_t)qrow * IN_AB_PAD + (MODE == 0 ? h * 192 : OFF_QNA + h * 128) + 8 * hf;
#pragma unroll
      for (int s = 0; s < NS; ++s) qf[s] = *(const bf16x8*)(qp + 16 * s); }
    if (MODE == 1) { for (int i = tid; i < 15 * 31; i += NTHR) rpb_l[i] = T.rpb[h * 465 + i]; }
    u32x4 kreg[NKC], vreg[2];
    auto key_row = [&](int kt, int rr) -> int {
        if (MODE == 0) return kt < 32 ? b * SEQ + kt * 64 + rr : MLAT + b * LC + (kt - 32) * 64 + rr;
        return kt < 4 ? MLAT + b * LC + kt * 64 + rr : b * SEQ + (krlo + kt - 4) * GW + rr;
    };
    auto load_tile = [&](int kt) {
#pragma unroll
        for (int i = 0; i < NKC; ++i) { const int ci = tid + i * NTHR, rr = ci / KCH, c = ci % KCH; const int row = key_row(kt, rr);
            const bf16* src;
            if (MODE == 0) src = c < 16 ? T.KV + (size_t)row * D + h * 256 + c * 8 : T.KPE + (size_t)row * 64 + (c - 16) * 8;
            else src = T.P + (size_t)row * IN_AB_PAD + OFF_KNA + h * 128 + c * 8;
            kreg[i] = *(const u32x4*)src; }
#pragma unroll
        for (int i = 0; i < 2; ++i) { const int ci = tid + i * NTHR, rr = ci >> 4, c = ci & 15; const int row = key_row(kt, rr);
            const bf16* src = MODE == 0 ? T.KV + (size_t)row * D + h * 256 + 128 + c * 8 : T.P + (size_t)row * IN_AB_PAD + OFF_VNA + h * 128 + c * 8;
            vreg[i] = *(const u32x4*)src; }
    };
    auto store_tile = [&](int buf) {
        LAS unsigned char* kb = lds + buf * BUF; LAS unsigned char* vb = kb + KBYTES;
#pragma unroll
        for (int i = 0; i < NKC; ++i) { const int ci = tid + i * NTHR, rr = ci / KCH, c = ci % KCH; *(LAS u32x4*)(kb + rr * KS + c * 16) = kreg[i]; }
#pragma unroll
        for (int i = 0; i < 2; ++i) { const int ci = tid + i * NTHR, rr = ci >> 4, c = ci & 15; *(LAS u32x4*)(vb + rr * VS + c * 16) = vreg[i]; }
    };
    f32x16 o[4];
#pragma unroll
    for (int c = 0; c < 4; ++c)
#pragma unroll
        for (int i = 0; i < 16; ++i) o[c][i] = 0.f;
    float m_run = -1e30f, l_run = 0.f;
    const float sc2 = (MODE == 0 ? 0.07216878364870322f : 0.08838834764831845f) * 1.4426950408889634f;
    load_tile(0); store_tile(0); __syncthreads();
    for (int kt = 0; kt < nkt; ++kt) {
        if (kt + 1 < nkt) load_tile(kt + 1);
        const int kr = krlo + kt - 4;
        const bool active = MODE == 0 || kt < 4 || (kr >= rs && kr < rs + 8);
        if (active) {
            const LAS unsigned char* kb = lds + (kt & 1) * BUF; const LAS unsigned char* vb = kb + KBYTES;
#pragma unroll
            for (int kb2 = 0; kb2 < 2; ++kb2) {
                f32x16 sc;
#pragma unroll
                for (int i = 0; i < 16; ++i) sc[i] = 0.f;
#pragma unroll
                for (int s = 0; s < NS; ++s) { const bf16x8 kf = *(const LAS bf16x8*)(kb + (32 * kb2 + l32) * KS + (16 * s + 8 * hf) * 2);
                    sc = __builtin_amdgcn_mfma_f32_32x32x16_bf16(kf, qf[s], sc, 0, 0, 0); }
                float mx = -1e30f;
#pragma unroll
                for (int i = 0; i < 16; ++i) {
                    float v = sc[i] * sc2;
                    if (MODE == 1 && kt >= 4) { const int kc = 32 * kb2 + 8 * (i >> 2) + 4 * hf + (i & 3); const int dcl = kc - cs; const bool ok = (unsigned)dcl < 16u;
                        int bi = (kr - r + 7) * 31 + (kc - qc + 15); bi = ok ? bi : 0;
                        v = ok ? v + rpb_l[bi] * 1.4426950408889634f : -1e30f; }
                    sc[i] = v; mx = fmaxf(mx, v); }
                mx = fmaxf(mx, __shfl_xor(mx, 32));
                const float m_new = fmaxf(m_run, mx), alpha = __builtin_amdgcn_exp2f(m_run - m_new);
                m_run = m_new;
                float ps = 0.f;
#pragma unroll
                for (int i = 0; i < 16; ++i) { const float p = __builtin_amdgcn_exp2f(sc[i] - m_new); sc[i] = p; ps += p; }
                l_run = l_run * alpha + ps;
                if (__builtin_amdgcn_ballot_w64(alpha != 1.f) != 0ull) {
#pragma unroll
                    for (int c = 0; c < 4; ++c)
#pragma unroll
                        for (int i = 0; i < 16; ++i) o[c][i] *= alpha; }
#pragma unroll
                for (int s2 = 0; s2 < 2; ++s2) {
                    u32x4 pw; pw.x = cvtpk(sc[8 * s2 + 0], sc[8 * s2 + 1]); pw.y = cvtpk(sc[8 * s2 + 2], sc[8 * s2 + 3]);
                    pw.z = cvtpk(sc[8 * s2 + 4], sc[8 * s2 + 5]); pw.w = cvtpk(sc[8 * s2 + 6], sc[8 * s2 + 7]);
                    const bf16x8 pf = __builtin_bit_cast(bf16x8, pw);
                    const LAS unsigned char* vrow = vb + (32 * kb2 + 16 * s2 + 4 * hf + ((lane & 15) >> 2)) * VS + (16 * ((lane >> 4) & 1) + 4 * (lane & 3)) * 2;
#pragma unroll
                    for (int c = 0; c < 4; ++c) {
                        const s16x4 v0 = vtr(vrow + c * 64), v1 = vtr(vrow + 8 * VS + c * 64);
                        const bf16x8 vf = {v0[0], v0[1], v0[2], v0[3], v1[0], v1[1], v1[2], v1[3]};
                        o[c] = __builtin_amdgcn_mfma_f32_32x32x16_bf16(vf, pf, o[c], 0, 0, 0); }
                }
            }
        }
        if (kt + 1 < nkt) store_tile((kt + 1) & 1);
        __syncthreads();
    }
    const float linv = 1.f / (l_run + __shfl_xor(l_run, 32));
    bf16* op = T.CAT + (size_t)qrow * D + (MODE == 0 ? h * 128 : 1024 + h * 128) + 4 * hf;
#pragma unroll
    for (int c = 0; c < 4; ++c)
#pragma unroll
        for (int g = 0; g < 4; ++g) { u32x2 w; w.x = cvtpk(o[c][4 * g] * linv, o[c][4 * g + 1] * linv); w.y = cvtpk(o[c][4 * g + 2] * linv, o[c][4 * g + 3] * linv);
            *(u32x2*)(op + 32 * c + 8 * g) = w; }
}
}

namespace hy {
constexpr int ZROW = 4800;
constexpr int Z_BYTES = 16 * ZROW;
constexpr int HR_OFF = 76800;
constexpr int HR_CH = 16384 + 64, HR_C1 = 8192 + 64;
constexpr int XROW = 4096 + 16;
constexpr int HR_BYTES = 16 * XROW;
static_assert(HR_OFF + HR_BYTES <= LDS_MAIN && HR_OFF >= Z_BYTES && HR_BYTES >= 4 * HR_CH, "hyena LDS map");

__device__ __forceinline__ void load_rows(LAS unsigned char* lds, const bf16* ST, int part, int c0, bool zlayout) {
    const int tid = tid_opaque();
#pragma unroll
    for (int i = 0; i < 8; ++i) { const int ci = tid + i * NTHR, row = ci >> 8, cc = ci & 255, ch = row >> 2, b = row & 3;
        const u32x4 v = *(const u32x4*)(ST + ((size_t)(b * HY3 + part * HYW + c0 + ch) * SEQ + cc * 8));
        if (zlayout) *(LAS u32x4*)(lds + row * ZROW + (cc >> 3) * 144 + (cc & 7) * 16) = v;
        else *(LAS u32x4*)(lds + HR_OFF + row * XROW + cc * 16) = v; }
}
__device__ __forceinline__ void load_hr(LAS unsigned char* lds, const bf16* HRg, int o, int c0) {
    const int tid = tid_opaque();
#pragma unroll
    for (int i = 0; i < 4; ++i) { const int ci = tid + i * NTHR, ch = ci >> 9, cc = ci & 511;
        const unsigned* src = (const unsigned*)(HRg + ((size_t)(o * HYW + c0 + ch) * 4096 + cc * 8));
        const u32x4 v = *(const u32x4*)src; const unsigned nx = cc == 511 ? 0u : src[4];
        *(LAS u32x4*)(lds + HR_OFF + ch * HR_CH + cc * 16) = v;
        u32x4 s; s.x = (v.x >> 16) | (v.y << 16); s.y = (v.y >> 16) | (v.z << 16); s.z = (v.z >> 16) | (v.w << 16); s.w = (v.w >> 16) | (nx << 16);
        *(LAS u32x4*)(lds + HR_OFF + ch * HR_CH + HR_C1 + cc * 16) = s; }
}
struct ConvAddr { const LAS unsigned char* a; const LAS unsigned char* b[4]; };
__device__ __forceinline__ void conv_addr(ConvAddr& c, const LAS unsigned char* hrc, const LAS unsigned char* zl, int d, int xb, int il) {
    const int x0 = xb - 64 * d;
    c.a = hrc + (x0 & 1) * HR_C1 + (x0 >> 1) * 4;
    const int j0 = il - d;
#pragma unroll
    for (int n = 0; n < 4; ++n) { const int j = j0 + 8 * n; c.b[n] = zl + ((unsigned)j < 32u ? j : 32) * 144; }
}
template <int K4, int MASK>
__device__ __forceinline__ void conv_load(const ConvAddr& c, u32x4& a, u32x4 (&b)[4]) {
    const LAS unsigned* ap = (const LAS unsigned*)(c.a + K4 * 32);
    a.x = ap[0]; a.y = ap[1]; a.z = ap[2]; a.w = ap[3];
#pragma unroll
    for (int n = 0; n < 4; ++n) if ((MASK >> n) & 1) b[n] = *(const LAS u32x4*)(c.b[n] + K4 * 32);
}
template <int MASK>
__device__ __forceinline__ void conv_step(f32x16 (&acc)[4], const u32x4& a, const u32x4 (&b)[4]) {
    const bf16x8 af = __builtin_bit_cast(bf16x8, a);
#pragma unroll
    for (int n = 0; n < 4; ++n) if ((MASK >> n) & 1) acc[n] = __builtin_amdgcn_mfma_f32_32x32x16_bf16(af, __builtin_bit_cast(bf16x8, b[n]), acc[n], 0, 0, 0);
}
template <int MASK>
__device__ __forceinline__ void conv_seg(f32x16 (&acc)[4], const LAS unsigned char* hrc, const LAS unsigned char* zl, int xb, int il, int dlo, int dhi) {
    u32x4 fa0, fb0[4], fa1, fb1[4], fa2, fb2[4], fa3, fb3[4];
    ConvAddr ca; conv_addr(ca, hrc, zl, dlo, xb, il);
    conv_load<0, MASK>(ca, fa0, fb0); conv_load<1, MASK>(ca, fa1, fb1);
#pragma unroll 1
    for (int d = dlo; d <= dhi; ++d) {
        ConvAddr cn; conv_addr(cn, hrc, zl, d < dhi ? d + 1 : dhi, xb, il);
        conv_load<2, MASK>(ca, fa2, fb2); conv_step<MASK>(acc, fa0, fb0);
        conv_load<3, MASK>(ca, fa3, fb3); conv_step<MASK>(acc, fa1, fb1);
        conv_load<0, MASK>(cn, fa0, fb0); conv_step<MASK>(acc, fa2, fb2);
        conv_load<1, MASK>(cn, fa1, fb1); conv_step<MASK>(acc, fa3, fb3);
        ca = cn;
    }
}
__device__ __forceinline__ void conv_mma(LAS unsigned char* lds, f32x16 (&acc)[4], int wave, int lane) {
    const int ch = wave >> 1, a0 = (wave & 1) * 32, l32 = lane & 31, hf = lane >> 5, il = l32 >> 2, b = l32 & 3;
    const LAS unsigned char* hrc = lds + HR_OFF + ch * HR_CH;
    const LAS unsigned char* zl = lds + (ch * 4 + b) * ZROW + hf * 16;
    const int xb = 2048 - a0 - l32 + 8 * hf;
#pragma unroll
    for (int n = 0; n < 4; ++n)
#pragma unroll
        for (int i = 0; i < 16; ++i) acc[n][i] = 0.f;
    conv_seg<0x1>(acc, hrc, zl, xb, il, -31, -24);
    conv_seg<0x3>(acc, hrc, zl, xb, il, -23, -16);
    conv_seg<0x7>(acc, hrc, zl, xb, il, -15, -8);
    conv_seg<0xF>(acc, hrc, zl, xb, il, -7, 7);
    conv_seg<0xE>(acc, hrc, zl, xb, il, 8, 15);
    conv_seg<0xC>(acc, hrc, zl, xb, il, 16, 23);
    conv_seg<0x8>(acc, hrc, zl, xb, il, 24, 31);
}
__device__ __forceinline__ void gate_epi(LAS unsigned char* lds, f32x16 (&acc)[4], float skip, int wave, int lane) {
    const int ch = wave >> 1, a0 = (wave & 1) * 32, l32 = lane & 31, hf = lane >> 5, il = l32 >> 2, b = l32 & 3;
#pragma unroll
    for (int n = 0; n < 4; ++n)
#pragma unroll
        for (int g = 0; g < 4; ++g) { const int i = 8 * n + il, ao = a0 + 8 * g + 4 * hf;
            const u32x2 zw = *(const LAS u32x2*)(lds + (ch * 4 + b) * ZROW + i * 144 + ao * 2);
            const u32x2 xw = *(const LAS u32x2*)(lds + HR_OFF + (ch * 4 + b) * XROW + (64 * i + ao) * 2);
            acc[n][4 * g + 0] = bflo(xw.x) * (acc[n][4 * g + 0] + skip * bflo(zw.x));
            acc[n][4 * g + 1] = bfhi(xw.x) * (acc[n][4 * g + 1] + skip * bfhi(zw.x));
            acc[n][4 * g + 2] = bflo(xw.y) * (acc[n][4 * g + 2] + skip * bflo(zw.y));
            acc[n][4 * g + 3] = bfhi(xw.y) * (acc[n][4 * g + 3] + skip * bfhi(zw.y)); }
}
__device__ __forceinline__ void hyena_unit(LAS unsigned char* lds, const bf16* ST, const bf16* HRg, const float* skip, bf16* CAT, int unit) {
    const int tid = tid_opaque(), wave = __builtin_amdgcn_readfirstlane(tid >> 6), lane = tid & 63;
    const int c0 = unit * 4, ch = wave >> 1, a0 = (wave & 1) * 32, l32 = lane & 31, hf = lane >> 5, il = l32 >> 2, b = l32 & 3;
    f32x16 acc[4];
    load_rows(lds, ST, 0, c0, true); load_hr(lds, HRg, 0, c0);
    if (tid < 128) *(LAS u32x4*)(lds + (tid >> 3) * ZROW + 32 * 144 + (tid & 7) * 16) = (u32x4){0u, 0u, 0u, 0u};
    __syncthreads();
    conv_mma(lds, acc, wave, lane);
    __syncthreads();
    load_rows(lds, ST, 1, c0, false);
    __syncthreads();
    gate_epi(lds, acc, skip[c0 + ch], wave, lane);
    __syncthreads();
#pragma unroll
    for (int n = 0; n < 4; ++n)
#pragma unroll
        for (int g = 0; g < 4; ++g) { const int i = 8 * n + il, ao = a0 + 8 * g + 4 * hf;
            u32x2 w; w.x = cvtpk(acc[n][4 * g], acc[n][4 * g + 1]); w.y = cvtpk(acc[n][4 * g + 2], acc[n][4 * g + 3]);
            *(LAS u32x2*)(lds + (ch * 4 + b) * ZROW + i * 144 + ao * 2) = w; }
    load_hr(lds, HRg, 1, c0);
    __syncthreads();
    conv_mma(lds, acc, wave, lane);
    __syncthreads();
    load_rows(lds, ST, 2, c0, false);
    __syncthreads();
    gate_epi(lds, acc, skip[HYW + c0 + ch], wave, lane);
    __syncthreads();
    LAS bf16* Y = (LAS bf16*)lds;
#pragma unroll
    for (int n = 0; n < 4; ++n)
#pragma unroll
        for (int e = 0; e < 16; ++e) { const int t = 64 * (8 * n + il) + a0 + 8 * (e >> 2) + 4 * hf + (e & 3);
            Y[(b * SEQ + t) * 4 + ch] = (bf16)f2bf(acc[n][e]); }
    __syncthreads();
#pragma unroll 4
    for (int i = 0; i < 16; ++i) { const int it = tid + i * NTHR; const u32x2 v = *(const LAS u32x2*)(lds + it * 8);
        *(u32x2*)(CAT + (size_t)it * D + c0) = v; }
    __syncthreads();
}
}

__device__ __forceinline__ void prep_item(LAS unsigned char* scr, const bf16* P1, const float* cw, const float* cb, bf16* ST, int item, int lane) {
    const int ct = item % 48, tt = (item / 48) & 31, b = item / (48 * 32), t0 = tt * 64, c30 = ct * 64;
#pragma unroll
    for (int i = 0; i < 9; ++i) { const int ci = lane + i * 64; if (ci < 66 * 8) { const int rr = ci >> 3, cc = ci & 7, t = t0 - 1 + rr;
        u32x4 v = (u32x4){0u, 0u, 0u, 0u};
        if (t >= 0 && t < SEQ) v = *(const u32x4*)(P1 + ((size_t)(b * SEQ + t) * IN_CD + c30 + cc * 8));
        *(LAS u32x4*)(scr + rr * 144 + cc * 16) = v; } }
    LDS_WAIT(); asm volatile("" ::: "memory");
    const LAS bf16* tile = (const LAS bf16*)scr;
    for (int c = 0; c < 64; ++c) { const int c3 = c30 + c;
        const float w0 = cw[c3], w1 = cw[HY3 + c3], w2 = cw[2 * HY3 + c3], bb = cb[c3];
        const float v = bb + w0 * bf2f(tile[lane * 72 + c]) + w1 * bf2f(tile[(lane + 1) * 72 + c]) + w2 * bf2f(tile[(lane + 2) * 72 + c]);
        ST[(size_t)(b * HY3 + c3) * SEQ + t0 + lane] = (bf16)f2bf(v); }
    LDS_WAIT(); asm volatile("" ::: "memory");
}

__device__ __forceinline__ void transpose_item(const float* W, int N, bf16* WT, int ldt, int k0, int n0, int drow0, LAS float* scr, int lane) {
    const int r = lane >> 4, c4 = lane & 15;
    f32x4 v[16];
#pragma unroll
    for (int i = 0; i < 16; ++i) v[i] = __builtin_nontemporal_load((const f32x4*)(W + (size_t)(k0 + 4 * i + r) * N + n0 + 4 * c4));
#pragma unroll
    for (int i = 0; i < 16; ++i) { LAS float* d = scr + (4 * i + r) * 65 + 4 * c4; d[0] = v[i][0]; d[1] = v[i][1]; d[2] = v[i][2]; d[3] = v[i][3]; }
    LDS_WAIT(); asm volatile("" ::: "memory");
    const int c = lane & 7;
#pragma unroll
    for (int j = 0; j < 8; ++j) { const int n = (lane >> 3) + 8 * j; const LAS float* s = scr + (8 * c) * 65 + n;
        u32x4 o; o.x = pk2(s[0 * 65], s[1 * 65]); o.y = pk2(s[2 * 65], s[3 * 65]); o.z = pk2(s[4 * 65], s[5 * 65]); o.w = pk2(s[6 * 65], s[7 * 65]);
        *(u32x4*)(WT + (size_t)(drow0 + n) * ldt + k0 + 8 * c) = o; }
    LDS_WAIT(); asm volatile("" ::: "memory");
}
struct Args { const float* in[31]; float* out; unsigned char* ws; int ph_lo, ph_hi; };
enum { I_X = 0, I_C, I_CTX, I_CCTX, I_ADAW, I_ADAB, I_LN1G, I_LN1B, I_LN2G, I_LN2B, I_ROUTER, I_W1, I_W3, I_W2, I_ABIN, I_KVNORM, I_UKV, I_RPB, I_ABOUT,
       I_CDIN, I_CONVW, I_CONVB, I_FW1, I_FB1, I_FF1, I_FW2, I_FB2, I_FF2, I_FW3, I_SKIP, I_CDOUT };
constexpr int NPHASE = 21;
typedef const char __attribute__((address_space(4)))* kptr_t;
__device__ __forceinline__ const float* kin(int i) { kptr_t ka = (kptr_t)__builtin_amdgcn_kernarg_segment_ptr(); int off = i * 8; asm volatile("" : "+s"(off)); return *(const float* const __attribute__((address_space(4)))*)(ka + off); }
__device__ __forceinline__ float* kout() { kptr_t ka = (kptr_t)__builtin_amdgcn_kernarg_segment_ptr(); int off = 31 * 8; asm volatile("" : "+s"(off)); return *(float* const __attribute__((address_space(4)))*)(ka + off); }
__device__ __forceinline__ unsigned char* kws() { kptr_t ka = (kptr_t)__builtin_amdgcn_kernarg_segment_ptr(); int off = 32 * 8; asm volatile("" : "+s"(off)); return *(unsigned char* const __attribute__((address_space(4)))*)(ka + off); }
static_assert(sizeof(Args) == 33 * 8 + 8, "Args layout");

__device__ __forceinline__ void ada_phase(LAS unsigned char* lds, const Args& A, int vcu, int G) {
    const int tid = tid_opaque();
    LAS float* sil = (LAS float*)lds; LAS float* part = sil + 5 * D;
    float* ADA = (float*)(kws() + WS_ADA);
    for (int i = tid; i < 5 * D; i += NTHR) { const int r = i / D, k = i % D; const float x = r < 4 ? kin(I_C)[r * D + k] : kin(I_CCTX)[k]; sil[i] = x / (1.f + expf(-x)); }
    __syncthreads();
    const int kg = tid >> 4, c4 = tid & 15;
    for (int unit = vcu; unit < 384; unit += G) {
        const int l = unit / 192, col0 = (unit % 192) * 64;
        f32x4 acc[5];
#pragma unroll
        for (int r = 0; r < 5; ++r) acc[r] = (f32x4){0.f, 0.f, 0.f, 0.f};
        const float* W = kin(I_ADAW) + (size_t)l * D * (6 * D) + col0 + 4 * c4;
#pragma unroll 8
        for (int i = 0; i < 64; ++i) { const int row = kg * 64 + i; const f32x4 w = *(const f32x4*)(W + (size_t)row * (6 * D));
#pragma unroll
            for (int r = 0; r < 5; ++r) acc[r] += w * sil[r * D + row]; }
#pragma unroll
        for (int r = 0; r < 5; ++r) *(LAS f32x4*)(part + ((kg * 16 + c4) * 5 + r) * 4) = acc[r];
        __syncthreads();
        if (tid < 320) { const int r = tid >> 6, col = tid & 63; float s = 0.f;
            for (int g = 0; g < 32; ++g) s += part[((g * 16 + (col >> 2)) * 5 + r) * 4 + (col & 3)];
            ADA[(size_t)(l * 5 + r) * (6 * D) + col0 + col] = s + kin(I_ADAB)[l * 6 * D + col0 + col]; }
        __syncthreads();
    }
}
__device__ __forceinline__ void filt_phase(LAS unsigned char* lds, const Args& A, int vcu, int G) {
    const int tid = tid_opaque(), wave = __builtin_amdgcn_readfirstlane(tid >> 6), lane = tid & 63;
    LAS float* zf = (LAS float*)lds;
    LAS float* h1 = zf + 64 * 33;
    LAS float* h2 = h1 + 64 * 65;
    bf16* HRg = (bf16*)(kws() + WS_HR);
    const float* fw1 = kin(I_FW1); const float* fb1 = kin(I_FB1); const float* ff1 = kin(I_FF1);
    const float* fw2 = kin(I_FW2); const float* fb2 = kin(I_FB2); const float* ff2 = kin(I_FF2); const float* fw3 = kin(I_FW3);
    for (int unit = vcu; unit < 256; unit += G) {
        const int lb = unit >> 3, cbk = unit & 7, l = lb * 64 + lane;
        const float t01 = (float)l / 2047.f, w = 6.283185307179586f * (float)l / 2048.f;
        for (int f = wave; f < 33; f += 8) { float v;
            if (f == 0) v = t01; else { const int j = (f - 1) & 15; const float band = 1e-4f + (float)j * ((15.f - 1e-4f) / 15.f); v = f <= 16 ? cosf(w * band) : -sinf(w * band); }
            zf[lane * 33 + f] = v; }
        __syncthreads();
        { float a[8];
#pragma unroll
          for (int i = 0; i < 8; ++i) a[i] = fb1[wave * 8 + i];
#pragma unroll 1
          for (int f = 0; f < 33; ++f) { const float z = zf[lane * 33 + f];
#pragma unroll
              for (int i = 0; i < 8; ++i) a[i] += z * fw1[f * 64 + wave * 8 + i]; }
#pragma unroll
          for (int i = 0; i < 8; ++i) h1[lane * 65 + wave * 8 + i] = sinf(ff1[wave * 8 + i] * a[i]); }
        __syncthreads();
        { float a[8];
#pragma unroll
          for (int i = 0; i < 8; ++i) a[i] = fb2[wave * 8 + i];
#pragma unroll 1
          for (int f = 0; f < 64; ++f) { const float z = h1[lane * 65 + f];
#pragma unroll
              for (int i = 0; i < 8; ++i) a[i] += z * fw2[f * 64 + wave * 8 + i]; }
#pragma unroll
          for (int i = 0; i < 8; ++i) h2[lane * 65 + wave * 8 + i] = sinf(ff2[wave * 8 + i] * a[i]); }
        __syncthreads();
        for (int cg = 0; cg < 4; ++cg) {
            const int col0 = cbk * 512 + wave * 64 + cg * 16;
            float acc[16];
#pragma unroll
            for (int i = 0; i < 16; ++i) acc[i] = 0.f;
#pragma unroll 1
            for (int j = 0; j < 64; ++j) { const float hv = h2[lane * 65 + j]; const float* wr = fw3 + (size_t)j * 4096 + col0;
#pragma unroll
                for (int i = 0; i < 16; ++i) acc[i] += hv * wr[i]; }
            const int o = col0 >> 11, dir = (col0 >> 10) & 1, cbase = col0 & 1023;
#pragma unroll
            for (int i = 0; i < 16; ++i) { const int c = cbase + i;
                const float delta = fabsf(-3.0701134573253946f + (float)c * ((-15.350567286626973f + 3.0701134573253946f) / 1023.f));
                const float v = acc[i] * expf(-t01 * delta);
                bf16* row = HRg + (size_t)(o * HYW + c) * 4096;
                if (dir == 0) row[2048 - l] = (bf16)f2bf(v); else row[l == 0 ? 0 : 2048 + l] = l == 0 ? (bf16)0 : (bf16)f2bf(v); }
        }
        __syncthreads();
    }
}
__device__ __forceinline__ void convert_phase(LAS unsigned char* lds, const Args& A, int vcu, int G) {
    const int tid = tid_opaque(), wave = __builtin_amdgcn_readfirstlane(tid >> 6), lane = tid & 63;
    LAS float* scr = (LAS float*)(lds + wave * 16640);
    const int gw = vcu * NWAVES + wave, NGW = G * NWAVES;
    unsigned char* ws = kws();
    constexpr int N0 = 32 * 81, N1 = 8 * 32, N2 = 32 * 32, N3 = 32 * 64, N4 = 32 * 32;
    constexpr int NIT = N0 + N1 + N2 + N3 + N4;
    for (int it = gw; it < NIT; it += NGW) {
        int r = it;
        if (r < N0) { transpose_item(kin(I_ABIN), IN_AB, (bf16*)(ws + WS_WAB), D, (r / 81) * 64, (r % 81) * 64, (r % 81) * 64, scr, lane); continue; } r -= N0;
        if (r < N1) { transpose_item(kin(I_UKV), D, (bf16*)(ws + WS_WUKV), KVR, (r / 32) * 64, (r % 32) * 64, (r % 32) * 64, scr, lane); continue; } r -= N1;
        if (r < N2) { transpose_item(kin(I_ABOUT), D, (bf16*)(ws + WS_WABO), D, (r / 32) * 64, (r % 32) * 64, (r % 32) * 64, scr, lane); continue; } r -= N2;
        if (r < N3) { transpose_item(kin(I_CDIN), IN_CD, (bf16*)(ws + WS_WCD), D, (r / 64) * 64, (r % 64) * 64, (r % 64) * 64, scr, lane); continue; } r -= N3;
        transpose_item(kin(I_CDOUT), D, (bf16*)(ws + WS_WCDO), D, (r / 32) * 64, (r % 32) * 64, (r % 32) * 64, scr, lane);
    }
    const size_t gt = (size_t)vcu * NTHR + tid, NGT = (size_t)G * NTHR;
    { u32x4* z = (u32x4*)(ws + WS_WAB + (size_t)IN_AB * D * 2); for (size_t i = gt; i < (size_t)(IN_AB_PAD - IN_AB) * D * 2 / 16; i += NGT) z[i] = (u32x4){0u, 0u, 0u, 0u}; }
    { unsigned* cs = (unsigned*)(ws + WS_CS256);
      for (size_t i = gt; i < 512 * 128; i += NGT) { const int row = (int)(i >> 7), n = (int)(i & 127) * 2, k2 = row & 255; const bool sn = row >= 256;
          const float a0 = (float)((k2 * n) & 255) * (1.f / 128.f), a1 = (float)((k2 * (n + 1)) & 255) * (1.f / 128.f);
          cs[i] = pk2((sn ? sinpif(a0) : cospif(a0)) * 0.0625f, (sn ? sinpif(a1) : cospif(a1)) * 0.0625f); } }
    { unsigned* cl = (unsigned*)(ws + WS_CSL);
      const float nrm = 0.022097086912079608f;
      for (size_t i = gt; i < (size_t)2048 * 2048; i += NGT) { const int k1 = (int)(i >> 11), j = (int)(i & 2047) * 2; const bool sn = j >= 2048; const int t = j & 2047;
          const float a0 = (float)((k1 * t) & 2047) * (1.f / 1024.f), a1 = (float)((k1 * (t + 1)) & 2047) * (1.f / 1024.f);
          cl[i] = pk2((sn ? -sinpif(a0) : cospif(a0)) * nrm, (sn ? -sinpif(a1) : cospif(a1)) * nrm); } }
}
__device__ __forceinline__ void mod_row(const float* xrow, const float* shift, const float* scale, bf16* orow, int lane) {
#pragma unroll
    for (int j = 0; j < 8; ++j) { const int c = 4 * lane + 256 * j; const f32x4 x = *(const f32x4*)(xrow + c), sh = *(const f32x4*)(shift + c), sc = *(const f32x4*)(scale + c);
        const f32x4 u = x * (sc + 1.f) + sh; u32x2 w; w.x = pk2(u[0], u[1]); w.y = pk2(u[2], u[3]); *(u32x2*)(orow + c) = w; }
}
__device__ __forceinline__ void modulate_phase(const Args& A, int vcu, int G) {
    const int tid = tid_opaque(), lane = tid & 63, gw = vcu * NWAVES + __builtin_amdgcn_readfirstlane(tid >> 6), NGW = G * NWAVES;
    const float* ADA = (const float*)(kws() + WS_ADA); bf16* U = (bf16*)(kws() + WS_UALL); const float* X = kin(I_X); const float* CT = kin(I_CTX);
    for (int row = gw; row < MALL; row += NGW) {
        if (row < MLAT) { const int b = row >> 11; mod_row(X + (size_t)row * D, ADA + (size_t)b * 6 * D, ADA + (size_t)b * 6 * D + D, U + (size_t)row * D, lane); }
        else mod_row(CT + (size_t)(row - MLAT) * D, ADA + (size_t)4 * 6 * D, ADA + (size_t)4 * 6 * D + D, U + (size_t)row * D, lane);
    }
}
__device__ __forceinline__ void postproj_phase(const Args& A, int vcu, int G) {
    const int tid = tid_opaque(), lane = tid & 63, gw = vcu * NWAVES + __builtin_amdgcn_readfirstlane(tid >> 6), NGW = G * NWAVES;
    bf16* P = (bf16*)(kws() + WS_P); bf16* CK = (bf16*)(kws() + WS_CKVN); bf16* KPE = (bf16*)(kws() + WS_KPE); const float* kvn = kin(I_KVNORM);
    const int fi = lane & 31;
    const float inv = exp2f(-(float)(fi & 15) * (13.287712379549449f / 16.f));
    for (int row = gw; row < MALL; row += NGW) {
        bf16* pr = P + (size_t)row * IN_AB_PAD;
        { const u32x4 w = *(const u32x4*)(pr + OFF_CKV + 8 * lane); float x[8] = {bflo(w.x), bfhi(w.x), bflo(w.y), bfhi(w.y), bflo(w.z), bfhi(w.z), bflo(w.w), bfhi(w.w)};
          float ss = 0.f;
#pragma unroll
          for (int i = 0; i < 8; ++i) ss += x[i] * x[i];
          const float rstd = 1.f / sqrtf(wave_sum(ss) * (1.f / KVR) + LN_EPS);
          const f32x4 g0 = *(const f32x4*)(kvn + 8 * lane), g1 = *(const f32x4*)(kvn + 8 * lane + 4);
          u32x4 o; o.x = pk2(x[0] * rstd * g0[0], x[1] * rstd * g0[1]); o.y = pk2(x[2] * rstd * g0[2], x[3] * rstd * g0[3]);
          o.z = pk2(x[4] * rstd * g1[0], x[5] * rstd * g1[1]); o.w = pk2(x[6] * rstd * g1[2], x[7] * rstd * g1[3]);
          *(u32x4*)(CK + (size_t)row * KVR + 8 * lane) = o; }
        if (row < MLAT) {
            const int t = row & 2047; const float pos = (float)(fi < 16 ? (t >> 6) : (t & 63)); float sn, cs; sincosf(pos * inv, &sn, &cs);
            if (lane < 32) { const float t1 = bf2f(pr[OFF_KPE + fi]), t2 = bf2f(pr[OFF_KPE + 32 + fi]);
                KPE[(size_t)row * 64 + fi] = (bf16)f2bf(t1 * cs - t2 * sn); KPE[(size_t)row * 64 + 32 + fi] = (bf16)f2bf(t2 * cs + t1 * sn); }
#pragma unroll
            for (int q = 0; q < 4; ++q) { const int h = 2 * q + (lane >> 5); bf16* qp = pr + h * 192 + 128;
                const float t1 = bf2f(qp[fi]), t2 = bf2f(qp[32 + fi]); qp[fi] = (bf16)f2bf(t1 * cs - t2 * sn); qp[32 + fi] = (bf16)f2bf(t2 * cs + t1 * sn); }
        } else KPE[(size_t)row * 64 + lane] = pr[OFF_KPE + lane];
    }
}
__device__ __forceinline__ void ln1_phase(LAS unsigned char* lds, int l, int vcu, int G) {
    const int tid = tid_opaque(), lane = tid & 63, gw = vcu * NWAVES + __builtin_amdgcn_readfirstlane(tid >> 6), NGW = G * NWAVES;
    LAS float* rt = (LAS float*)lds;
    unsigned char* ws = kws();
    { const float* router = kin(I_ROUTER) + (size_t)l * D * NE;
      for (int i = tid; i < 4 * D; i += NTHR) { const int c = i & (D - 1), q = i >> 11; const f32x4 v = *(const f32x4*)(router + (size_t)c * NE + 4 * q);
          rt[(4 * q + 0) * D + c] = v[0]; rt[(4 * q + 1) * D + c] = v[1]; rt[(4 * q + 2) * D + c] = v[2]; rt[(4 * q + 3) * D + c] = v[3]; } }
    __syncthreads();
    const float* PRE = (const float*)(ws + WS_PRE); float* H1 = (float*)(ws + WS_H1); bf16* U2 = (bf16*)(ws + WS_U2); float* AFF = (float*)(ws + WS_AFF);
    const float* g = kin(I_LN1G) + l * D; const float* bb = kin(I_LN1B) + l * D; const float* ADA = (const float*)(ws + WS_ADA) + (size_t)l * 5 * 6 * D;
    for (int rp = gw; rp < MLAT / 2; rp += NGW) {
        const int row0 = rp * 2, b = row0 >> 11;
        const float* ada = ADA + (size_t)b * 6 * D;
        f32x4 v[2][8];
#pragma unroll
        for (int rr = 0; rr < 2; ++rr)
#pragma unroll
            for (int j = 0; j < 8; ++j) v[rr][j] = *(const f32x4*)(PRE + (size_t)(row0 + rr) * D + 4 * lane + 256 * j);
#pragma unroll
        for (int rr = 0; rr < 2; ++rr) { float s = 0.f;
#pragma unroll
            for (int j = 0; j < 8; ++j) s += (v[rr][j][0] + v[rr][j][1]) + (v[rr][j][2] + v[rr][j][3]);
            const float mean = wave_sum(s) * (1.f / D); float q = 0.f;
#pragma unroll
            for (int j = 0; j < 8; ++j) { v[rr][j] = v[rr][j] - mean; q += (v[rr][j][0] * v[rr][j][0] + v[rr][j][1] * v[rr][j][1]) + (v[rr][j][2] * v[rr][j][2] + v[rr][j][3] * v[rr][j][3]); }
            const float rstd = 1.f / sqrtf(wave_sum(q) * (1.f / D) + LN_EPS);
#pragma unroll
            for (int j = 0; j < 8; ++j) { const int c = 4 * lane + 256 * j;
                const f32x4 hv = v[rr][j] * rstd * *(const f32x4*)(g + c) + *(const f32x4*)(bb + c);
                *(f32x4*)(H1 + (size_t)(row0 + rr) * D + c) = hv;
                const f32x4 u = hv * (*(const f32x4*)(ada + 4 * D + c) + 1.f) + *(const f32x4*)(ada + 3 * D + c);
                u32x2 w; w.x = pk2(u[0], u[1]); w.y = pk2(u[2], u[3]); *(u32x2*)(U2 + (size_t)(row0 + rr) * D + c) = w;
                v[rr][j] = u; } }
        float a[32];
#pragma unroll
        for (int e = 0; e < NE; ++e) { float a0 = 0.f, a1 = 0.f;
#pragma unroll
            for (int j = 0; j < 8; ++j) { const f32x4 r4 = *(const LAS f32x4*)(rt + e * D + 4 * lane + 256 * j);
                a0 += (v[0][j][0] * r4[0] + v[0][j][1] * r4[1]) + (v[0][j][2] * r4[2] + v[0][j][3] * r4[3]);
                a1 += (v[1][j][0] * r4[0] + v[1][j][1] * r4[1]) + (v[1][j][2] * r4[2] + v[1][j][3] * r4[3]); }
            a[e] = a0; a[16 + e] = a1; __builtin_amdgcn_sched_barrier(0); }
#pragma unroll
        for (int i = 0; i < 16; ++i) { const bool up = (lane & 32) != 0; const float snd = up ? a[i] : a[i + 16], kp = up ? a[i + 16] : a[i]; a[i] = kp + __shfl_xor(snd, 32); }
#pragma unroll
        for (int i = 0; i < 8; ++i) { const bool up = (lane & 16) != 0; const float snd = up ? a[i] : a[i + 8], kp = up ? a[i + 8] : a[i]; a[i] = kp + __shfl_xor(snd, 16); }
#pragma unroll
        for (int i = 0; i < 4; ++i) { const bool up = (lane & 8) != 0; const float snd = up ? a[i] : a[i + 4], kp = up ? a[i + 4] : a[i]; a[i] = kp + __shfl_xor(snd, 8); }
#pragma unroll
        for (int i = 0; i < 2; ++i) { const bool up = (lane & 4) != 0; const float snd = up ? a[i] : a[i + 2], kp = up ? a[i + 2] : a[i]; a[i] = kp + __shfl_xor(snd, 4); }
        { const bool up = (lane & 2) != 0; const float snd = up ? a[0] : a[1], kp = up ? a[1] : a[0]; a[0] = kp + __shfl_xor(snd, 2); }
        float lg = a[0] + __shfl_xor(a[0], 1);
        float mx = lg;
#pragma unroll
        for (int o = 2; o < 32; o <<= 1) mx = fmaxf(mx, __shfl_xor(mx, o));
        const float ex = expf(lg - mx); float den = ex;
#pragma unroll
        for (int o = 2; o < 32; o <<= 1) den += __shfl_xor(den, o);
        if ((lane & 1) == 0) { const int rr = lane >> 5, e = (lane >> 1) & 15, t = (row0 + rr) & 2047; AFF[(size_t)(b * NE + e) * SEQ + t] = ex / den; }
    }
}
__device__ __forceinline__ void topk_phase(LAS unsigned char* lds, const Args& A, int u0, int ustride) {
    const int tid = tid_opaque(), wave = __builtin_amdgcn_readfirstlane(tid >> 6), lane = tid & 63;
    LAS unsigned long long* keys = (LAS unsigned long long*)lds;
    const float* AFF = (const float*)(kws() + WS_AFF); int* IDX = (int*)(kws() + WS_IDX); float* GATE = (float*)(kws() + WS_GATE); int* INV = (int*)(kws() + WS_INV);
    for (int unit = u0; unit < NRT; unit += ustride) {
        const int e = unit >> 2, b = unit & 3;
        for (int i = tid; i < SEQ; i += NTHR) keys[i] = ((unsigned long long)__builtin_bit_cast(unsigned, AFF[(size_t)(b * NE + e) * SEQ + i]) << 32) | (unsigned)(2047 - i);
        __syncthreads();
        for (int k = 2; k <= SEQ; k <<= 1)
            for (int j = k >> 1; j > 0; j >>= 1) {
                for (int i = tid; i < SEQ; i += NTHR) { const int x = i ^ j; if (x > i) { const unsigned long long a = keys[i], c = keys[x]; const bool asc = (i & k) == 0;
                    if ((a > c) == asc) { keys[i] = c; keys[x] = a; } } }
                __syncthreads(); }
        for (int p = tid; p < SEQ; p += NTHR) { const unsigned long long kk = keys[p]; const int idx = 2047 - (int)(unsigned)(kk & 0xffffffffu), slot = 2047 - p;
            INV[(size_t)(b * SEQ + idx) * NE + e] = slot < CAP ? slot : -1;
            if (slot < CAP) { IDX[unit * CAP + slot] = idx; GATE[unit * CAP + slot] = __builtin_bit_cast(float, (unsigned)(kk >> 32)); } }
        __syncthreads();
    }
}
__device__ __forceinline__ void ln2_phase(int l, int vcu, int G) {
    const int tid = tid_opaque(), lane = tid & 63, gw = vcu * NWAVES + __builtin_amdgcn_readfirstlane(tid >> 6), NGW = G * NWAVES;
    unsigned char* ws = kws();
    const float* H1 = (const float*)(ws + WS_H1); const bf16* YE = (const bf16*)(ws + WS_YE); const int* INV = (const int*)(ws + WS_INV);
    float* out = l == 0 ? (float*)(ws + WS_H2) : kout(); bf16* U = (bf16*)(ws + WS_UALL);
    const float* g = kin(I_LN2G) + l * D; const float* bb = kin(I_LN2B) + l * D; const float* ADA = (const float*)(ws + WS_ADA);
    int inv_n = (gw < MLAT && lane < NE) ? INV[(size_t)gw * NE + lane] : -1;
    for (int row = gw; row < MLAT; row += NGW) {
        const int b = row >> 11; const int inv = inv_n;
        if (row + NGW < MLAT && lane < NE) inv_n = INV[(size_t)(row + NGW) * NE + lane];
        const float* ada = ADA + (size_t)(l * 5 + b) * 6 * D;
        f32x4 v[8];
#pragma unroll
        for (int j = 0; j < 8; ++j) v[j] = *(const f32x4*)(H1 + (size_t)row * D + 4 * lane + 256 * j);
        f32x4 m[8];
#pragma unroll
        for (int j = 0; j < 8; ++j) m[j] = (f32x4){0.f, 0.f, 0.f, 0.f};
        unsigned mask = (unsigned)__builtin_amdgcn_ballot_w64(inv >= 0) & 0xffffu;
        while (mask) {
            const int e0 = __builtin_ctz(mask); mask &= mask - 1; const bool two = mask != 0u; const int e1 = two ? __builtin_ctz(mask) : e0; if (two) mask &= mask - 1;
            const int s0 = __builtin_amdgcn_readlane(inv, e0), s1 = __builtin_amdgcn_readlane(inv, e1);
            const bf16* y0 = YE + (size_t)((e0 * 4 + b) * CAP + s0) * D + 4 * lane; const bf16* y1 = YE + (size_t)((e1 * 4 + b) * CAP + s1) * D + 4 * lane;
            u32x2 w0[8], w1[8];
#pragma unroll
            for (int j = 0; j < 8; ++j) { w0[j] = *(const u32x2*)(y0 + 256 * j); w1[j] = *(const u32x2*)(y1 + 256 * j); }
            const float f1 = two ? 1.f : 0.f;
#pragma unroll
            for (int j = 0; j < 8; ++j) { m[j][0] += bflo(w0[j].x) + f1 * bflo(w1[j].x); m[j][1] += bfhi(w0[j].x) + f1 * bfhi(w1[j].x); m[j][2] += bflo(w0[j].y) + f1 * bflo(w1[j].y); m[j][3] += bfhi(w0[j].y) + f1 * bfhi(w1[j].y); }
        }
        float s = 0.f;
#pragma unroll
        for (int j = 0; j < 8; ++j) { const int c = 4 * lane + 256 * j; v[j] = v[j] * DN_ALPHA + *(const f32x4*)(ada + 5 * D + c) * m[j]; s += (v[j][0] + v[j][1]) + (v[j][2] + v[j][3]); }
        const float mean = wave_sum(s) * (1.f / D); float q = 0.f;
#pragma unroll
        for (int j = 0; j < 8; ++j) { v[j] = v[j] - mean; q += (v[j][0] * v[j][0] + v[j][1] * v[j][1]) + (v[j][2] * v[j][2] + v[j][3] * v[j][3]); }
        const float rstd = 1.f / sqrtf(wave_sum(q) * (1.f / D) + LN_EPS);
        const float* ada1 = ADA + (size_t)(5 + b) * 6 * D;
#pragma unroll
        for (int j = 0; j < 8; ++j) { const int c = 4 * lane + 256 * j;
            const f32x4 hv = v[j] * rstd * *(const f32x4*)(g + c) + *(const f32x4*)(bb + c);
            *(f32x4*)(out + (size_t)row * D + c) = hv;
            if (l == 0) { const f32x4 u = hv * (*(const f32x4*)(ada1 + D + c) + 1.f) + *(const f32x4*)(ada1 + c); u32x2 w; w.x = pk2(u[0], u[1]); w.y = pk2(u[2], u[3]); *(u32x2*)(U + (size_t)row * D + c) = w; } }
    }
}

constexpr int CW_QHEAD = 64, CW_DONE0 = 256;
constexpr int XW_L = 3 * 16 * 704;
constexpr unsigned XT_L = XW_L / 8, XT_ALL = 2 * XT_L;
__device__ __forceinline__ void expert_item(int w, LAS float* scr, int lane) {
    const int l = w / XW_L, r = w % XW_L, kind = r / 11264, q = r % 11264, e = q / 704, qq = q % 704, le = l * 16 + e;
    unsigned char* ws = kws();
    const int tq = qq >> 3, sub = qq & 7;
    if (kind < 2) { const int kb = (tq / 11) * 4 + (sub >> 1), nb = (tq % 11) * 2 + (sub & 1), f0 = nb * 64;
        transpose_item(kin(kind == 0 ? I_W1 : I_W3) + (size_t)le * D * FF, FF, (bf16*)(ws + WS_W13) + (size_t)le * (2 * FF * D), D, kb * 64, f0, (f0 >> 7) * 256 + kind * 128 + (f0 & 127), scr, lane); }
    else { const int kb = (tq >> 3) * 2 + (sub & 1), nb = (tq & 7) * 4 + (sub >> 1);
        transpose_item(kin(I_W2) + (size_t)le * FF * D, D, (bf16*)(ws + WS_W2) + (size_t)le * (D * FF), FF, kb * 64, nb * 64, nb * 64, scr, lane); }
}
__device__ __forceinline__ void steal(LAS unsigned char* lds, volatile LAS unsigned* MISC, int k, unsigned must, int G) {
    const int tid = tid_opaque(), wave = __builtin_amdgcn_readfirstlane(tid >> 6), lane = tid & 63;
    unsigned* ctl = (unsigned*)(kws() + WS_CTL);
    __syncthreads();
    if (tid == 0) (void)xb_add(ctl + CW_DONE0 + 64 * k, 1u);
    for (;;) {
        if (tid == 0) { unsigned it = 0xffffffffu;
            const unsigned d = xb_ld(ctl + CW_DONE0 + 64 * k), h = xb_ld(ctl + CW_QHEAD);
            if (h < XT_ALL && (d < (unsigned)G || h < must)) { it = xb_add(ctl + CW_QHEAD, 1u); if (it >= XT_ALL) it = 0xffffffffu; }
            MISC[4] = it; }
        __syncthreads();
        const unsigned it = MISC[4];
        __syncthreads();
        if (it == 0xffffffffu) break;
        expert_item((int)it * 8 + wave, (LAS float*)(lds + wave * 16640), lane);
    }
}

__global__ void __launch_bounds__(NTHR, 2) mk_fwd(Args A) {
    extern __shared__ __attribute__((aligned(16))) unsigned char lds_raw[];
    LAS unsigned char* lds = (LAS unsigned char*)lds_raw;
    volatile LAS unsigned* MISC = (volatile LAS unsigned*)(lds + LDS_MISC);
    const int G = gridDim.x; const int bx = blockIdx.x; const int vcu = (G % 8 == 0) ? (bx % 8) * (G / 8) + bx / 8 : bx;
    if (threadIdx.x < 16) MISC[threadIdx.x] = 0u;
    __syncthreads();
#if MK_LAUNCH_PER_PHASE
#define GRID_BAR() do { } while (0)
#else
    XcdBarrier bar = xcd_barrier_post((unsigned*)(kws() + WS_CTL) + 4096, MISC + 8);
#define GRID_BAR() xcd_barrier(bar)
#endif
    const int lo = A.ph_lo, hi = A.ph_hi;
#ifndef PH_MASK
#define PH_MASK 0xFFFFFFFFu
#endif
#define IN(k) ((((PH_MASK) >> (k)) & 1u) && lo <= (k) && (k) < hi)
#define SEAM(k) do { if ((k) + 1 < hi) GRID_BAR(); } while (0)
#ifndef PROBE_DUP
#define PROBE_DUP 0u
#endif
#define REP(k) for (int rep_ = 0; rep_ < (int)(((PROBE_DUP) >> (k)) & 1u) + 1; ++rep_)

    #ifndef PX_PARTS
#define PX_PARTS 3
#endif
#ifndef P0_PARTS
#define P0_PARTS 7
#endif
    if (IN(0)) REP(0) { if (P0_PARTS & 1) ada_phase(lds, A, vcu, G); if (P0_PARTS & 2) filt_phase(lds, A, vcu, G); if (P0_PARTS & 4) convert_phase(lds, A, vcu, G); SEAM(0); }

    {

            if (IN(1)) REP(1) { modulate_phase(A, vcu, G); SEAM(1); }
            if (IN(2)) REP(2) { ProbPlain P{2048, 2048, 2048, 36 * 21, (const bf16*)(kws() + WS_UALL), (const bf16*)(kws() + WS_WAB), (bf16*)(kws() + WS_P), IN_AB_PAD, 36, 21};
                pg8::gemm_phase(lds, P, vcu, G); SEAM(2); }
            if (IN(3)) REP(3) { postproj_phase(A, vcu, G); SEAM(3); }
            if (IN(4)) REP(4) { ProbPlain P{512, 512, 512, 36 * 8, (const bf16*)(kws() + WS_CKVN), (const bf16*)(kws() + WS_WUKV), (bf16*)(kws() + WS_KV), D, 36, 8};
                if (G == 256) { if ((vcu & 31) < 18) pg8::gemm_phase(lds, P, (vcu >> 5) * 18 + (vcu & 31), 144); }
                else pg8::gemm_phase(lds, P, vcu, G);
                steal(lds, MISC, 4, 0u, G); SEAM(4); }
            if (IN(5)) REP(5) { const att::Tensors T{(const bf16*)(kws() + WS_P), (const bf16*)(kws() + WS_KV), (const bf16*)(kws() + WS_KPE), kin(I_RPB), (bf16*)(kws() + WS_CAT)};
                for (int u = vcu; u < 256; u += G) att::attn_unit<0>(lds, T, u);
                for (int u = vcu; u < 256; u += G) att::attn_unit<1>(lds, T, u);
                steal(lds, MISC, 5, 0u, G); SEAM(5); }
    }
#define COMMON_PHASES(l, cb) \
        if (IN(cb)) REP(cb) { ProbOut P{2048, 2048, 2048, 256, (const bf16*)(kws() + WS_CAT), (const bf16*)(kws() + (l == 0 ? WS_WABO : WS_WCDO)), l == 0 ? kin(I_X) : (const float*)(kws() + WS_H2), \
                               (const float*)(kws() + WS_ADA) + (size_t)l * 5 * 6 * D + 2 * D, (float*)(kws() + WS_PRE)}; \
            pg8::gemm_phase(lds, P, vcu, G); SEAM(cb); } \
        if (IN(cb + 1)) REP(cb + 1) { ln1_phase(lds, l, vcu, G); SEAM(cb + 1); } \
        if (IN(cb + 2)) REP(cb + 2) { if (G == 256) topk_phase(lds, A, (vcu & 31) < 8 ? (vcu >> 5) * 8 + (vcu & 31) : NRT, NRT); else topk_phase(lds, A, vcu, G); \
            steal(lds, MISC, cb + 2, (unsigned)(l + 1) * XT_L, G); SEAM(cb + 2); } \
        if (IN(cb + 3)) REP(cb + 3) { ProbMoe1 P{2048, 2048, 2048, 704, (const bf16*)(kws() + WS_U2), (const int*)(kws() + WS_IDX), (const bf16*)(kws() + WS_W13) + (size_t)l * 16 * (2 * FF * D), (bf16*)(kws() + WS_HDN)}; \
            if (G == 256) { if ((vcu & 31) < 30) pg8::gemm_phase(lds, P, (vcu >> 5) * 30 + (vcu & 31), 240); } else pg8::gemm_phase(lds, P, vcu, G); \
            steal(lds, MISC, cb + 3, 0u, G); SEAM(cb + 3); } \
        if (IN(cb + 4)) REP(cb + 4) { ProbMoe2 P{FF, FF, FF, 512, (const bf16*)(kws() + WS_HDN), (const bf16*)(kws() + WS_W2) + (size_t)l * 16 * (D * FF), (const float*)(kws() + WS_GATE), (bf16*)(kws() + WS_YE)}; \
            pg8::gemm_phase(lds, P, vcu, G); SEAM(cb + 4); } \
        if (IN(cb + 5)) REP(cb + 5) { ln2_phase(l, vcu, G); SEAM(cb + 5); }
    COMMON_PHASES(0, 6)
    {

            if (IN(12)) REP(12) { ProbPlain P{2048, 2048, 2048, 32 * 16, (const bf16*)(kws() + WS_UALL), (const bf16*)(kws() + WS_WCD), (bf16*)(kws() + WS_P), IN_CD, 32, 16};
                pg8::gemm_phase(lds, P, vcu, G); SEAM(12); }
            if (IN(13)) REP(13) {
                if (PX_PARTS & 1) { const int tid = tid_opaque(), lane = tid & 63, wave = __builtin_amdgcn_readfirstlane(tid >> 6);
                    for (int it = vcu * NWAVES + wave; it < NB * 32 * 48; it += G * NWAVES) prep_item(lds + wave * 9600, (const bf16*)(kws() + WS_P), kin(I_CONVW), kin(I_CONVB), (bf16*)(kws() + WS_ST), it, lane); }
                __syncthreads();
                ProbF1 P{256, 256, IN_CD, 256, (const bf16*)(kws() + WS_CS256), (const bf16*)(kws() + WS_P), (bf16*)(kws() + WS_T1)};
                if (PX_PARTS & 2) pg8::gemm_phase(lds, P, vcu, G); SEAM(13); }
            if (IN(14)) REP(14) {
                if (G == 256) { if ((vcu & 31) < 16) { ProbF2 P{4096, 4096, 4096, 128, (const bf16*)(kws() + WS_CSL), (const bf16*)(kws() + WS_T1), (bf16*)(kws() + WS_CAT)}; pg8::gemm_phase(lds, P, (vcu >> 5) * 16 + (vcu & 31), 128); } }
                else { ProbF2 P{4096, 4096, 4096, 128, (const bf16*)(kws() + WS_CSL), (const bf16*)(kws() + WS_T1), (bf16*)(kws() + WS_CAT)}; pg8::gemm_phase(lds, P, vcu, G); }
                for (int u = vcu; u < 256; u += G) hy::hyena_unit(lds, (const bf16*)(kws() + WS_ST), (const bf16*)(kws() + WS_HR), kin(I_SKIP), (bf16*)(kws() + WS_CAT), u);
                steal(lds, MISC, 14, 0u, G); SEAM(14); }
    }
    COMMON_PHASES(1, 15)
#undef COMMON_PHASES
#undef IN
#undef SEAM
}

extern "C" void kernel_launch(void* const* d_in, const int* in_sizes, int n_in, void* d_out, int out_size, void* d_ws, size_t ws_size, hipStream_t stream) {
    static int grid = 0;
    if (grid == 0) {
        if (n_in != 31 || out_size != MLAT * D || ws_size < WS_END) { fprintf(stderr, "kernel_launch: unexpected shapes (n_in %d, out %d, ws %zu < %zu)\n", n_in, out_size, ws_size, (size_t)WS_END); grid = -1; return; }
        int dev = 0, cus = 0, per_cu = 0;
        if (hipGetDevice(&dev) != hipSuccess || hipDeviceGetAttribute(&cus, hipDeviceAttributeMultiprocessorCount, dev) != hipSuccess) { grid = -1; return; }
        if (hipFuncSetAttribute((const void*)mk_fwd, hipFuncAttributeMaxDynamicSharedMemorySize, LDS_BYTES) != hipSuccess) { fprintf(stderr, "kernel_launch: hipFuncSetAttribute failed\n"); grid = -1; return; }
        if (hipOccupancyMaxActiveBlocksPerMultiprocessor(&per_cu, (const void*)mk_fwd, NTHR, LDS_BYTES) != hipSuccess || per_cu < 1) { fprintf(stderr, "kernel_launch: occupancy query says %d\n", per_cu); }
        (void)hipGetLastError();
        grid = cus;
    }
    if (grid < 0) return;
    (void)hipMemsetAsync((char*)d_ws + WS_CTL, 0, CTL_ZERO_BYTES, stream);
    Args a{};
    for (int i = 0; i < 31; ++i) a.in[i] = (const float*)d_in[i];
    a.out = (float*)d_out; a.ws = (unsigned char*)d_ws;
#if MK_LAUNCH_PER_PHASE
    for (int ph = 0; ph < NPHASE; ++ph) { a.ph_lo = ph; a.ph_hi = ph + 1; hipLaunchKernelGGL(mk_fwd, dim3(grid), dim3(NTHR), LDS_BYTES, stream, a); }
#else
    a.ph_lo = 0; a.ph_hi = NPHASE;
    hipLaunchKernelGGL(mk_fwd, dim3(grid), dim3(NTHR), LDS_BYTES, stream, a);
#endif
}
```

```cpp
#include <hip/hip_runtime.h>
#include <cstdio>
#include <cstdint>

#ifndef MK_LAUNCH_PER_PHASE
#define MK_LAUNCH_PER_PHASE 0
#endif

#define GAS __attribute__((address_space(1)))
#define LAS __attribute__((address_space(3)))
typedef unsigned short bf16;
typedef short bf16x8 __attribute__((ext_vector_type(8)));
typedef short s16x4 __attribute__((ext_vector_type(4)));
typedef float f32x4 __attribute__((ext_vector_type(4)));
typedef float f32x2 __attribute__((ext_vector_type(2)));
typedef float f32x16 __attribute__((ext_vector_type(16)));
typedef unsigned u32x4 __attribute__((ext_vector_type(4)));
typedef unsigned u32x2 __attribute__((ext_vector_type(2)));
#define RLX_AGENT __ATOMIC_RELAXED, __HIP_MEMORY_SCOPE_AGENT
#define LDS_WAIT() asm volatile("s_waitcnt lgkmcnt(0)" ::: "memory")
#define VM_WAIT() asm volatile("s_waitcnt vmcnt(0)" ::: "memory")

constexpr int D = 2048, NB = 4, SEQ = 2048, LC = 256, GW = 64;
constexpr int MLAT = NB * SEQ, MCTX = NB * LC, MALL = MLAT + MCTX;
constexpr int IN_AB = 5184, IN_AB_PAD = 5376;
constexpr int OFF_CKV = 1536, OFF_KPE = 2048, OFF_QNA = 2112, OFF_KNA = 3136, OFF_VNA = 4160;
constexpr int KVR = 512, NH = 8;
constexpr int FF = 1408, NE = 16, CAP = 256, NRT = NE * NB;
constexpr int IN_CD = 4096, HYW = 1024, HY3 = 3072;
constexpr float LN_EPS = 1e-6f;
constexpr float DN_ALPHA = 1.41421356237f;
constexpr int NWAVES = 8, NTHR = 512;

constexpr size_t MiB = 1u << 20;
constexpr size_t WS_CTL = 0, CTL_ZERO_BYTES = 2 * MiB;
constexpr size_t WS_ADA = 1 * MiB;
constexpr size_t WS_AFF = 2 * MiB;
constexpr size_t WS_IDX = 3 * MiB;
constexpr size_t WS_GATE = WS_IDX + 64 * 1024;
constexpr size_t WS_INV = 4 * MiB;
constexpr size_t WS_CS256 = 5 * MiB;
constexpr size_t WS_DBG = 6 * MiB;
constexpr size_t WS_WAB = 8 * MiB;
constexpr size_t WS_WUKV = 30 * MiB;
constexpr size_t WS_WABO = 32 * MiB;
constexpr size_t WS_WCD = 40 * MiB;
constexpr size_t WS_WCDO = 56 * MiB;
constexpr size_t WS_CSL = 64 * MiB;
constexpr size_t WS_HR = 80 * MiB;
constexpr size_t W13_E = (size_t)2 * FF * D * 2;
constexpr size_t W2_E = (size_t)D * FF * 2;
constexpr size_t WS_W13 = 96 * MiB;
constexpr size_t WS_W2 = WS_W13 + 32 * W13_E;
constexpr size_t WS_UALL = WS_W2 + 32 * W2_E;
constexpr size_t WS_P = WS_UALL + (size_t)MALL * D * 2;
constexpr size_t WS_CKVN = WS_P + (size_t)MALL * IN_AB_PAD * 2;
constexpr size_t WS_KPE = WS_CKVN + (size_t)MALL * KVR * 2;
constexpr size_t WS_KV = WS_KPE + (size_t)MALL * 64 * 2;
constexpr size_t WS_ST = WS_KV;
constexpr size_t WS_CAT = WS_KV + (size_t)NB * HY3 * SEQ * 2;
constexpr size_t WS_PRE = WS_CAT + (size_t)MLAT * D * 2;
constexpr size_t WS_H1 = WS_PRE + (size_t)MLAT * D * 4;
constexpr size_t WS_H2 = WS_H1 + (size_t)MLAT * D * 4;
constexpr size_t WS_U2 = WS_H2 + (size_t)MLAT * D * 4;
constexpr size_t WS_XE = WS_U2 + (size_t)MLAT * D * 2;
constexpr size_t WS_HDN = WS_XE + (size_t)NRT * CAP * D * 2;
constexpr size_t WS_YE = WS_HDN + (size_t)NRT * CAP * FF * 2;
constexpr size_t WS_T1 = WS_YE + (size_t)NRT * CAP * D * 2;
constexpr size_t WS_END = WS_T1 + (size_t)16 * 256 * 2 * 2048 * 2;
static_assert(WS_WAB + (size_t)IN_AB_PAD * D * 2 <= WS_WUKV && WS_HR + (size_t)2 * 1024 * 4096 * 2 <= WS_W13, "ws map");
static_assert(WS_END < (size_t)1400 * MiB, "ws map too large");

constexpr int LDS_MAIN = 151552;
constexpr int LDS_MISC = LDS_MAIN;
constexpr int LDS_STAMP = LDS_MAIN + 64;
constexpr int LDS_BYTES = LDS_MAIN + 64 + 192;

__device__ __forceinline__ unsigned f2bf(float f) { unsigned u = __builtin_bit_cast(unsigned, f); return (u + 0x7fffu + ((u >> 16) & 1u)) >> 16; }
__device__ __forceinline__ unsigned pk2(float lo, float hi) { return f2bf(lo) | (f2bf(hi) << 16); }
__device__ __forceinline__ float bf2f(unsigned b) { return __builtin_bit_cast(float, b << 16); }
__device__ __forceinline__ float bflo(unsigned w) { return __builtin_bit_cast(float, w << 16); }
__device__ __forceinline__ float bfhi(unsigned w) { return __builtin_bit_cast(float, w & 0xffff0000u); }
__device__ __forceinline__ unsigned cvt_pk_bf16(float lo, float hi) { unsigned r; asm volatile("v_cvt_pk_bf16_f32 %0, %1, %2" : "=v"(r) : "v"(lo), "v"(hi)); return r; }
__device__ __forceinline__ float wave_sum(float v) {
#pragma unroll
    for (int o = 1; o < 64; o <<= 1) v += __shfl_xor(v, o);
    return v;
}
__device__ __forceinline__ int tid_opaque() { int t = threadIdx.x; asm volatile("" : "+v"(t)); return t; }
__device__ __forceinline__ float silu_f(float x) { return x / (1.f + __expf(-x)); }

#define XB_TMO      128
#define XB_XCNT(j)  (256  + 64 * (j))
#define XB_XSUB(j)  (1280 + 64 * (j))
#define XB_XGEN(j)  (2304 + 64 * (j))
#define XB_TOP      3328
#define XB_TOPGEN   3392
#define XCD_BAR_WORDS 3456
#define XB_SPIN_CAP (1u << 18)
__device__ __forceinline__ unsigned xb_ld(unsigned* p)              { return __hip_atomic_load(p, __ATOMIC_RELAXED, __HIP_MEMORY_SCOPE_AGENT); }
__device__ __forceinline__ unsigned xb_add(unsigned* p, unsigned v) { return __hip_atomic_fetch_add(p, v, __ATOMIC_RELAXED, __HIP_MEMORY_SCOPE_AGENT); }
__device__ __forceinline__ unsigned xb_xcc_id() { return (unsigned)__builtin_amdgcn_s_getreg((3 << 11) | 20) & 0xFu; }
#define XB_SPIN(cond, bar) do { unsigned _sp = 0; while (cond) { __builtin_amdgcn_s_sleep(1); \
    if ((++_sp & 255u) == 0u) { if (xb_ld(&(bar)[XB_TMO])) break; if (_sp > XB_SPIN_CAP) { atomicAdd(&(bar)[XB_TMO], 1u); break; } } } } while (0)
struct XcdBarrier { unsigned* bar; unsigned x; volatile LAS unsigned* st; };
__device__ __forceinline__ XcdBarrier xcd_barrier_post(unsigned* bar, volatile LAS unsigned* st) {
    XcdBarrier b; b.bar = bar; b.x = xb_xcc_id(); b.st = st;
    if (threadIdx.x == 0) (void)xb_add(&bar[XB_XCNT(b.x)], 1u);
    return b;
}
__device__ __forceinline__ void xcd_barrier_complete(unsigned* bar, unsigned x, unsigned& nloc, unsigned& nx) {
    const unsigned G = gridDim.x * gridDim.y * gridDim.z;
    unsigned sum, cnt, mine, sp = 0u;
    for (;;) {
        sum = 0u; cnt = 0u; mine = 0u;
#pragma unroll
        for (unsigned j = 0; j < 16; ++j) { const unsigned c = xb_ld(&bar[XB_XCNT(j)]); sum += c; cnt += (c > 0u) ? 1u : 0u; mine = (j == x) ? c : mine; }
        if (sum == G) break;
        __builtin_amdgcn_s_sleep(1);
        if ((++sp & 255u) == 0u) { if (xb_ld(&bar[XB_TMO])) break; if (sp > XB_SPIN_CAP) { atomicAdd(&bar[XB_TMO], 1u); break; } }
    }
    nloc = mine > 0u ? mine : 1u; nx = cnt > 0u ? cnt : 1u;
}
__device__ __forceinline__ void xcd_barrier(const XcdBarrier& b) {
    asm volatile("s_waitcnt vmcnt(0)" ::: "memory");
    __syncthreads();
    if (threadIdx.x == 0) {
        unsigned* bar = b.bar;
        __builtin_amdgcn_s_waitcnt(0);
        unsigned nloc = b.st[0], nx = b.st[1];
        if (nloc == 0u) { xcd_barrier_complete(bar, b.x, nloc, nx); b.st[0] = nloc; b.st[1] = nx; }
        const unsigned old = xb_add(&bar[XB_XSUB(b.x)], 1u);
        const unsigned gen = old / nloc;
        if (old + 1u == (gen + 1u) * nloc) {
            __builtin_amdgcn_fence(__ATOMIC_RELEASE, "agent");
            asm volatile("s_waitcnt vmcnt(0)" ::: "memory");
            const unsigned og = xb_add(&bar[XB_TOP], 1u);
            const unsigned tg = og / nx;
            if (og + 1u == (tg + 1u) * nx) xb_add(&bar[XB_TOPGEN], 1u);
            else XB_SPIN(xb_ld(&bar[XB_TOPGEN]) == tg, bar);
            __builtin_amdgcn_fence(__ATOMIC_ACQUIRE, "agent");
            xb_add(&bar[XB_XGEN(b.x)], 1u);
            asm volatile("s_waitcnt vmcnt(0)" ::: "memory");
        } else {
            XB_SPIN(xb_ld(&bar[XB_XGEN(b.x)]) == gen, bar);
            __builtin_amdgcn_fence(__ATOMIC_ACQUIRE, "agent");
            asm volatile("s_waitcnt vmcnt(0)" ::: "memory");
        }
    }
    __syncthreads();
}

namespace pg8 {
constexpr int BM = 256, BK = 64, HALF = 128, HTB = HALF * BK * 2, STAGE_BYTES = 8 * HTB;
__host__ __device__ __forceinline__ int lds_byte(int r, int c) { const int st = (r >> 4) * 2 + (c >> 5), rr = r & 15, cc = c & 31, ob = rr * 64 + cc * 2; return st * 1024 + (ob ^ (((ob >> 9) & 1) << 5)); }
__host__ __device__ __forceinline__ void stage_rc(int b, int& R, int& C) { const int st = b / 1024, sb = b % 1024, swz = sb ^ (((sb >> 9) & 1) << 5); R = (st >> 1) * 16 + swz / 64; C = (st & 1) * 32 + (swz % 64) / 2; }
__host__ __device__ __forceinline__ int perm32(int rho) { const int n = rho >> 4, i = rho & 15; return 8 * (i >> 2) + 4 * n + (i & 3); }

template <class Prob>
__device__ __forceinline__ void gemm_phase(LAS unsigned char* lds, const Prob& P, int u0, int ustride) {
    const int tid = tid_opaque(), wid = __builtin_amdgcn_readfirstlane(tid >> 6), lane = tid & 63, wr = wid >> 2, wc = wid & 3, fr = lane & 15, fq = lane >> 4;
    const int K = P.K, nt = K / BK;
    unsigned voffA[2], voffB[2];
#pragma unroll
    for (int i = 0; i < 2; ++i) { int R, C; stage_rc(tid * 16 + i * 8192, R, C); const int Rb = Prob::PERM ? ((R & ~31) + perm32(R & 31)) : R;
        voffA[i] = (unsigned)(R * P.lda + C) * 2u; voffB[i] = (unsigned)(Rb * P.ldb + C) * 2u; }
    const size_t kstep = (size_t)(BK * 2);
    const size_t hstepA = Prob::GATHER ? (size_t)0 : (size_t)HALF * P.lda * 2, hstepB = (size_t)HALF * P.ldb * 2;
    unsigned gvoC[2][2], gvoN[2][2];
    long voffBm[2]; long cBd = 0, nBd = 0;
    if constexpr (Prob::BMIRROR) {
#pragma unroll
        for (int i = 0; i < 2; ++i) { int R, C; stage_rc(tid * 16 + i * 8192, R, C); const int Rb = Prob::PERM ? ((R & ~31) + perm32(R & 31)) : R; voffBm[i] = ((long)C - (long)Rb * P.ldb) * 2; } }
    const unsigned ldsw = (unsigned)wid * 1024u;
    const int aoff = lds_byte(wr * 64 + fr, fq * 8), boff = lds_byte(wc * 32 + fr, fq * 8);
#define PG8_SA(b, h) (((b) * 2 + (h)) * HTB)
#define PG8_SB(b, h) ((4 + (b) * 2 + (h)) * HTB)
#define PG8_STAGE(bufoff, gbase, voff) do { _Pragma("unroll") for (int _i = 0; _i < 2; ++_i) \
        __builtin_amdgcn_global_load_lds((const unsigned*)((const char*)(gbase) + (voff)[_i]), (LAS unsigned*)(lds + (bufoff) + ldsw + _i * 8192), 16, 0, 0); } while (0)
#define PG8_STAGEA(bufoff, gbase, h, NX) do { if constexpr (Prob::GATHER) { if (NX) PG8_STAGE(bufoff, gbase, gvoN[h]); else PG8_STAGE(bufoff, gbase, gvoC[h]); } else PG8_STAGE(bufoff, (gbase) + (h) * hstepA, voffA); } while (0)
#define PG8_STAGEB1(bufoff, gbase, NX) do { if constexpr (Prob::BMIRROR) PG8_STAGE(bufoff, (gbase) + ((NX) ? nBd : cBd), voffBm); else PG8_STAGE(bufoff, (gbase) + hstepB, voffB); } while (0)
#define PG8_LDA(dst, b, h) do { _Pragma("unroll") for (int m = 0; m < 4; ++m) _Pragma("unroll") for (int k = 0; k < 2; ++k) dst[m][k] = *(const LAS bf16x8*)(lds + PG8_SA(b, h) + aoff + m * 2048 + k * 1024); } while (0)
#define PG8_LDB(dst, b, h) do { _Pragma("unroll") for (int n = 0; n < 2; ++n) _Pragma("unroll") for (int k = 0; k < 2; ++k) dst[n][k] = *(const LAS bf16x8*)(lds + PG8_SB(b, h) + boff + n * 2048 + k * 1024); } while (0)
#define PG8_MMA(ai, bj, At, Bt) do { __builtin_amdgcn_s_setprio(1); _Pragma("unroll") for (int m = 0; m < 4; ++m) _Pragma("unroll") for (int n = 0; n < 2; ++n) _Pragma("unroll") for (int k = 0; k < 2; ++k) \
        acc[ai][bj][m][n] = __builtin_amdgcn_mfma_f32_16x16x32_bf16(Bt[n][k], At[m][k], acc[ai][bj][m][n], 0, 0, 0); __builtin_amdgcn_s_setprio(0); } while (0)
#define PG8_WAIT_V(n) asm volatile("s_waitcnt vmcnt(" #n ")" ::: "memory")
#define PG8_WAIT_L(n) asm volatile("s_waitcnt lgkmcnt(" #n ")" ::: "memory")
#define PG8_BAR __builtin_amdgcn_s_barrier()
#define PG8_SCHED __builtin_amdgcn_sched_barrier(0)
    int u = u0;
    if (u >= P.nunits) return;
    f32x4 acc[2][2][4][2];
#pragma unroll
    for (int a = 0; a < 2; ++a)
#pragma unroll
        for (int b = 0; b < 2; ++b)
#pragma unroll
            for (int m = 0; m < 4; ++m)
#pragma unroll
                for (int n = 0; n < 2; ++n) acc[a][b][m][n] = (f32x4){0.f, 0.f, 0.f, 0.f};
    bf16x8 At[4][2], B0[2][2], B1[2][2];
    const char* cA; const char* cB; P.locate(u, cA, cB);
    if constexpr (Prob::BMIRROR) { cBd = P.bdelta(u); nBd = cBd; }
    if constexpr (Prob::GATHER) { P.aoffs(u, tid, gvoC);
#pragma unroll
        for (int h = 0; h < 2; ++h)
#pragma unroll
            for (int i = 0; i < 2; ++i) gvoN[h][i] = gvoC[h][i]; }
    PG8_STAGE(PG8_SB(0, 0), cB, voffB); PG8_STAGEB1(PG8_SB(0, 1), cB, false); PG8_STAGEA(PG8_SA(0, 0), cA, 0, false); PG8_STAGEA(PG8_SA(0, 1), cA, 1, false);
    if (wr == 1) PG8_BAR;
    PG8_WAIT_V(2); PG8_BAR;
    PG8_STAGE(PG8_SB(1, 0), cB + kstep, voffB); PG8_STAGEA(PG8_SA(1, 0), cA + kstep, 0, false); PG8_STAGEB1(PG8_SB(1, 1), cB + kstep, false);
    PG8_WAIT_V(6); PG8_BAR;
    for (;;) {
        const int un = u + ustride; const bool has_next = un < P.nunits;
        const char* nA = cA; const char* nB = cB; if (has_next) P.locate(un, nA, nB);
        if constexpr (Prob::GATHER) { if (has_next) P.aoffs(un, tid, gvoN); }
        if constexpr (Prob::BMIRROR) { nBd = has_next ? P.bdelta(un) : cBd; }
        for (int t = 0; t < nt; t += 2) {
            const bool last = (t == nt - 2);
            const char* a1 = cA + (size_t)(t + 1) * kstep;
            const char* a2 = last ? nA : cA + (size_t)(t + 2) * kstep; const char* b2 = last ? nB : cB + (size_t)(t + 2) * kstep;
            const char* a3 = a2 + kstep; const char* b3 = b2 + kstep;
            PG8_LDB(B0, 0, 0); PG8_LDB(B1, 0, 1); PG8_SCHED; PG8_LDA(At, 0, 0); PG8_STAGEA(PG8_SA(1, 1), a1, 1, false);
            PG8_WAIT_V(8); PG8_WAIT_L(0); PG8_BAR; PG8_MMA(0, 0, At, B0); PG8_MMA(0, 1, At, B1); PG8_BAR; PG8_SCHED;
            PG8_LDA(At, 0, 1); PG8_STAGE(PG8_SB(0, 0), b2, voffB); PG8_STAGEB1(PG8_SB(0, 1), b2, last); PG8_STAGEA(PG8_SA(0, 0), a2, 0, last);
            PG8_WAIT_V(8); PG8_WAIT_L(0); PG8_BAR; PG8_MMA(1, 0, At, B0); PG8_MMA(1, 1, At, B1); PG8_BAR; PG8_SCHED;
            PG8_LDB(B0, 1, 0); PG8_LDB(B1, 1, 1); PG8_SCHED; PG8_LDA(At, 1, 0); PG8_STAGEA(PG8_SA(0, 1), a2, 1, last);
            PG8_WAIT_V(8); PG8_WAIT_L(0); PG8_BAR; PG8_MMA(0, 0, At, B0); PG8_MMA(0, 1, At, B1); PG8_BAR; PG8_SCHED;
            PG8_LDA(At, 1, 1); PG8_STAGE(PG8_SB(1, 0), b3, voffB); PG8_STAGEB1(PG8_SB(1, 1), b3, last); PG8_STAGEA(PG8_SA(1, 0), a3, 0, last);
            PG8_WAIT_V(8); PG8_WAIT_L(0); PG8_BAR; PG8_MMA(1, 0, At, B0); PG8_MMA(1, 1, At, B1); PG8_BAR; PG8_SCHED;
        }
        if (wr == 0) PG8_BAR;
        P.epi(acc, u, wr, wc, fr, fq);
        if (!has_next) break;
#pragma unroll
        for (int a = 0; a < 2; ++a)
#pragma unroll
            for (int b = 0; b < 2; ++b)
#pragma unroll
                for (int m = 0; m < 4; ++m)
#pragma unroll
                    for (int n = 0; n < 2; ++n) acc[a][b][m][n] = (f32x4){0.f, 0.f, 0.f, 0.f};
        u = un; cA = nA; cB = nB; if constexpr (Prob::BMIRROR) cBd = nBd;
        if constexpr (Prob::GATHER) {
#pragma unroll
            for (int h = 0; h < 2; ++h)
#pragma unroll
                for (int i = 0; i < 2; ++i) gvoC[h][i] = gvoN[h][i]; }
        if (wr == 1) PG8_BAR;
    }
    PG8_WAIT_V(0);
    PG8_BAR;
#undef PG8_SA
#undef PG8_SB
#undef PG8_STAGE
#undef PG8_STAGEA
#undef PG8_STAGEB1
#undef PG8_LDA
#undef PG8_LDB
#undef PG8_MMA
#undef PG8_WAIT_V
#undef PG8_WAIT_L
#undef PG8_BAR
#undef PG8_SCHED
}
__device__ __forceinline__ void tile_of(int u, int nM, int nN, int& pm, int& pn) {
    const int nig = 8 * nN, g = u / nig, r = u % nig, fm = g * 8, gsz = (nM - fm) < 8 ? (nM - fm) : 8;
    pm = fm + r % gsz; pn = r / gsz;
}
__device__ __forceinline__ void st8(bf16* p, f32x4 v0, f32x4 v1) {
    u32x4 w; w.x = cvt_pk_bf16(v0[0], v0[1]); w.y = cvt_pk_bf16(v0[2], v0[3]); w.z = cvt_pk_bf16(v1[0], v1[1]); w.w = cvt_pk_bf16(v1[2], v1[3]);
    *(u32x4*)p = w;
}
}

typedef __bf16 bf16x2_t __attribute__((ext_vector_type(2)));
__device__ __forceinline__ unsigned cvtpk(float lo, float hi) { f32x2 v = {lo, hi}; bf16x2_t b = __builtin_convertvector(v, bf16x2_t); return __builtin_bit_cast(unsigned, b); }

struct ProbPlain {
    static constexpr bool GATHER = false; static constexpr bool BMIRROR = false; static constexpr bool PERM = true;
    int K, lda, ldb, nunits; const bf16* A; const bf16* Bt; bf16* O; int ldc, nM, nN;
    __device__ __forceinline__ void locate(int u, const char*& a, const char*& b) const { int pm, pn; pg8::tile_of(u, nM, nN, pm, pn); a = (const char*)(A + (size_t)pm * 256 * lda); b = (const char*)(Bt + (size_t)pn * 256 * ldb); }
    __device__ __forceinline__ void epi(const f32x4 (&acc)[2][2][4][2], int u, int wr, int wc, int fr, int fq) const {
        int pm, pn; pg8::tile_of(u, nM, nN, pm, pn);
        const int row0 = pm * 256 + wr * 64 + fr, col0 = pn * 256 + wc * 32 + 8 * fq;
#pragma unroll
        for (int ai = 0; ai < 2; ++ai)
#pragma unroll
            for (int m = 0; m < 4; ++m) { bf16* rowp = O + (size_t)(row0 + ai * 128 + m * 16) * ldc + col0;
#pragma unroll
                for (int bj = 0; bj < 2; ++bj) pg8::st8(rowp + bj * 128, acc[ai][bj][m][0], acc[ai][bj][m][1]); }
    }
};
struct ProbInAB {
    static constexpr bool GATHER = false; static constexpr bool BMIRROR = false; static constexpr bool PERM = true;
    int K, lda, ldb, nunits; const bf16* A; const bf16* Bt; bf16* O;
    __device__ __forceinline__ void map(int u, int& pm, int& pn) const {
        if (u < 32 * 21) pg8::tile_of(u, 32, 21, pm, pn);
        else { const int v = u - 32 * 21, q = v >> 2; pm = 32 + (v & 3); pn = q < 3 ? 6 + q : 9 + q; } }
    __device__ __forceinline__ void locate(int u, const char*& a, const char*& b) const { int pm, pn; map(u, pm, pn); a = (const char*)(A + (size_t)pm * 256 * lda); b = (const char*)(Bt + (size_t)pn * 256 * ldb); }
    __device__ __forceinline__ void epi(const f32x4 (&acc)[2][2][4][2], int u, int wr, int wc, int fr, int fq) const {
        int pm, pn; map(u, pm, pn);
        const int row0 = pm * 256 + wr * 64 + fr, col0 = pn * 256 + wc * 32 + 8 * fq;
#pragma unroll
        for (int ai = 0; ai < 2; ++ai)
#pragma unroll
            for (int m = 0; m < 4; ++m) { bf16* rowp = O + (size_t)(row0 + ai * 128 + m * 16) * IN_AB_PAD + col0;
#pragma unroll
                for (int bj = 0; bj < 2; ++bj) pg8::st8(rowp + bj * 128, acc[ai][bj][m][0], acc[ai][bj][m][1]); }
    }
};
template <bool HBF> struct ProbOut {
    static constexpr bool GATHER = false; static constexpr bool BMIRROR = false; static constexpr bool PERM = true;
    int K, lda, ldb, nunits; const bf16* A; const bf16* Bt; const void* h; const float* gate; bf16* pre;
    __device__ __forceinline__ void locate(int u, const char*& a, const char*& b) const { int pm, pn; pg8::tile_of(u, 32, 8, pm, pn); a = (const char*)(A + (size_t)pm * 256 * lda); b = (const char*)(Bt + (size_t)pn * 256 * ldb); }
    __device__ __forceinline__ void epi(const f32x4 (&acc)[2][2][4][2], int u, int wr, int wc, int fr, int fq) const {
        int pm, pn; pg8::tile_of(u, 32, 8, pm, pn);
        const int row0 = pm * 256 + wr * 64 + fr, col0 = pn * 256 + wc * 32 + 8 * fq;
        const float* g = gate + (size_t)(pm >> 3) * (6 * D);
        f32x4 gv[2][2];
#pragma unroll
        for (int bj = 0; bj < 2; ++bj)
#pragma unroll
            for (int n = 0; n < 2; ++n) gv[bj][n] = *(const f32x4*)(g + col0 + bj * 128 + n * 4);
#pragma unroll
        for (int ai = 0; ai < 2; ++ai)
#pragma unroll
            for (int m = 0; m < 4; ++m) { const size_t off = (size_t)(row0 + ai * 128 + m * 16) * D + col0;
#pragma unroll
                for (int bj = 0; bj < 2; ++bj) { f32x4 h0, h1;
                    if (HBF) { const u32x4 w = *(const u32x4*)((const bf16*)h + off + bj * 128); h0 = (f32x4){bflo(w.x), bfhi(w.x), bflo(w.y), bfhi(w.y)}; h1 = (f32x4){bflo(w.z), bfhi(w.z), bflo(w.w), bfhi(w.w)}; }
                    else { h0 = *(const f32x4*)((const float*)h + off + bj * 128); h1 = *(const f32x4*)((const float*)h + off + bj * 128 + 4); }
                    pg8::st8(pre + off + bj * 128, h0 * DN_ALPHA + gv[bj][0] * acc[ai][bj][m][0], h1 * DN_ALPHA + gv[bj][1] * acc[ai][bj][m][1]); } }
    }
};
struct ProbMoe1 {
    static constexpr bool GATHER = true; static constexpr bool BMIRROR = false; static constexpr bool PERM = true;
    int K, lda, ldb, nunits; const bf16* U2; const int* IDX; const bf16* W13; bf16* HDN;
    __device__ __forceinline__ void map(int u, int& rt, int& pn) const { const int b = u & 3, q = u >> 2; pn = q % 11; rt = (q / 11) * 4 + b; }
    __device__ __forceinline__ void locate(int u, const char*& a, const char*& b) const { int rt, pn; map(u, rt, pn); a = (const char*)U2; b = (const char*)(W13 + (size_t)(rt >> 2) * (2 * FF * D) + (size_t)pn * 256 * D); }
    __device__ __forceinline__ void aoffs(int u, int tid, unsigned (&vo)[2][2]) const { int rt, pn; map(u, rt, pn);
#pragma unroll
        for (int i = 0; i < 2; ++i) { int R, C; pg8::stage_rc(tid * 16 + i * 8192, R, C);
#pragma unroll
            for (int h = 0; h < 2; ++h) { const int row = (rt & 3) * SEQ + IDX[rt * CAP + h * 128 + R]; vo[h][i] = (unsigned)(row * D + C) * 2u; } } }
    __device__ __forceinline__ void epi(const f32x4 (&acc)[2][2][4][2], int u, int wr, int wc, int fr, int fq) const {
        int rt, pn; map(u, rt, pn);
        const int row0 = rt * 256 + wr * 64 + fr, col0 = pn * 128 + wc * 32 + 8 * fq;
#pragma unroll
        for (int ai = 0; ai < 2; ++ai)
#pragma unroll
            for (int m = 0; m < 4; ++m) { bf16* rowp = HDN + (size_t)(row0 + ai * 128 + m * 16) * FF + col0;
                f32x4 v[2];
#pragma unroll
                for (int n = 0; n < 2; ++n) { const f32x4 a = acc[ai][0][m][n], g = acc[ai][1][m][n];
#pragma unroll
                    for (int j = 0; j < 4; ++j) v[n][j] = a[j] / (1.f + __expf(-a[j])) * g[j]; }
                pg8::st8(rowp, v[0], v[1]); }
    }
};
struct ProbMoe2 {
    static constexpr bool GATHER = false; static constexpr bool BMIRROR = false; static constexpr bool PERM = true;
    int K, lda, ldb, nunits; const bf16* HDN; const bf16* W2; const float* gate; bf16* YE;
    __device__ __forceinline__ void map(int u, int& rt, int& pn) const { const int b = u & 3, q = u >> 2; pn = q & 7; rt = (q >> 3) * 4 + b; }
    __device__ __forceinline__ void locate(int u, const char*& a, const char*& b) const { int rt, pn; map(u, rt, pn); a = (const char*)(HDN + (size_t)rt * 256 * FF); b = (const char*)(W2 + (size_t)(rt >> 2) * (D * FF) + (size_t)pn * 256 * FF); }
    __device__ __forceinline__ void epi(const f32x4 (&acc)[2][2][4][2], int u, int wr, int wc, int fr, int fq) const {
        int rt, pn; map(u, rt, pn);
        const int row0 = rt * 256 + wr * 64 + fr, col0 = pn * 256 + wc * 32 + 8 * fq;
#pragma unroll
        for (int ai = 0; ai < 2; ++ai)
#pragma unroll
            for (int m = 0; m < 4; ++m) { const int row = row0 + ai * 128 + m * 16; const float gt = gate[row]; bf16* rowp = YE + (size_t)row * D + col0;
#pragma unroll
                for (int bj = 0; bj < 2; ++bj) pg8::st8(rowp + bj * 128, acc[ai][bj][m][0] * gt, acc[ai][bj][m][1] * gt); }
    }
};
struct ProbF1 {
    static constexpr bool GATHER = false; static constexpr bool BMIRROR = true; static constexpr bool PERM = true;
    int K, lda, ldb, nunits; const bf16* CS; const bf16* P1; bf16* T1;
    __device__ __forceinline__ void map(int u, int& bg, int& pm, int& jt) const { jt = u & 7; pm = (u >> 3) & 1; bg = u >> 4; }
    __device__ __forceinline__ void locate(int u, const char*& a, const char*& b) const { int bg, pm, jt; map(u, bg, pm, jt);
        a = (const char*)(CS + (size_t)pm * 256 * 256); b = (const char*)(P1 + ((size_t)(bg >> 2) * SEQ + (size_t)jt * 128) * IN_CD + HY3 + (bg & 3) * 256); }
    __device__ __forceinline__ long bdelta(int u) const { const int jt = u & 7; return (long)(SEQ - 256 * jt) * IN_CD * 2; }
    __device__ __forceinline__ void epi(const f32x4 (&acc)[2][2][4][2], int u, int wr, int wc, int fr, int fq) const {
        int bg, pm, jt; map(u, bg, pm, jt);
        const int k20 = wr * 64 + fr, t0 = jt * 128 + wc * 32 + 8 * fq;
#pragma unroll
        for (int ai = 0; ai < 2; ++ai)
#pragma unroll
            for (int m = 0; m < 4; ++m) { const int k2 = k20 + ai * 128 + m * 16; bf16* rowp = T1 + ((size_t)bg * 256 + k2) * SEQ;
                f32x4 v0, v1;
                if (pm == 0) { v0 = acc[ai][0][m][0] + acc[ai][1][m][0]; v1 = acc[ai][0][m][1] + acc[ai][1][m][1]; if (t0 == 0) v0[0] = acc[ai][0][m][0][0]; pg8::st8(rowp + t0, v0, v1); }
                else { v0 = acc[ai][0][m][0] - acc[ai][1][m][0]; v1 = acc[ai][0][m][1] - acc[ai][1][m][1];
                    if (t0 != 0) pg8::st8(rowp + 1024 + t0, v0, v1);
                    else { bf16* q = rowp + 1024; q[1] = (bf16)f2bf(v0[1]); q[2] = (bf16)f2bf(v0[2]); q[3] = (bf16)f2bf(v0[3]); q[4] = (bf16)f2bf(v1[0]); q[5] = (bf16)f2bf(v1[1]); q[6] = (bf16)f2bf(v1[2]); q[7] = (bf16)f2bf(v1[3]); } }
            }
    }
};
__device__ __forceinline__ void f1_mid(const bf16* CS, const bf16* P1, bf16* T1, int gt, int NGT) {
    for (int i = gt; i < 16 * 256; i += NGT) { const int bg = i >> 8, k2 = i & 255; const bf16* c = CS + (size_t)k2 * 256; const bf16* g = P1 + ((size_t)(bg >> 2) * SEQ + 1024) * IN_CD + HY3 + (bg & 3) * 256;
        float a = 0.f;
        for (int n = 0; n < 256; n += 8) { const u32x4 cw = *(const u32x4*)(c + n), gw = *(const u32x4*)(g + n);
            a += bflo(cw.x) * bflo(gw.x) + bfhi(cw.x) * bfhi(gw.x) + bflo(cw.y) * bflo(gw.y) + bfhi(cw.y) * bfhi(gw.y) + bflo(cw.z) * bflo(gw.z) + bfhi(cw.z) * bfhi(gw.z) + bflo(cw.w) * bflo(gw.w) + bfhi(cw.w) * bfhi(gw.w); }
        T1[((size_t)bg * 256 + k2) * SEQ + 1024] = (bf16)f2bf(a); }
}
struct ProbF2 {
    static constexpr bool GATHER = false; static constexpr bool BMIRROR = false; static constexpr bool PERM = true;
    int K, lda, ldb, nunits; const bf16* CSL; const bf16* T1; bf16* CAT;
    __device__ __forceinline__ void locate(int u, const char*& a, const char*& b) const { const int pm = u & 7, bg = u >> 3; a = (const char*)(CSL + (size_t)pm * 256 * 2048); b = (const char*)(T1 + (size_t)bg * 256 * 2048); }
    __device__ __forceinline__ void epi(const f32x4 (&acc)[2][2][4][2], int u, int wr, int wc, int fr, int fq) const {
        const int pm = u & 7, bg = u >> 3;
        const int row0 = (bg >> 2) * SEQ + pm * 256 + wr * 64 + fr, col0 = 1024 + (bg & 3) * 256 + wc * 32 + 8 * fq;
#pragma unroll
        for (int ai = 0; ai < 2; ++ai)
#pragma unroll
            for (int m = 0; m < 4; ++m) { bf16* rowp = CAT + (size_t)(row0 + ai * 128 + m * 16) * D + col0;
#pragma unroll
                for (int bj = 0; bj < 2; ++bj) pg8::st8(rowp + bj * 128, acc[ai][bj][m][0], acc[ai][bj][m][1]); }
    }
};

namespace att {
typedef short v4i16_t __attribute__((ext_vector_type(4)));
__device__ __forceinline__ s16x4 vtr(const LAS unsigned char* p) { return __builtin_bit_cast(s16x4, __builtin_amdgcn_ds_read_tr16_b64_v4i16((LAS v4i16_t*)p)); }
constexpr int VS = 320;
struct Tensors { const bf16* P; const bf16* KV; const bf16* KPE; const float* rpb; bf16* CAT; };

template <int MODE>
__device__ __forceinline__ void attn_unit(LAS unsigned char* lds, const Tensors& T, int unit) {
    constexpr int DK = MODE == 0 ? 192 : 128, NS = DK / 16, KCH = DK / 8, KS = DK * 2 + 16;
    constexpr int KBYTES = 64 * KS, VBYTES = 64 * VS, BUF = KBYTES + VBYTES;
    constexpr int NKC = (64 * KCH) / NTHR;
    const int tid = tid_opaque(), wave = __builtin_amdgcn_readfirstlane(tid >> 6), lane = tid & 63, l32 = lane & 31, hf = lane >> 5;
    const int b = unit >> 6, h = (unit >> 3) & 7, sub = unit & 7;
    LAS float* rpb_l = (LAS float*)(lds + 2 * BUF);
    int qrow, r = 0, qc = 0, krlo = 0, nkt;
    if (MODE == 0) { qrow = b * SEQ + sub * 256 + wave * 32 + l32; nkt = 36; }
    else { r = sub * 4 + (wave >> 1); qc = (wave & 1) * 32 + l32; qrow = b * SEQ + r * GW + qc;
        const int r0 = sub * 4, r3 = r0 + 3; krlo = r0 - 4 < 0 ? 0 : (r0 - 4 > 24 ? 24 : r0 - 4); const int rs3 = r3 - 4 < 0 ? 0 : (r3 - 4 > 24 ? 24 : r3 - 4);
        nkt = 4 + (rs3 + 8 - krlo); }
    const int rs = r - 4 < 0 ? 0 : (r - 4 > 24 ? 24 : r - 4);
    const int cs = qc - 8 < 0 ? 0 : (qc - 8 > 48 ? 48 : qc - 8);
    bf16x8 qf[NS];
    { const bf16* qp = T.P + (size_t)qrow * IN_AB_PAD + (MODE == 0 ? h * 192 : OFF_QNA + h * 128) + 8 * hf;
#pragma unroll
      for (int s = 0; s < NS; ++s) qf[s] = *(const bf16x8*)(qp + 16 * s); }
    if (MODE == 1) { for (int i = tid; i < 15 * 31; i += NTHR) rpb_l[i] = T.rpb[h * 465 + i]; }
    u32x4 kreg[NKC], vreg[2];
    auto key_row = [&](int kt, int rr) -> int {
        if (MODE == 0) return kt < 32 ? b * SEQ + kt * 64 + rr : MLAT + b * LC + (kt - 32) * 64 + rr;
        return kt < 4 ? MLAT + b * LC + kt * 64 + rr : b * SEQ + (krlo + kt - 4) * GW + rr;
    };
    auto load_tile = [&](int kt) {
#pragma unroll
        for (int i = 0; i < NKC; ++i) { const int ci = tid + i * NTHR, rr = ci / KCH, c = ci % KCH; const int row = key_row(kt, rr);
            const bf16* src;
            if (MODE == 0) src = c < 16 ? T.KV + (size_t)row * D + h * 256 + c * 8 : T.KPE + (size_t)row * 64 + (c - 16) * 8;
            else src = T.P + (size_t)row * IN_AB_PAD + OFF_KNA + h * 128 + c * 8;
            kreg[i] = *(const u32x4*)src; }
#pragma unroll
        for (int i = 0; i < 2; ++i) { const int ci = tid + i * NTHR, rr = ci >> 4, c = ci & 15; const int row = key_row(kt, rr);
            const bf16* src = MODE == 0 ? T.KV + (size_t)row * D + h * 256 + 128 + c * 8 : T.P + (size_t)row * IN_AB_PAD + OFF_VNA + h * 128 + c * 8;
            vreg[i] = *(const u32x4*)src; }
    };
    auto store_tile = [&](int buf) {
        LAS unsigned char* kb = lds + buf * BUF; LAS unsigned char* vb = kb + KBYTES;
#pragma unroll
        for (int i = 0; i < NKC; ++i) { const int ci = tid + i * NTHR, rr = ci / KCH, c = ci % KCH; *(LAS u32x4*)(kb + rr * KS + c * 16) = kreg[i]; }
#pragma unroll
        for (int i = 0; i < 2; ++i) { const int ci = tid + i * NTHR, rr = ci >> 4, c = ci & 15; *(LAS u32x4*)(vb + rr * VS + c * 16) = vreg[i]; }
    };
    f32x16 o[4];
#pragma unroll
    for (int c = 0; c < 4; ++c)
#pragma unroll
        for (int i = 0; i < 16; ++i) o[c][i] = 0.f;
    float m_run = -1e30f, l_run = 0.f;
    const float sc2 = (MODE == 0 ? 0.07216878364870322f : 0.08838834764831845f) * 1.4426950408889634f;
    load_tile(0); store_tile(0); __syncthreads();
    for (int kt = 0; kt < nkt; ++kt) {
        if (kt + 1 < nkt) load_tile(kt + 1);
        const int kr = krlo + kt - 4;
        const bool active = MODE == 0 || kt < 4 || (kr >= rs && kr < rs + 8);
        if (active) {
            const LAS unsigned char* kb = lds + (kt & 1) * BUF; const LAS unsigned char* vb = kb + KBYTES;
            constexpr int NG = NS / 4;
            bf16x8 kf[2][4];
            auto ldk = [&](int kb2, int g, bf16x8 (&dst)[4]) {
#pragma unroll
                for (int i = 0; i < 4; ++i) dst[i] = *(const LAS bf16x8*)(kb + (32 * kb2 + l32) * KS + (16 * (4 * g + i) + 8 * hf) * 2); };
            ldk(0, 0, kf[0]);
#pragma unroll
            for (int kb2 = 0; kb2 < 2; ++kb2) {
                f32x16 sc;
#pragma unroll
                for (int i = 0; i < 16; ++i) sc[i] = 0.f;
#pragma unroll
                for (int g = 0; g < NG; ++g) {
                    const int cur = (kb2 * NG + g) & 1;
                    if (g + 1 < NG) ldk(kb2, g + 1, kf[cur ^ 1]); else if (kb2 == 0) ldk(1, 0, kf[cur ^ 1]);
                    __builtin_amdgcn_sched_barrier(0);
#pragma unroll
                    for (int i = 0; i < 4; ++i) sc = __builtin_amdgcn_mfma_f32_32x32x16_bf16(kf[cur][i], qf[4 * g + i], sc, 0, 0, 0);
                    __builtin_amdgcn_sched_barrier(0);
                }
                float mx = -1e30f;
                if (MODE == 1 && kt >= 4) {
#pragma unroll
                    for (int i = 0; i < 16; ++i) { const int kc = 32 * kb2 + 8 * (i >> 2) + 4 * hf + (i & 3); const bool ok = (unsigned)(kc - cs) < 16u;
                        int bi = (kr - r + 7) * 31 + (kc - qc + 15); bi = ok ? bi : 0;
                        const float v = ok ? sc[i] * sc2 + rpb_l[bi] * 1.4426950408889634f : -1e30f; sc[i] = v; mx = fmaxf(mx, v); }
                } else {
#pragma unroll
                    for (int i = 0; i < 16; ++i) mx = fmaxf(mx, sc[i]);
                    mx *= sc2;
                }
                mx = fmaxf(mx, __shfl_xor(mx, 32));
                const bool upd = mx > m_run + 8.f;
                const float m_new = upd ? mx : m_run, alpha = upd ? __builtin_amdgcn_exp2f(m_run - m_new) : 1.f;
                m_run = m_new;
                float ps = 0.f;
                if (MODE == 1 && kt >= 4) {
#pragma unroll
                    for (int i = 0; i < 16; ++i) { const float p = __builtin_amdgcn_exp2f(sc[i] - m_new); sc[i] = p; ps += p; }
                } else {
#pragma unroll
                    for (int i = 0; i < 16; ++i) { const float p = __builtin_amdgcn_exp2f(__builtin_fmaf(sc[i], sc2, -m_new)); sc[i] = p; ps += p; }
                }
                l_run = l_run * alpha + ps;
                if (__builtin_amdgcn_ballot_w64(alpha != 1.f) != 0ull) {
#pragma unroll
                    for (int c = 0; c < 4; ++c)
#pragma unroll
                        for (int i = 0; i < 16; ++i) o[c][i] *= alpha; }
                bf16x8 vf[2][4];
                auto ldv = [&](int s2, bf16x8 (&dst)[4]) {
                    const LAS unsigned char* vrow = vb + (32 * kb2 + 16 * s2 + 4 * hf + ((lane & 15) >> 2)) * VS + (16 * ((lane >> 4) & 1) + 4 * (lane & 3)) * 2;
#pragma unroll
                    for (int c = 0; c < 4; ++c) { const s16x4 v0 = vtr(vrow + c * 64), v1 = vtr(vrow + 8 * VS + c * 64); dst[c] = (bf16x8){v0[0], v0[1], v0[2], v0[3], v1[0], v1[1], v1[2], v1[3]}; } };
                ldv(0, vf[0]);
#pragma unroll
                for (int s2 = 0; s2 < 2; ++s2) {
                    if (s2 == 0) ldv(1, vf[1]);
                    __builtin_amdgcn_sched_barrier(0);
                    u32x4 pw; pw.x = cvtpk(sc[8 * s2 + 0], sc[8 * s2 + 1]); pw.y = cvtpk(sc[8 * s2 + 2], sc[8 * s2 + 3]);
                    pw.z = cvtpk(sc[8 * s2 + 4], sc[8 * s2 + 5]); pw.w = cvtpk(sc[8 * s2 + 6], sc[8 * s2 + 7]);
                    const bf16x8 pf = __builtin_bit_cast(bf16x8, pw);
#pragma unroll
                    for (int c = 0; c < 4; ++c) o[c] = __builtin_amdgcn_mfma_f32_32x32x16_bf16(vf[s2][c], pf, o[c], 0, 0, 0);
                }
            }
        }
        if (kt + 1 < nkt) store_tile((kt + 1) & 1);
        __syncthreads();
    }
    const float linv = 1.f / (l_run + __shfl_xor(l_run, 32));
    bf16* op = T.CAT + (size_t)qrow * D + (MODE == 0 ? h * 128 : 1024 + h * 128) + 4 * hf;
#pragma unroll
    for (int c = 0; c < 4; ++c)
#pragma unroll
        for (int g = 0; g < 4; ++g) { u32x2 w; w.x = cvtpk(o[c][4 * g] * linv, o[c][4 * g + 1] * linv); w.y = cvtpk(o[c][4 * g + 2] * linv, o[c][4 * g + 3] * linv);
            *(u32x2*)(op + 32 * c + 8 * g) = w; }
}
}

namespace hy {
constexpr int ZROW = 4800;
constexpr int Z_BYTES = 16 * ZROW;
constexpr int HR_OFF = 76800;
constexpr int HR_CH = 16384 + 64, HR_C1 = 8192 + 64;
constexpr int XROW = 4096 + 16;
constexpr int HR_BYTES = 16 * XROW;
static_assert(HR_OFF + HR_BYTES <= LDS_MAIN && HR_OFF >= Z_BYTES && HR_BYTES >= 4 * HR_CH, "hyena LDS map");

__device__ __forceinline__ void load_rows(LAS unsigned char* lds, const bf16* ST, int part, int c0, bool zlayout) {
    const int tid = tid_opaque();
#pragma unroll
    for (int i = 0; i < 8; ++i) { const int ci = tid + i * NTHR, row = ci >> 8, cc = ci & 255, ch = row >> 2, b = row & 3;
        const u32x4 v = *(const u32x4*)(ST + ((size_t)(b * HY3 + part * HYW + c0 + ch) * SEQ + cc * 8));
        if (zlayout) *(LAS u32x4*)(lds + row * ZROW + (cc >> 3) * 144 + (cc & 7) * 16) = v;
        else *(LAS u32x4*)(lds + HR_OFF + row * XROW + cc * 16) = v; }
}
__device__ __forceinline__ void load_hr(LAS unsigned char* lds, const bf16* HRg, int o, int c0) {
    const int tid = tid_opaque();
#pragma unroll
    for (int i = 0; i < 4; ++i) { const int ci = tid + i * NTHR, ch = ci >> 9, cc = ci & 511;
        const unsigned* src = (const unsigned*)(HRg + ((size_t)(o * HYW + c0 + ch) * 4096 + cc * 8));
        const u32x4 v = *(const u32x4*)src; const unsigned nx = cc == 511 ? 0u : src[4];
        *(LAS u32x4*)(lds + HR_OFF + ch * HR_CH + cc * 16) = v;
        u32x4 s; s.x = (v.x >> 16) | (v.y << 16); s.y = (v.y >> 16) | (v.z << 16); s.z = (v.z >> 16) | (v.w << 16); s.w = (v.w >> 16) | (nx << 16);
        *(LAS u32x4*)(lds + HR_OFF + ch * HR_CH + HR_C1 + cc * 16) = s; }
}
struct ConvAddr { const LAS unsigned char* a; const LAS unsigned char* b[4]; };
__device__ __forceinline__ void conv_addr(ConvAddr& c, const LAS unsigned char* hrc, const LAS unsigned char* zl, int d, int xb, int il) {
    const int x0 = xb - 64 * d;
    c.a = hrc + (x0 & 1) * HR_C1 + (x0 >> 1) * 4;
    const int j0 = il - d;
#pragma unroll
    for (int n = 0; n < 4; ++n) { const int j = j0 + 8 * n; c.b[n] = zl + ((unsigned)j < 32u ? j : 32) * 144; }
}
template <int K4, int MASK>
__device__ __forceinline__ void conv_load(const ConvAddr& c, u32x4& a, u32x4 (&b)[4]) {
    const LAS unsigned* ap = (const LAS unsigned*)(c.a + K4 * 32);
    a.x = ap[0]; a.y = ap[1]; a.z = ap[2]; a.w = ap[3];
#pragma unroll
    for (int n = 0; n < 4; ++n) if ((MASK >> n) & 1) b[n] = *(const LAS u32x4*)(c.b[n] + K4 * 32);
}
template <int MASK>
__device__ __forceinline__ void conv_step(f32x16 (&acc)[4], const u32x4& a, const u32x4 (&b)[4]) {
    const bf16x8 af = __builtin_bit_cast(bf16x8, a);
#pragma unroll
    for (int n = 0; n < 4; ++n) if ((MASK >> n) & 1) acc[n] = __builtin_amdgcn_mfma_f32_32x32x16_bf16(af, __builtin_bit_cast(bf16x8, b[n]), acc[n], 0, 0, 0);
}
template <int MASK>
__device__ __forceinline__ void conv_seg(f32x16 (&acc)[4], const LAS unsigned char* hrc, const LAS unsigned char* zl, int xb, int il, int dlo, int dhi) {
    u32x4 fa0, fb0[4], fa1, fb1[4], fa2, fb2[4], fa3, fb3[4];
    ConvAddr ca; conv_addr(ca, hrc, zl, dlo, xb, il);
    conv_load<0, MASK>(ca, fa0, fb0); conv_load<1, MASK>(ca, fa1, fb1);
#pragma unroll 1
    for (int d = dlo; d <= dhi; ++d) {
        ConvAddr cn; conv_addr(cn, hrc, zl, d < dhi ? d + 1 : dhi, xb, il);
        conv_load<2, MASK>(ca, fa2, fb2); conv_step<MASK>(acc, fa0, fb0);
        conv_load<3, MASK>(ca, fa3, fb3); conv_step<MASK>(acc, fa1, fb1);
        conv_load<0, MASK>(cn, fa0, fb0); conv_step<MASK>(acc, fa2, fb2);
        conv_load<1, MASK>(cn, fa1, fb1); conv_step<MASK>(acc, fa3, fb3);
        ca = cn;
    }
}
__device__ __forceinline__ void conv_mma(LAS unsigned char* lds, f32x16 (&acc)[4], int wave, int lane) {
    const int ch = wave >> 1, a0 = (wave & 1) * 32, l32 = lane & 31, hf = lane >> 5, il = l32 >> 2, b = l32 & 3;
    const LAS unsigned char* hrc = lds + HR_OFF + ch * HR_CH;
    const LAS unsigned char* zl = lds + (ch * 4 + b) * ZROW + hf * 16;
    const int xb = 2048 - a0 - l32 + 8 * hf;
#pragma unroll
    for (int n = 0; n < 4; ++n)
#pragma unroll
        for (int i = 0; i < 16; ++i) acc[n][i] = 0.f;
    conv_seg<0x1>(acc, hrc, zl, xb, il, -31, -24);
    conv_seg<0x3>(acc, hrc, zl, xb, il, -23, -16);
    conv_seg<0x7>(acc, hrc, zl, xb, il, -15, -8);
    conv_seg<0xF>(acc, hrc, zl, xb, il, -7, 7);
    conv_seg<0xE>(acc, hrc, zl, xb, il, 8, 15);
    conv_seg<0xC>(acc, hrc, zl, xb, il, 16, 23);
    conv_seg<0x8>(acc, hrc, zl, xb, il, 24, 31);
}
__device__ __forceinline__ void gate_epi(LAS unsigned char* lds, f32x16 (&acc)[4], float skip, int wave, int lane) {
    const int ch = wave >> 1, a0 = (wave & 1) * 32, l32 = lane & 31, hf = lane >> 5, il = l32 >> 2, b = l32 & 3;
#pragma unroll
    for (int n = 0; n < 4; ++n)
#pragma unroll
        for (int g = 0; g < 4; ++g) { const int i = 8 * n + il, ao = a0 + 8 * g + 4 * hf;
            const u32x2 zw = *(const LAS u32x2*)(lds + (ch * 4 + b) * ZROW + i * 144 + ao * 2);
            const u32x2 xw = *(const LAS u32x2*)(lds + HR_OFF + (ch * 4 + b) * XROW + (64 * i + ao) * 2);
            acc[n][4 * g + 0] = bflo(xw.x) * (acc[n][4 * g + 0] + skip * bflo(zw.x));
            acc[n][4 * g + 1] = bfhi(xw.x) * (acc[n][4 * g + 1] + skip * bfhi(zw.x));
            acc[n][4 * g + 2] = bflo(xw.y) * (acc[n][4 * g + 2] + skip * bflo(zw.y));
            acc[n][4 * g + 3] = bfhi(xw.y) * (acc[n][4 * g + 3] + skip * bfhi(zw.y)); }
}
__device__ __forceinline__ void hyena_unit(LAS unsigned char* lds, const bf16* ST, const bf16* HRg, const float* skip, bf16* CAT, int unit) {
    const int tid = tid_opaque(), wave = __builtin_amdgcn_readfirstlane(tid >> 6), lane = tid & 63;
    const int c0 = unit * 4, ch = wave >> 1, a0 = (wave & 1) * 32, l32 = lane & 31, hf = lane >> 5, il = l32 >> 2, b = l32 & 3;
    f32x16 acc[4];
    load_rows(lds, ST, 0, c0, true); load_hr(lds, HRg, 0, c0);
    if (tid < 128) *(LAS u32x4*)(lds + (tid >> 3) * ZROW + 32 * 144 + (tid & 7) * 16) = (u32x4){0u, 0u, 0u, 0u};
    __syncthreads();
    conv_mma(lds, acc, wave, lane);
    __syncthreads();
    load_rows(lds, ST, 1, c0, false);
    __syncthreads();
    gate_epi(lds, acc, skip[c0 + ch], wave, lane);
    __syncthreads();
#pragma unroll
    for (int n = 0; n < 4; ++n)
#pragma unroll
        for (int g = 0; g < 4; ++g) { const int i = 8 * n + il, ao = a0 + 8 * g + 4 * hf;
            u32x2 w; w.x = cvtpk(acc[n][4 * g], acc[n][4 * g + 1]); w.y = cvtpk(acc[n][4 * g + 2], acc[n][4 * g + 3]);
            *(LAS u32x2*)(lds + (ch * 4 + b) * ZROW + i * 144 + ao * 2) = w; }
    load_hr(lds, HRg, 1, c0);
    __syncthreads();
    conv_mma(lds, acc, wave, lane);
    __syncthreads();
    load_rows(lds, ST, 2, c0, false);
    __syncthreads();
    gate_epi(lds, acc, skip[HYW + c0 + ch], wave, lane);
    __syncthreads();
    LAS bf16* Y = (LAS bf16*)lds;
#pragma unroll
    for (int n = 0; n < 4; ++n)
#pragma unroll
        for (int e = 0; e < 16; ++e) { const int t = 64 * (8 * n + il) + a0 + 8 * (e >> 2) + 4 * hf + (e & 3);
            Y[(b * SEQ + t) * 4 + ch] = (bf16)f2bf(acc[n][e]); }
    __syncthreads();
#pragma unroll 4
    for (int i = 0; i < 16; ++i) { const int it = tid + i * NTHR; const u32x2 v = *(const LAS u32x2*)(lds + it * 8);
        *(u32x2*)(CAT + (size_t)it * D + c0) = v; }
    __syncthreads();
}
}

__device__ __forceinline__ void prep_item(LAS unsigned char* scr, const bf16* P1, const float* cw, const float* cb, bf16* ST, int item, int lane) {
    const int ct = item % 48, tt = (item / 48) & 31, b = item / (48 * 32), t0 = tt * 64, c30 = ct * 64;
#pragma unroll
    for (int i = 0; i < 9; ++i) { const int ci = lane + i * 64; if (ci < 66 * 8) { const int rr = ci >> 3, cc = ci & 7, t = t0 - 1 + rr;
        u32x4 v = (u32x4){0u, 0u, 0u, 0u};
        if (t >= 0 && t < SEQ) v = *(const u32x4*)(P1 + ((size_t)(b * SEQ + t) * IN_CD + c30 + cc * 8));
        *(LAS u32x4*)(scr + rr * 144 + cc * 16) = v; } }
    LDS_WAIT(); asm volatile("" ::: "memory");
    const LAS bf16* tile = (const LAS bf16*)scr;
    for (int c = 0; c < 64; ++c) { const int c3 = c30 + c;
        const float w0 = cw[c3], w1 = cw[HY3 + c3], w2 = cw[2 * HY3 + c3], bb = cb[c3];
        const float v = bb + w0 * bf2f(tile[lane * 72 + c]) + w1 * bf2f(tile[(lane + 1) * 72 + c]) + w2 * bf2f(tile[(lane + 2) * 72 + c]);
        ST[(size_t)(b * HY3 + c3) * SEQ + t0 + lane] = (bf16)f2bf(v); }
    LDS_WAIT(); asm volatile("" ::: "memory");
}

__device__ __forceinline__ void transpose_item(const float* W, int N, bf16* WT, int ldt, int k0, int n0, int drow0, LAS float* scr, int lane) {
    const int r = lane >> 4, c4 = lane & 15;
    f32x4 v[16];
#pragma unroll
    for (int i = 0; i < 16; ++i) v[i] = __builtin_nontemporal_load((const f32x4*)(W + (size_t)(k0 + 4 * i + r) * N + n0 + 4 * c4));
#pragma unroll
    for (int i = 0; i < 16; ++i) { LAS float* d = scr + (4 * i + r) * 65 + 4 * c4; d[0] = v[i][0]; d[1] = v[i][1]; d[2] = v[i][2]; d[3] = v[i][3]; }
    LDS_WAIT(); asm volatile("" ::: "memory");
    const int c = lane & 7;
#pragma unroll
    for (int j = 0; j < 8; ++j) { const int n = (lane >> 3) + 8 * j; const LAS float* s = scr + (8 * c) * 65 + n;
        u32x4 o; o.x = pk2(s[0 * 65], s[1 * 65]); o.y = pk2(s[2 * 65], s[3 * 65]); o.z = pk2(s[4 * 65], s[5 * 65]); o.w = pk2(s[6 * 65], s[7 * 65]);
        __builtin_nontemporal_store(o, (u32x4*)(WT + (size_t)(drow0 + n) * ldt + k0 + 8 * c)); }
    LDS_WAIT(); asm volatile("" ::: "memory");
}
struct Args { const float* in[31]; float* out; unsigned char* ws; int ph_lo, ph_hi; };
enum { I_X = 0, I_C, I_CTX, I_CCTX, I_ADAW, I_ADAB, I_LN1G, I_LN1B, I_LN2G, I_LN2B, I_ROUTER, I_W1, I_W3, I_W2, I_ABIN, I_KVNORM, I_UKV, I_RPB, I_ABOUT,
       I_CDIN, I_CONVW, I_CONVB, I_FW1, I_FB1, I_FF1, I_FW2, I_FB2, I_FF2, I_FW3, I_SKIP, I_CDOUT };
constexpr int NPHASE = 21;
typedef const char __attribute__((address_space(4)))* kptr_t;
__device__ __forceinline__ const float* kin(int i) { kptr_t ka = (kptr_t)__builtin_amdgcn_kernarg_segment_ptr(); int off = i * 8; asm volatile("" : "+s"(off)); return *(const float* const __attribute__((address_space(4)))*)(ka + off); }
__device__ __forceinline__ float* kout() { kptr_t ka = (kptr_t)__builtin_amdgcn_kernarg_segment_ptr(); int off = 31 * 8; asm volatile("" : "+s"(off)); return *(float* const __attribute__((address_space(4)))*)(ka + off); }
__device__ __forceinline__ unsigned char* kws() { kptr_t ka = (kptr_t)__builtin_amdgcn_kernarg_segment_ptr(); int off = 32 * 8; asm volatile("" : "+s"(off)); return *(unsigned char* const __attribute__((address_space(4)))*)(ka + off); }
static_assert(sizeof(Args) == 33 * 8 + 8, "Args layout");

__device__ __forceinline__ void ada_phase(LAS unsigned char* lds, const Args& A, int vcu, int G) {
    const int tid = tid_opaque();
    LAS float* sil = (LAS float*)lds; LAS float* part = sil + 5 * D;
    float* ADA = (float*)(kws() + WS_ADA);
    { const float* C = kin(I_C); const float* CC = kin(I_CCTX);
      for (int i = tid; i < 5 * D; i += NTHR) { const int r = i / D, k = i % D; const float x = r < 4 ? C[r * D + k] : CC[k]; sil[i] = x / (1.f + expf(-x)); } }
    __syncthreads();
    const int kg = tid >> 4, c4 = tid & 15;
    const float* AW = kin(I_ADAW); const float* AB = kin(I_ADAB);
    for (int unit = vcu; unit < 768; unit += G) {
        const int l = unit / 384, rest = unit % 384, col0 = (rest >> 1) * 64, kh = rest & 1;
        f32x4 acc[5];
#pragma unroll
        for (int r = 0; r < 5; ++r) acc[r] = (f32x4){0.f, 0.f, 0.f, 0.f};
        const float* W = AW + (size_t)l * D * (6 * D) + col0 + 4 * c4;
        const int rowb = kh * 1024 + kg * 32;
#pragma unroll 8
        for (int i = 0; i < 32; ++i) { const int row = rowb + i; const f32x4 w = __builtin_nontemporal_load((const f32x4*)(W + (size_t)row * (6 * D)));
#pragma unroll
            for (int r = 0; r < 5; ++r) acc[r] += w * sil[r * D + row]; }
#pragma unroll
        for (int r = 0; r < 5; ++r) *(LAS f32x4*)(part + ((kg * 16 + c4) * 5 + r) * 4) = acc[r];
        __syncthreads();
        if (tid < 320) { const int r = tid >> 6, col = tid & 63; float s = kh == 0 ? AB[l * 6 * D + col0 + col] : 0.f;
            for (int g = 0; g < 32; ++g) s += part[((g * 16 + (col >> 2)) * 5 + r) * 4 + (col & 3)];
            atomicAdd(ADA + (size_t)(l * 5 + r) * (6 * D) + col0 + col, s); }
        __syncthreads();
    }
}
__device__ __forceinline__ void filt_phase(LAS unsigned char* lds, const Args& A, int vcu, int G) {
    const int tid = tid_opaque(), wave = __builtin_amdgcn_readfirstlane(tid >> 6), lane = tid & 63, l32 = lane & 31, hf = lane >> 5;
    LAS float* zf = (LAS float*)lds;
    LAS float* h1 = zf + 64 * 33;
    LAS float* w1s = h1 + 64 * 65;
    LAS float* w2s = w1s + 33 * 64;
    LAS bf16* h2b = (LAS bf16*)(w2s + 64 * 64);
    LAS bf16* w3t = h2b + 64 * 72 + wave * (64 * 72);
    bf16* HRg = (bf16*)(kws() + WS_HR);
    const float* fw1 = kin(I_FW1); const float* fb1 = kin(I_FB1); const float* ff1 = kin(I_FF1);
    const float* fw2 = kin(I_FW2); const float* fb2 = kin(I_FB2); const float* ff2 = kin(I_FF2); const float* fw3 = kin(I_FW3);
    for (int i = tid; i < 33 * 64; i += NTHR) w1s[i] = fw1[i];
    for (int i = tid; i < 64 * 64; i += NTHR) w2s[i] = fw2[i];
    for (int unit = vcu; unit < 256; unit += G) {
        const int lb = unit >> 3, cbk = unit & 7, l = lb * 64 + lane;
        const float t01 = (float)l / 2047.f, w = 6.283185307179586f * (float)l / 2048.f;
        for (int f = wave; f < 33; f += 8) { float v;
            if (f == 0) v = t01; else { const int j = (f - 1) & 15; const float band = 1e-4f + (float)j * ((15.f - 1e-4f) / 15.f); v = f <= 16 ? cosf(w * band) : -sinf(w * band); }
            zf[lane * 33 + f] = v; }
        const int col0 = cbk * 512 + wave * 64;
        { const f32x4* src = (const f32x4*)(fw3 + (size_t)lane * 4096 + col0);
#pragma unroll 4
          for (int c4 = 0; c4 < 16; ++c4) { const f32x4 v = src[c4];
#pragma unroll
              for (int k = 0; k < 4; ++k) w3t[(4 * c4 + k) * 72 + lane] = (bf16)f2bf(v[k]); } }
        __syncthreads();
        { f32x4 a0 = *(const f32x4*)(fb1 + wave * 8), a1 = *(const f32x4*)(fb1 + wave * 8 + 4);
#pragma unroll 3
          for (int f = 0; f < 33; ++f) { const float z = zf[lane * 33 + f]; a0 += *(const LAS f32x4*)(w1s + f * 64 + wave * 8) * z; a1 += *(const LAS f32x4*)(w1s + f * 64 + wave * 8 + 4) * z; }
          const f32x4 q0 = *(const f32x4*)(ff1 + wave * 8), q1 = *(const f32x4*)(ff1 + wave * 8 + 4);
#pragma unroll
          for (int i = 0; i < 4; ++i) { h1[lane * 65 + wave * 8 + i] = sinf(q0[i] * a0[i]); h1[lane * 65 + wave * 8 + 4 + i] = sinf(q1[i] * a1[i]); } }
        __syncthreads();
        { f32x4 a0 = *(const f32x4*)(fb2 + wave * 8), a1 = *(const f32x4*)(fb2 + wave * 8 + 4);
#pragma unroll 4
          for (int f = 0; f < 64; ++f) { const float z = h1[lane * 65 + f]; a0 += *(const LAS f32x4*)(w2s + f * 64 + wave * 8) * z; a1 += *(const LAS f32x4*)(w2s + f * 64 + wave * 8 + 4) * z; }
          const f32x4 q0 = *(const f32x4*)(ff2 + wave * 8), q1 = *(const f32x4*)(ff2 + wave * 8 + 4);
          u32x4 hw; hw.x = cvtpk(sinf(q0[0] * a0[0]), sinf(q0[1] * a0[1])); hw.y = cvtpk(sinf(q0[2] * a0[2]), sinf(q0[3] * a0[3]));
          hw.z = cvtpk(sinf(q1[0] * a1[0]), sinf(q1[1] * a1[1])); hw.w = cvtpk(sinf(q1[2] * a1[2]), sinf(q1[3] * a1[3]));
          *(LAS u32x4*)(h2b + lane * 72 + wave * 8) = hw; }
        __syncthreads();
        f32x16 acc[2][2];
#pragma unroll
        for (int x = 0; x < 2; ++x)
#pragma unroll
            for (int y = 0; y < 2; ++y)
#pragma unroll
                for (int i = 0; i < 16; ++i) acc[x][y][i] = 0.f;
#pragma unroll
        for (int ks = 0; ks < 4; ++ks) { bf16x8 af[2], bfr[2];
#pragma unroll
            for (int x = 0; x < 2; ++x) { af[x] = *(const LAS bf16x8*)(h2b + (32 * x + l32) * 72 + 16 * ks + 8 * hf); bfr[x] = *(const LAS bf16x8*)(w3t + (32 * x + l32) * 72 + 16 * ks + 8 * hf); }
#pragma unroll
            for (int x = 0; x < 2; ++x)
#pragma unroll
                for (int y = 0; y < 2; ++y) acc[x][y] = __builtin_amdgcn_mfma_f32_32x32x16_bf16(af[x], bfr[y], acc[x][y], 0, 0, 0); }
        LDS_WAIT(); asm volatile("" ::: "memory");
        const int o = col0 >> 11, dir = (col0 >> 10) & 1, cbase = col0 & 1023;
#pragma unroll
        for (int y = 0; y < 2; ++y) { const int c = cbase + 32 * y + l32;
            const float delta = fabsf(-3.0701134573253946f + (float)c * ((-15.350567286626973f + 3.0701134573253946f) / 1023.f));
#pragma unroll
            for (int x = 0; x < 2; ++x)
#pragma unroll
                for (int g = 0; g < 4; ++g) { const int ll = 32 * x + 8 * g + 4 * hf; float v[4];
#pragma unroll
                    for (int e = 0; e < 4; ++e) v[e] = acc[x][y][4 * g + e] * expf(-((float)(lb * 64 + ll + e) / 2047.f) * delta);
                    u32x2 pw; pw.x = cvtpk(v[0], v[1]); pw.y = cvtpk(v[2], v[3]);
                    *(LAS u32x2*)(w3t + (32 * y + l32) * 72 + ll) = pw; } }
        LDS_WAIT(); asm volatile("" ::: "memory");
        for (int cc = 0; cc < 64; ++cc) { const bf16 val = w3t[cc * 72 + lane]; bf16* row = HRg + (size_t)(o * HYW + cbase + cc) * 4096;
            if (dir == 0) row[2048 - l] = val; else row[l == 0 ? 0 : 2048 + l] = l == 0 ? (bf16)0 : val; }
        __syncthreads();
    }
}
__device__ __forceinline__ void convert_phase(LAS unsigned char* lds, const Args& A, int vcu, int G) {
    const int tid = tid_opaque(), wave = __builtin_amdgcn_readfirstlane(tid >> 6), lane = tid & 63;
    LAS float* scr = (LAS float*)(lds + wave * 16640);
    const int gw = vcu * NWAVES + wave, NGW = G * NWAVES;
    unsigned char* ws = kws();
    constexpr int N0 = 32 * 81, N1 = 8 * 32, N2 = 32 * 32, N3 = 32 * 64, N4 = 32 * 32;
    constexpr int NIT = N0 + N1 + N2 + N3 + N4;
    for (int it = gw; it < NIT; it += NGW) {
        int r = it;
        if (r < N0) { transpose_item(kin(I_ABIN), IN_AB, (bf16*)(ws + WS_WAB), D, (r / 81) * 64, (r % 81) * 64, (r % 81) * 64, scr, lane); continue; } r -= N0;
        if (r < N1) { transpose_item(kin(I_UKV), D, (bf16*)(ws + WS_WUKV), KVR, (r / 32) * 64, (r % 32) * 64, (r % 32) * 64, scr, lane); continue; } r -= N1;
        if (r < N2) { transpose_item(kin(I_ABOUT), D, (bf16*)(ws + WS_WABO), D, (r / 32) * 64, (r % 32) * 64, (r % 32) * 64, scr, lane); continue; } r -= N2;
        if (r < N3) { transpose_item(kin(I_CDIN), IN_CD, (bf16*)(ws + WS_WCD), D, (r / 64) * 64, (r % 64) * 64, (r % 64) * 64, scr, lane); continue; } r -= N3;
        transpose_item(kin(I_CDOUT), D, (bf16*)(ws + WS_WCDO), D, (r / 32) * 64, (r % 32) * 64, (r % 32) * 64, scr, lane);
    }
    const size_t gt = (size_t)vcu * NTHR + tid, NGT = (size_t)G * NTHR;
    { u32x4* z = (u32x4*)(ws + WS_WAB + (size_t)IN_AB * D * 2); for (size_t i = gt; i < (size_t)(IN_AB_PAD - IN_AB) * D * 2 / 16; i += NGT) z[i] = (u32x4){0u, 0u, 0u, 0u}; }
    { unsigned* cs = (unsigned*)(ws + WS_CS256);
      for (size_t i = gt; i < 512 * 128; i += NGT) { const int row = (int)(i >> 7), n = (int)(i & 127) * 2, k2 = row & 255; const bool sn = row >= 256;
          const float a0 = (float)((k2 * n) & 255) * (1.f / 128.f), a1 = (float)((k2 * (n + 1)) & 255) * (1.f / 128.f);
          cs[i] = pk2((sn ? sinpif(a0) : cospif(a0)) * 0.0625f, (sn ? sinpif(a1) : cospif(a1)) * 0.0625f); } }
    { unsigned* cl = (unsigned*)(ws + WS_CSL);
      const float nrm = 0.022097086912079608f;
      for (size_t i = gt; i < (size_t)2048 * 1024; i += NGT) { const int k1 = (int)(i >> 10), j = (int)(i & 1023) * 2; float v[2];
#pragma unroll
          for (int q = 0; q < 2; ++q) { const int jj = j + q; const bool sn = jj > 1024; const int t = sn ? jj - 1024 : jj; const float a = (float)((k1 * t) & 2047) * (1.f / 1024.f); v[q] = (sn ? -sinpif(a) : cospif(a)) * nrm; }
          cl[i] = pk2(v[0], v[1]); } }
}
__device__ __forceinline__ void mod_row(const float* xrow, const float* shift, const float* scale, bf16* orow, int lane) {
#pragma unroll
    for (int j = 0; j < 8; ++j) { const int c = 4 * lane + 256 * j; const f32x4 x = *(const f32x4*)(xrow + c), sh = *(const f32x4*)(shift + c), sc = *(const f32x4*)(scale + c);
        const f32x4 u = x * (sc + 1.f) + sh; u32x2 w; w.x = pk2(u[0], u[1]); w.y = pk2(u[2], u[3]); *(u32x2*)(orow + c) = w; }
}
__device__ __forceinline__ void modulate_phase(const Args& A, int vcu, int G) {
    const int tid = tid_opaque(), lane = tid & 63, gw = vcu * NWAVES + __builtin_amdgcn_readfirstlane(tid >> 6), NGW = G * NWAVES;
    const float* ADA = (const float*)(kws() + WS_ADA); bf16* U = (bf16*)(kws() + WS_UALL); const float* X = kin(I_X); const float* CT = kin(I_CTX);
    for (int row = gw; row < MALL; row += NGW) {
        if (row < MLAT) { const int b = row >> 11; mod_row(X + (size_t)row * D, ADA + (size_t)b * 6 * D, ADA + (size_t)b * 6 * D + D, U + (size_t)row * D, lane); }
        else mod_row(CT + (size_t)(row - MLAT) * D, ADA + (size_t)4 * 6 * D, ADA + (size_t)4 * 6 * D + D, U + (size_t)row * D, lane);
    }
}
__device__ __forceinline__ void postproj_phase(const Args& A, int vcu, int G) {
    const int tid = tid_opaque(), lane = tid & 63, gw = vcu * NWAVES + __builtin_amdgcn_readfirstlane(tid >> 6), NGW = G * NWAVES;
    bf16* P = (bf16*)(kws() + WS_P); bf16* CK = (bf16*)(kws() + WS_CKVN); bf16* KPE = (bf16*)(kws() + WS_KPE); const float* kvn = kin(I_KVNORM);
    const int fi = lane & 31;
    const float inv = exp2f(-(float)(fi & 15) * (13.287712379549449f / 16.f));
    for (int row = gw; row < MALL; row += NGW) {
        bf16* pr = P + (size_t)row * IN_AB_PAD;
        { const u32x4 w = *(const u32x4*)(pr + OFF_CKV + 8 * lane); float x[8] = {bflo(w.x), bfhi(w.x), bflo(w.y), bfhi(w.y), bflo(w.z), bfhi(w.z), bflo(w.w), bfhi(w.w)};
          float ss = 0.f;
#pragma unroll
          for (int i = 0; i < 8; ++i) ss += x[i] * x[i];
          const float rstd = 1.f / sqrtf(wave_sum(ss) * (1.f / KVR) + LN_EPS);
          const f32x4 g0 = *(const f32x4*)(kvn + 8 * lane), g1 = *(const f32x4*)(kvn + 8 * lane + 4);
          u32x4 o; o.x = pk2(x[0] * rstd * g0[0], x[1] * rstd * g0[1]); o.y = pk2(x[2] * rstd * g0[2], x[3] * rstd * g0[3]);
          o.z = pk2(x[4] * rstd * g1[0], x[5] * rstd * g1[1]); o.w = pk2(x[6] * rstd * g1[2], x[7] * rstd * g1[3]);
          *(u32x4*)(CK + (size_t)row * KVR + 8 * lane) = o; }
        if (row < MLAT) {
            const int t = row & 2047; const float pos = (float)(fi < 16 ? (t >> 6) : (t & 63)); float sn, cs; sincosf(pos * inv, &sn, &cs);
            if (lane < 32) { const float t1 = bf2f(pr[OFF_KPE + fi]), t2 = bf2f(pr[OFF_KPE + 32 + fi]);
                KPE[(size_t)row * 64 + fi] = (bf16)f2bf(t1 * cs - t2 * sn); KPE[(size_t)row * 64 + 32 + fi] = (bf16)f2bf(t2 * cs + t1 * sn); }
#pragma unroll
            for (int q = 0; q < 4; ++q) { const int h = 2 * q + (lane >> 5); bf16* qp = pr + h * 192 + 128;
                const float t1 = bf2f(qp[fi]), t2 = bf2f(qp[32 + fi]); qp[fi] = (bf16)f2bf(t1 * cs - t2 * sn); qp[32 + fi] = (bf16)f2bf(t2 * cs + t1 * sn); }
        } else KPE[(size_t)row * 64 + lane] = pr[OFF_KPE + lane];
    }
}
__device__ __forceinline__ void ln1_phase(LAS unsigned char* lds, int l, int vcu, int G) {
    const int tid = tid_opaque(), lane = tid & 63, gw = vcu * NWAVES + __builtin_amdgcn_readfirstlane(tid >> 6), NGW = G * NWAVES;
    LAS float* rt = (LAS float*)lds;
    unsigned char* ws = kws();
    { const float* router = kin(I_ROUTER) + (size_t)l * D * NE;
      for (int i = tid; i < 4 * D; i += NTHR) { const int c = i & (D - 1), q = i >> 11; const f32x4 v = *(const f32x4*)(router + (size_t)c * NE + 4 * q);
          rt[(4 * q + 0) * D + c] = v[0]; rt[(4 * q + 1) * D + c] = v[1]; rt[(4 * q + 2) * D + c] = v[2]; rt[(4 * q + 3) * D + c] = v[3]; } }
    __syncthreads();
    const bf16* PRE = (const bf16*)(ws + WS_PRE); bf16* H1 = (bf16*)(ws + WS_H1); bf16* U2 = (bf16*)(ws + WS_U2); float* AFF = (float*)(ws + WS_AFF);
    const float* g = kin(I_LN1G) + l * D; const float* bb = kin(I_LN1B) + l * D; const float* ADA = (const float*)(ws + WS_ADA) + (size_t)l * 5 * 6 * D;
    u32x2 pw[2][8];
    if (gw < MLAT / 2) {
#pragma unroll
        for (int rr = 0; rr < 2; ++rr)
#pragma unroll
            for (int j = 0; j < 8; ++j) pw[rr][j] = *(const u32x2*)(PRE + (size_t)(gw * 2 + rr) * D + 4 * lane + 256 * j); }
    for (int rp = gw; rp < MLAT / 2; rp += NGW) {
        const int row0 = rp * 2, b = row0 >> 11;
        const float* ada = ADA + (size_t)b * 6 * D;
        f32x4 v[2][8];
#pragma unroll
        for (int rr = 0; rr < 2; ++rr)
#pragma unroll
            for (int j = 0; j < 8; ++j) v[rr][j] = (f32x4){bflo(pw[rr][j].x), bfhi(pw[rr][j].x), bflo(pw[rr][j].y), bfhi(pw[rr][j].y)};
        if (rp + NGW < MLAT / 2) {
#pragma unroll
            for (int rr = 0; rr < 2; ++rr)
#pragma unroll
                for (int j = 0; j < 8; ++j) pw[rr][j] = *(const u32x2*)(PRE + (size_t)((rp + NGW) * 2 + rr) * D + 4 * lane + 256 * j); }
#pragma unroll
        for (int rr = 0; rr < 2; ++rr) { float s = 0.f;
#pragma unroll
            for (int j = 0; j < 8; ++j) s += (v[rr][j][0] + v[rr][j][1]) + (v[rr][j][2] + v[rr][j][3]);
            const float mean = wave_sum(s) * (1.f / D); float q = 0.f;
#pragma unroll
            for (int j = 0; j < 8; ++j) { v[rr][j] = v[rr][j] - mean; q += (v[rr][j][0] * v[rr][j][0] + v[rr][j][1] * v[rr][j][1]) + (v[rr][j][2] * v[rr][j][2] + v[rr][j][3] * v[rr][j][3]); }
            const float rstd = 1.f / sqrtf(wave_sum(q) * (1.f / D) + LN_EPS);
#pragma unroll
            for (int j = 0; j < 8; ++j) { const int c = 4 * lane + 256 * j;
                const f32x4 hv = v[rr][j] * rstd * *(const f32x4*)(g + c) + *(const f32x4*)(bb + c);
                { u32x2 hw; hw.x = pk2(hv[0], hv[1]); hw.y = pk2(hv[2], hv[3]); *(u32x2*)(H1 + (size_t)(row0 + rr) * D + c) = hw; }
                const f32x4 u = hv * (*(const f32x4*)(ada + 4 * D + c) + 1.f) + *(const f32x4*)(ada + 3 * D + c);
                u32x2 w; w.x = pk2(u[0], u[1]); w.y = pk2(u[2], u[3]); *(u32x2*)(U2 + (size_t)(row0 + rr) * D + c) = w;
                v[rr][j] = u; } }
        float a[32];
#pragma unroll
        for (int e = 0; e < NE; ++e) { float a0 = 0.f, a1 = 0.f;
#pragma unroll
            for (int j = 0; j < 8; ++j) { const f32x4 r4 = *(const LAS f32x4*)(rt + e * D + 4 * lane + 256 * j);
                a0 += (v[0][j][0] * r4[0] + v[0][j][1] * r4[1]) + (v[0][j][2] * r4[2] + v[0][j][3] * r4[3]);
                a1 += (v[1][j][0] * r4[0] + v[1][j][1] * r4[1]) + (v[1][j][2] * r4[2] + v[1][j][3] * r4[3]); }
            a[e] = a0; a[16 + e] = a1; __builtin_amdgcn_sched_barrier(0); }
#pragma unroll
        for (int i = 0; i < 16; ++i) { const bool up = (lane & 32) != 0; const float snd = up ? a[i] : a[i + 16], kp = up ? a[i + 16] : a[i]; a[i] = kp + __shfl_xor(snd, 32); }
#pragma unroll
        for (int i = 0; i < 8; ++i) { const bool up = (lane & 16) != 0; const float snd = up ? a[i] : a[i + 8], kp = up ? a[i + 8] : a[i]; a[i] = kp + __shfl_xor(snd, 16); }
#pragma unroll
        for (int i = 0; i < 4; ++i) { const bool up = (lane & 8) != 0; const float snd = up ? a[i] : a[i + 4], kp = up ? a[i + 4] : a[i]; a[i] = kp + __shfl_xor(snd, 8); }
#pragma unroll
        for (int i = 0; i < 2; ++i) { const bool up = (lane & 4) != 0; const float snd = up ? a[i] : a[i + 2], kp = up ? a[i + 2] : a[i]; a[i] = kp + __shfl_xor(snd, 4); }
        { const bool up = (lane & 2) != 0; const float snd = up ? a[0] : a[1], kp = up ? a[1] : a[0]; a[0] = kp + __shfl_xor(snd, 2); }
        float lg = a[0] + __shfl_xor(a[0], 1);
        float mx = lg;
#pragma unroll
        for (int o = 2; o < 32; o <<= 1) mx = fmaxf(mx, __shfl_xor(mx, o));
        const float ex = expf(lg - mx); float den = ex;
#pragma unroll
        for (int o = 2; o < 32; o <<= 1) den += __shfl_xor(den, o);
        if ((lane & 1) == 0) { const int rr = lane >> 5, e = (lane >> 1) & 15, t = (row0 + rr) & 2047; AFF[(size_t)(b * NE + e) * SEQ + t] = ex / den; }
    }
}
__device__ __forceinline__ void topk_phase(LAS unsigned char* lds, const Args& A, int u0, int ustride) {
    const int tid = tid_opaque(), wave = __builtin_amdgcn_readfirstlane(tid >> 6), lane = tid & 63;
    LAS unsigned* hist = (LAS unsigned*)lds;
    LAS unsigned* ctl = hist + 512;
    LAS unsigned* wt = ctl + 8;
    const float* AFF = (const float*)(kws() + WS_AFF); int* IDX = (int*)(kws() + WS_IDX); float* GATE = (float*)(kws() + WS_GATE); int* INV = (int*)(kws() + WS_INV);
    for (int unit = u0; unit < NRT; unit += ustride) {
        const int e = unit >> 2, b = unit & 3;
        unsigned long long key[4]; float val[4];
#pragma unroll
        for (int q = 0; q < 4; ++q) { val[q] = AFF[(size_t)(b * NE + e) * SEQ + tid + 512 * q];
            key[q] = ((unsigned long long)__builtin_bit_cast(unsigned, val[q]) << 11) | (unsigned)(2047 - (tid + 512 * q)); }
        hist[tid] = 0u;
        unsigned long long prefix = 0ull; unsigned need = CAP;
        __syncthreads();
#pragma unroll 1
        for (int pass = 0; pass < 6; ++pass) { const int shift = 40 - 8 * pass; LAS unsigned* h = hist + (pass & 1) * 256;
#pragma unroll
            for (int q = 0; q < 4; ++q) if ((key[q] >> (shift + 8)) == prefix) (void)__hip_atomic_fetch_add(h + (unsigned)((key[q] >> shift) & 255ull), 1u, __ATOMIC_RELAXED, __HIP_MEMORY_SCOPE_WORKGROUP);
            __syncthreads();
            if (wave == 0) { const u32x4 c = *(const LAS u32x4*)(h + 4 * lane); const unsigned mine = (c.x + c.y) + (c.z + c.w);
                unsigned suf = mine;
#pragma unroll
                for (int o = 1; o < 64; o <<= 1) { const unsigned t = __shfl_down(suf, o); if (lane + o < 64) suf += t; }
                const unsigned above = suf - mine;
                const unsigned a3 = above, a2 = a3 + c.w, a1 = a2 + c.z, a0 = a1 + c.y;
                if (a3 < need && need <= a3 + c.w) { ctl[0] = 4 * lane + 3; ctl[1] = need - a3; }
                else if (a2 < need && need <= a2 + c.z) { ctl[0] = 4 * lane + 2; ctl[1] = need - a2; }
                else if (a1 < need && need <= a1 + c.y) { ctl[0] = 4 * lane + 1; ctl[1] = need - a1; }
                else if (a0 < need && need <= a0 + c.x) { ctl[0] = 4 * lane; ctl[1] = need - a0; }
                *(LAS u32x4*)(hist + ((pass & 1) ^ 1) * 256 + 4 * lane) = (u32x4){0u, 0u, 0u, 0u}; }
            __syncthreads();
            prefix = (prefix << 8) | (unsigned long long)ctl[0]; need = ctl[1];
        }
        unsigned cnt[4];
#pragma unroll
        for (int q = 0; q < 4; ++q) { const bool sel = key[q] >= prefix; const unsigned long long m = __builtin_amdgcn_ballot_w64(sel);
            cnt[q] = (unsigned)__builtin_popcountll(m & ((1ull << lane) - 1ull)); if (lane == 0) wt[q * 8 + wave] = (unsigned)__builtin_popcountll(m); }
        __syncthreads();
        unsigned base = 0u;
#pragma unroll
        for (int q = 0; q < 4; ++q) { unsigned before = 0u, tot = 0u;
#pragma unroll
            for (int w = 0; w < 8; ++w) { const unsigned x = wt[q * 8 + w]; tot += x; if (w < wave) before += x; }
            const bool sel = key[q] >= prefix; const int idx = tid + 512 * q; const int slot = (int)(base + before + cnt[q]);
            INV[(size_t)(b * SEQ + idx) * NE + e] = sel ? slot : -1;
            if (sel) { IDX[unit * CAP + slot] = idx; GATE[unit * CAP + slot] = val[q]; }
            base += tot; }
        __syncthreads();
    }
}
struct Ln2Pre { u32x2 h[8], y0[8], y1[8]; unsigned rest; float f0, f1; };
__device__ __forceinline__ void ln2_fetch(Ln2Pre& P, const bf16* H1, const bf16* YE, int row, int inv, int lane) {
    const int b = row >> 11;
    unsigned mask = (unsigned)__builtin_amdgcn_ballot_w64(inv >= 0) & 0xffffu;
    const bool any = mask != 0u; const int e0 = any ? __builtin_ctz(mask) : 0; mask &= mask - 1u;
    const bool two = mask != 0u; const int e1 = two ? __builtin_ctz(mask) : e0; if (two) mask &= mask - 1u;
    P.rest = mask; P.f0 = any ? 1.f : 0.f; P.f1 = two ? 1.f : 0.f;
    const int s0 = any ? __builtin_amdgcn_readlane(inv, e0) : 0, s1 = two ? __builtin_amdgcn_readlane(inv, e1) : s0;
    const bf16* y0 = YE + (size_t)((e0 * 4 + b) * CAP + s0) * D + 4 * lane; const bf16* y1 = YE + (size_t)((e1 * 4 + b) * CAP + s1) * D + 4 * lane;
#pragma unroll
    for (int j = 0; j < 8; ++j) { P.h[j] = *(const u32x2*)(H1 + (size_t)row * D + 4 * lane + 256 * j); P.y0[j] = *(const u32x2*)(y0 + 256 * j); P.y1[j] = *(const u32x2*)(y1 + 256 * j); }
}
__device__ __forceinline__ void ln2_phase(int l, int vcu, int G) {
    const int tid = tid_opaque(), lane = tid & 63, gw = vcu * NWAVES + __builtin_amdgcn_readfirstlane(tid >> 6), NGW = G * NWAVES;
    unsigned char* ws = kws();
    const bf16* H1 = (const bf16*)(ws + WS_H1); const bf16* YE = (const bf16*)(ws + WS_YE); const int* INV = (const int*)(ws + WS_INV);
    float* out = kout(); bf16* H2 = (bf16*)(ws + WS_H2); bf16* U = (bf16*)(ws + WS_UALL);
    const float* g = kin(I_LN2G) + l * D; const float* bb = kin(I_LN2B) + l * D; const float* ADA = (const float*)(ws + WS_ADA);
    if (gw >= MLAT) return;
    int inv_c = lane < NE ? INV[(size_t)gw * NE + lane] : -1;
    int inv_n = (gw + NGW < MLAT && lane < NE) ? INV[(size_t)(gw + NGW) * NE + lane] : -1;
    Ln2Pre cur; ln2_fetch(cur, H1, YE, gw, inv_c, lane);
    for (int row = gw; row < MLAT; row += NGW) {
        const int b = row >> 11; const int inv = inv_c; const bool has_n = row + NGW < MLAT;
        int inv_nn = -1; if (row + 2 * NGW < MLAT && lane < NE) inv_nn = INV[(size_t)(row + 2 * NGW) * NE + lane];
        Ln2Pre nxt; if (has_n) ln2_fetch(nxt, H1, YE, row + NGW, inv_n, lane); else nxt = cur;
        const float* ada = ADA + (size_t)(l * 5 + b) * 6 * D;
        f32x4 v[8], m[8];
#pragma unroll
        for (int j = 0; j < 8; ++j) { v[j] = (f32x4){bflo(cur.h[j].x), bfhi(cur.h[j].x), bflo(cur.h[j].y), bfhi(cur.h[j].y)};
            m[j][0] = cur.f0 * bflo(cur.y0[j].x) + cur.f1 * bflo(cur.y1[j].x); m[j][1] = cur.f0 * bfhi(cur.y0[j].x) + cur.f1 * bfhi(cur.y1[j].x);
            m[j][2] = cur.f0 * bflo(cur.y0[j].y) + cur.f1 * bflo(cur.y1[j].y); m[j][3] = cur.f0 * bfhi(cur.y0[j].y) + cur.f1 * bfhi(cur.y1[j].y); }
        unsigned mask = cur.rest;
        while (mask) {
            const int e0 = __builtin_ctz(mask); mask &= mask - 1u; const int s0 = __builtin_amdgcn_readlane(inv, e0);
            const bf16* y0 = YE + (size_t)((e0 * 4 + b) * CAP + s0) * D + 4 * lane;
            u32x2 w0[8];
#pragma unroll
            for (int j = 0; j < 8; ++j) w0[j] = *(const u32x2*)(y0 + 256 * j);
#pragma unroll
            for (int j = 0; j < 8; ++j) { m[j][0] += bflo(w0[j].x); m[j][1] += bfhi(w0[j].x); m[j][2] += bflo(w0[j].y); m[j][3] += bfhi(w0[j].y); }
        }
        float s = 0.f;
#pragma unroll
        for (int j = 0; j < 8; ++j) { const int c = 4 * lane + 256 * j; v[j] = v[j] * DN_ALPHA + *(const f32x4*)(ada + 5 * D + c) * m[j]; s += (v[j][0] + v[j][1]) + (v[j][2] + v[j][3]); }
        const float mean = wave_sum(s) * (1.f / D); float q = 0.f;
#pragma unroll
        for (int j = 0; j < 8; ++j) { v[j] = v[j] - mean; q += (v[j][0] * v[j][0] + v[j][1] * v[j][1]) + (v[j][2] * v[j][2] + v[j][3] * v[j][3]); }
        const float rstd = 1.f / sqrtf(wave_sum(q) * (1.f / D) + LN_EPS);
        const float* ada1 = ADA + (size_t)(5 + b) * 6 * D;
#pragma unroll
        for (int j = 0; j < 8; ++j) { const int c = 4 * lane + 256 * j;
            const f32x4 hv = v[j] * rstd * *(const f32x4*)(g + c) + *(const f32x4*)(bb + c);
            if (l == 0) { u32x2 hw; hw.x = pk2(hv[0], hv[1]); hw.y = pk2(hv[2], hv[3]); *(u32x2*)(H2 + (size_t)row * D + c) = hw;
                const f32x4 u = hv * (*(const f32x4*)(ada1 + D + c) + 1.f) + *(const f32x4*)(ada1 + c); u32x2 w; w.x = pk2(u[0], u[1]); w.y = pk2(u[2], u[3]); *(u32x2*)(U + (size_t)row * D + c) = w; }
            else *(f32x4*)(out + (size_t)row * D + c) = hv; }
        cur = nxt; inv_c = inv_n; inv_n = inv_nn;
    }
}

constexpr int CW_QHEAD = 64, CW_DONE0 = 256;
constexpr int XW_L = 3 * 16 * 704;
constexpr unsigned XT_L = XW_L / 8, XT_ALL = 2 * XT_L;
__device__ __forceinline__ void expert_item(int w, LAS float* scr, int lane) {
    const int l = w / XW_L, r = w % XW_L, kind = r / 11264, q = r % 11264, e = q / 704, qq = q % 704, le = l * 16 + e;
    unsigned char* ws = kws();
    const int tq = qq >> 3, sub = qq & 7;
    if (kind < 2) { const int kb = (tq / 11) * 4 + (sub >> 1), nb = (tq % 11) * 2 + (sub & 1), f0 = nb * 64;
        transpose_item(kin(kind == 0 ? I_W1 : I_W3) + (size_t)le * D * FF, FF, (bf16*)(ws + WS_W13) + (size_t)le * (2 * FF * D), D, kb * 64, f0, (f0 >> 7) * 256 + kind * 128 + (f0 & 127), scr, lane); }
    else { const int kb = (tq >> 3) * 2 + (sub & 1), nb = (tq & 7) * 4 + (sub >> 1);
        transpose_item(kin(I_W2) + (size_t)le * FF * D, D, (bf16*)(ws + WS_W2) + (size_t)le * (D * FF), FF, kb * 64, nb * 64, nb * 64, scr, lane); }
}
__device__ __forceinline__ void steal(LAS unsigned char* lds, volatile LAS unsigned* MISC, int k, unsigned must, int G, int early = 0) {
    const int tid = tid_opaque(), wave = __builtin_amdgcn_readfirstlane(tid >> 6), lane = tid & 63;
    unsigned* ctl = (unsigned*)(kws() + WS_CTL);
    __syncthreads();
    if (tid == 0) (void)xb_add(ctl + CW_DONE0 + 64 * k, 1u);
    for (;;) {
        if (tid == 0) { unsigned it = 0xffffffffu;
            const unsigned d = xb_ld(ctl + CW_DONE0 + 64 * k), h = xb_ld(ctl + CW_QHEAD);
            if (h < XT_ALL && (d + (unsigned)early < (unsigned)G || h < must)) { it = xb_add(ctl + CW_QHEAD, 1u); if (it >= XT_ALL) it = 0xffffffffu; }
            MISC[4] = it; }
        __syncthreads();
        const unsigned it = MISC[4];
        __syncthreads();
        if (it == 0xffffffffu) break;
        expert_item((int)it * 8 + wave, (LAS float*)(lds + wave * 16640), lane);
    }
}

__global__ void __launch_bounds__(NTHR, 2) mk_fwd(Args A) {
    extern __shared__ __attribute__((aligned(16))) unsigned char lds_raw[];
    LAS unsigned char* lds = (LAS unsigned char*)lds_raw;
    volatile LAS unsigned* MISC = (volatile LAS unsigned*)(lds + LDS_MISC);
    const int G = gridDim.x; const int bx = blockIdx.x; const int vcu = (G % 8 == 0) ? (bx % 8) * (G / 8) + bx / 8 : bx;
    if (threadIdx.x < 16) MISC[threadIdx.x] = 0u;
    __syncthreads();
#if MK_LAUNCH_PER_PHASE
#define GRID_BAR() do { } while (0)
#else
    XcdBarrier bar = xcd_barrier_post((unsigned*)(kws() + WS_CTL) + 4096, MISC + 8);
#define GRID_BAR() xcd_barrier(bar)
#endif
    const int lo = A.ph_lo, hi = A.ph_hi;
#ifndef PH_MASK
#define PH_MASK 0xFFFFFFFFu
#endif
#define IN(k) ((((PH_MASK) >> (k)) & 1u) && lo <= (k) && (k) < hi)
#ifndef PROBE_SA
#define PROBE_SA -1
#define PROBE_SB -1
#endif
#ifndef PROBE_SCALE
#define PROBE_SCALE 4
#endif
#define STAMP(i) do { if (PROBE_SA >= 0 && blockIdx.x == 0 && threadIdx.x == 0) ((volatile LAS unsigned*)(lds + LDS_STAMP))[(i)] = (unsigned)__builtin_amdgcn_s_memrealtime(); } while (0)
#define SEAM(k) do { if ((k) + 1 < hi) GRID_BAR(); STAMP((k) + 1); } while (0)
    STAMP(0);
#ifndef PROBE_DUP
#define PROBE_DUP 0u
#endif
#define REP(k) for (int rep_ = 0; rep_ < (int)(((PROBE_DUP) >> (k)) & 1u) + 1; ++rep_)

    #ifndef PX_PARTS
#define PX_PARTS 3
#endif
#ifndef P0_PARTS
#define P0_PARTS 7
#endif
    if (IN(0)) REP(0) { if (P0_PARTS & 1) ada_phase(lds, A, vcu, G); if (P0_PARTS & 2) filt_phase(lds, A, vcu, G); if (P0_PARTS & 4) convert_phase(lds, A, vcu, G); SEAM(0); }

    {

            if (IN(1)) REP(1) { modulate_phase(A, vcu, G); SEAM(1); }
            if (IN(2)) REP(2) { ProbInAB P{2048, 2048, 2048, 720, (const bf16*)(kws() + WS_UALL), (const bf16*)(kws() + WS_WAB), (bf16*)(kws() + WS_P)};
                if (G == 256) { if ((vcu & 31) < 30) pg8::gemm_phase(lds, P, (vcu >> 5) * 30 + (vcu & 31), 240); } else pg8::gemm_phase(lds, P, vcu, G);
                steal(lds, MISC, 2, 0u, G); SEAM(2); }
            if (IN(3)) REP(3) { postproj_phase(A, vcu, G); SEAM(3); }
            if (IN(4)) REP(4) { ProbPlain P{512, 512, 512, 36 * 8, (const bf16*)(kws() + WS_CKVN), (const bf16*)(kws() + WS_WUKV), (bf16*)(kws() + WS_KV), D, 36, 8};
                if (G == 256) { if ((vcu & 31) < 18) pg8::gemm_phase(lds, P, (vcu >> 5) * 18 + (vcu & 31), 144); }
                else pg8::gemm_phase(lds, P, vcu, G);
                steal(lds, MISC, 4, 0u, G); SEAM(4); }
            if (IN(5)) REP(5) { const att::Tensors T{(const bf16*)(kws() + WS_P), (const bf16*)(kws() + WS_KV), (const bf16*)(kws() + WS_KPE), kin(I_RPB), (bf16*)(kws() + WS_CAT)};
                if (vcu & 16) { for (int u = vcu; u < 256; u += G) att::attn_unit<1>(lds, T, u); }
                for (int u = vcu; u < 256; u += G) att::attn_unit<0>(lds, T, u);
                if (!(vcu & 16)) { for (int u = vcu; u < 256; u += G) att::attn_unit<1>(lds, T, u); }
                steal(lds, MISC, 5, 0u, G, 64); SEAM(5); }
    }
#define COMMON_PHASES(l, cb) \
        if (IN(cb)) REP(cb) { ProbOut<(l != 0)> P{2048, 2048, 2048, 256, (const bf16*)(kws() + WS_CAT), (const bf16*)(kws() + (l == 0 ? WS_WABO : WS_WCDO)), l == 0 ? (const void*)kin(I_X) : (const void*)(kws() + WS_H2), \
                               (const float*)(kws() + WS_ADA) + (size_t)l * 5 * 6 * D + 2 * D, (bf16*)(kws() + WS_PRE)}; \
            pg8::gemm_phase(lds, P, vcu, G); SEAM(cb); } \
        if (IN(cb + 1)) REP(cb + 1) { ln1_phase(lds, l, vcu, G); SEAM(cb + 1); } \
        if (IN(cb + 2)) REP(cb + 2) { if (G == 256) topk_phase(lds, A, (vcu & 31) < 8 ? (vcu >> 5) * 8 + (vcu & 31) : NRT, NRT); else topk_phase(lds, A, vcu, G); \
            steal(lds, MISC, cb + 2, (unsigned)l * XT_L + (XT_L / 3) * 2, G); SEAM(cb + 2); } \
        if (IN(cb + 3)) REP(cb + 3) { ProbMoe1 P{2048, 2048, 2048, 704, (const bf16*)(kws() + WS_U2), (const int*)(kws() + WS_IDX), (const bf16*)(kws() + WS_W13) + (size_t)l * 16 * (2 * FF * D), (bf16*)(kws() + WS_HDN)}; \
            if (G == 256) { if ((vcu & 31) < 30) pg8::gemm_phase(lds, P, (vcu >> 5) * 30 + (vcu & 31), 240); } else pg8::gemm_phase(lds, P, vcu, G); \
            steal(lds, MISC, cb + 3, (unsigned)(l + 1) * XT_L, G); SEAM(cb + 3); } \
        if (IN(cb + 4)) REP(cb + 4) { ProbMoe2 P{FF, FF, FF, 512, (const bf16*)(kws() + WS_HDN), (const bf16*)(kws() + WS_W2) + (size_t)l * 16 * (D * FF), (const float*)(kws() + WS_GATE), (bf16*)(kws() + WS_YE)}; \
            pg8::gemm_phase(lds, P, vcu, G); SEAM(cb + 4); } \
        if (IN(cb + 5)) REP(cb + 5) { ln2_phase(l, vcu, G); SEAM(cb + 5); }
    COMMON_PHASES(0, 6)
    {

            if (IN(12)) REP(12) { ProbPlain P{2048, 2048, 2048, 32 * 16, (const bf16*)(kws() + WS_UALL), (const bf16*)(kws() + WS_WCD), (bf16*)(kws() + WS_P), IN_CD, 32, 16};
                pg8::gemm_phase(lds, P, vcu, G); SEAM(12); }
            if (IN(13)) REP(13) {
                if (PX_PARTS & 1) { const int tid = tid_opaque(), lane = tid & 63, wave = __builtin_amdgcn_readfirstlane(tid >> 6);
                    for (int it = vcu * NWAVES + wave; it < NB * 32 * 48; it += G * NWAVES) prep_item(lds + wave * 9600, (const bf16*)(kws() + WS_P), kin(I_CONVW), kin(I_CONVB), (bf16*)(kws() + WS_ST), it, lane); }
                __syncthreads();
                ProbF1 P{256, 256, IN_CD, 256, (const bf16*)(kws() + WS_CS256), (const bf16*)(kws() + WS_P), (bf16*)(kws() + WS_T1)};
                if (PX_PARTS & 2) pg8::gemm_phase(lds, P, vcu, G);
                f1_mid((const bf16*)(kws() + WS_CS256), (const bf16*)(kws() + WS_P), (bf16*)(kws() + WS_T1), vcu * NTHR + (int)threadIdx.x, G * NTHR); SEAM(13); }
            if (IN(14)) REP(14) {
                if (G == 256) { if ((vcu & 31) < 16) { ProbF2 P{2048, 2048, 2048, 128, (const bf16*)(kws() + WS_CSL), (const bf16*)(kws() + WS_T1), (bf16*)(kws() + WS_CAT)}; pg8::gemm_phase(lds, P, (vcu >> 5) * 16 + (vcu & 31), 128); } }
                else { ProbF2 P{2048, 2048, 2048, 128, (const bf16*)(kws() + WS_CSL), (const bf16*)(kws() + WS_T1), (bf16*)(kws() + WS_CAT)}; pg8::gemm_phase(lds, P, vcu, G); }
                for (int u = vcu; u < 256; u += G) hy::hyena_unit(lds, (const bf16*)(kws() + WS_ST), (const bf16*)(kws() + WS_HR), kin(I_SKIP), (bf16*)(kws() + WS_CAT), u);
                steal(lds, MISC, 14, 0u, G); SEAM(14); }
    }
    COMMON_PHASES(1, 15)
#undef COMMON_PHASES
    if (PROBE_SA >= 0 && blockIdx.x == 0 && threadIdx.x == 0) { volatile LAS unsigned* st = (volatile LAS unsigned*)(lds + LDS_STAMP);
        const unsigned v = (st[PROBE_SB >= 0 ? PROBE_SB : 0] - st[PROBE_SA >= 0 ? PROBE_SA : 0]) * PROBE_SCALE; const unsigned long long t0 = __builtin_amdgcn_s_memrealtime();
        while (__builtin_amdgcn_s_memrealtime() - t0 < (unsigned long long)v) __builtin_amdgcn_s_sleep(8); }
#undef IN
#undef SEAM
}

extern "C" void kernel_launch(void* const* d_in, const int* in_sizes, int n_in, void* d_out, int out_size, void* d_ws, size_t ws_size, hipStream_t stream) {
    static int grid = 0;
    if (grid == 0) {
        if (n_in != 31 || out_size != MLAT * D || ws_size < WS_END) { fprintf(stderr, "kernel_launch: unexpected shapes (n_in %d, out %d, ws %zu < %zu)\n", n_in, out_size, ws_size, (size_t)WS_END); grid = -1; return; }
        int dev = 0, cus = 0, per_cu = 0;
        if (hipGetDevice(&dev) != hipSuccess || hipDeviceGetAttribute(&cus, hipDeviceAttributeMultiprocessorCount, dev) != hipSuccess) { grid = -1; return; }
        if (hipFuncSetAttribute((const void*)mk_fwd, hipFuncAttributeMaxDynamicSharedMemorySize, LDS_BYTES) != hipSuccess) { fprintf(stderr, "kernel_launch: hipFuncSetAttribute failed\n"); grid = -1; return; }
        if (hipOccupancyMaxActiveBlocksPerMultiprocessor(&per_cu, (const void*)mk_fwd, NTHR, LDS_BYTES) != hipSuccess || per_cu < 1) { fprintf(stderr, "kernel_launch: occupancy query says %d\n", per_cu); }
        (void)hipGetLastError();
        grid = cus;
    }
    if (grid < 0) return;
    (void)hipMemsetAsync((char*)d_ws + WS_CTL, 0, CTL_ZERO_BYTES, stream);
    Args a{};
    for (int i = 0; i < 31; ++i) a.in[i] = (const float*)d_in[i];
    a.out = (float*)d_out; a.ws = (unsigned char*)d_ws;
#if MK_LAUNCH_PER_PHASE
    for (int ph = 0; ph < NPHASE; ++ph) { a.ph_lo = ph; a.ph_hi = ph + 1; hipLaunchKernelGGL(mk_fwd, dim3(grid), dim3(NTHR), LDS_BYTES, stream, a); }
#else
    a.ph_lo = 0; a.ph_hi = NPHASE;
    hipLaunchKernelGGL(mk_fwd, dim3(grid), dim3(NTHR), LDS_BYTES, stream, a);
#endif
}
```

```cpp
#include <hip/hip_runtime.h>
#include <cstdio>
#include <cstdint>

#ifndef MK_LAUNCH_PER_PHASE
#define MK_LAUNCH_PER_PHASE 0
#endif

#define GAS __attribute__((address_space(1)))
#define LAS __attribute__((address_space(3)))
typedef unsigned short bf16;
typedef short bf16x8 __attribute__((ext_vector_type(8)));
typedef short s16x4 __attribute__((ext_vector_type(4)));
typedef float f32x4 __attribute__((ext_vector_type(4)));
typedef float f32x2 __attribute__((ext_vector_type(2)));
typedef float f32x16 __attribute__((ext_vector_type(16)));
typedef unsigned u32x4 __attribute__((ext_vector_type(4)));
typedef unsigned u32x2 __attribute__((ext_vector_type(2)));
#define RLX_AGENT __ATOMIC_RELAXED, __HIP_MEMORY_SCOPE_AGENT
#define LDS_WAIT() asm volatile("s_waitcnt lgkmcnt(0)" ::: "memory")
#define VM_WAIT() asm volatile("s_waitcnt vmcnt(0)" ::: "memory")

constexpr int D = 2048, NB = 4, SEQ = 2048, LC = 256, GW = 64;
constexpr int MLAT = NB * SEQ, MCTX = NB * LC, MALL = MLAT + MCTX;
constexpr int IN_AB = 5184, IN_AB_PAD = 5376;
constexpr int OFF_CKV = 1536, OFF_KPE = 2048, OFF_QNA = 2112, OFF_KNA = 3136, OFF_VNA = 4160;
constexpr int KVR = 512, NH = 8;
constexpr int FF = 1408, NE = 16, CAP = 256, NRT = NE * NB;
constexpr int IN_CD = 4096, HYW = 1024, HY3 = 3072;
constexpr float LN_EPS = 1e-6f;
constexpr float DN_ALPHA = 1.41421356237f;
constexpr int NWAVES = 8, NTHR = 512;

constexpr size_t MiB = 1u << 20;
constexpr size_t WS_CTL = 0, CTL_ZERO_BYTES = 2 * MiB;
constexpr size_t WS_ADA = 1 * MiB;
constexpr size_t WS_AFF = 2 * MiB;
constexpr size_t WS_IDX = 3 * MiB;
constexpr size_t WS_GATE = WS_IDX + 64 * 1024;
constexpr size_t WS_INV = 4 * MiB;
constexpr size_t WS_CS256 = 5 * MiB;
constexpr size_t WS_DBG = 6 * MiB;
constexpr size_t WS_WAB = 8 * MiB;
constexpr size_t WS_WUKV = 30 * MiB;
constexpr size_t WS_WABO = 32 * MiB;
constexpr size_t WS_WCD = 40 * MiB;
constexpr size_t WS_WCDO = 56 * MiB;
constexpr size_t WS_CSL = 64 * MiB;
constexpr size_t WS_HR = 80 * MiB;
constexpr size_t W13_E = (size_t)2 * FF * D * 2;
constexpr size_t W2_E = (size_t)D * FF * 2;
constexpr size_t WS_W13 = 96 * MiB;
constexpr size_t WS_W2 = WS_W13 + 32 * W13_E;
constexpr size_t WS_UALL = WS_W2 + 32 * W2_E;
constexpr size_t WS_P = WS_UALL + (size_t)MALL * D * 2;
constexpr size_t WS_CKVN = WS_P + (size_t)MALL * IN_AB_PAD * 2;
constexpr size_t WS_KPE = WS_CKVN + (size_t)MALL * KVR * 2;
constexpr size_t WS_KV = WS_KPE + (size_t)MALL * 64 * 2;
constexpr size_t WS_ST = WS_KV;
constexpr size_t WS_CAT = WS_KV + (size_t)NB * HY3 * SEQ * 2;
constexpr size_t WS_PRE = WS_CAT + (size_t)MLAT * D * 2;
constexpr size_t WS_H1 = WS_PRE + (size_t)MLAT * D * 4;
constexpr size_t WS_H2 = WS_H1 + (size_t)MLAT * D * 4;
constexpr size_t WS_U2 = WS_H2 + (size_t)MLAT * D * 4;
constexpr size_t WS_XE = WS_U2 + (size_t)MLAT * D * 2;
constexpr size_t WS_HDN = WS_XE + (size_t)NRT * CAP * D * 2;
constexpr size_t WS_YE = WS_HDN + (size_t)NRT * CAP * FF * 2;
constexpr size_t WS_T1 = WS_YE + (size_t)NRT * CAP * D * 2;
constexpr size_t WS_END = WS_T1 + (size_t)16 * 256 * 2 * 2048 * 2;
static_assert(WS_WAB + (size_t)IN_AB_PAD * D * 2 <= WS_WUKV && WS_HR + (size_t)2 * 1024 * 4096 * 2 <= WS_W13, "ws map");
static_assert(WS_END < (size_t)1400 * MiB, "ws map too large");

constexpr int LDS_MAIN = 151552;
constexpr int LDS_MISC = LDS_MAIN;
constexpr int LDS_STAMP = LDS_MAIN + 64;
constexpr int LDS_BYTES = LDS_MAIN + 64 + 192;

__device__ __forceinline__ unsigned f2bf(float f) { unsigned u = __builtin_bit_cast(unsigned, f); return (u + 0x7fffu + ((u >> 16) & 1u)) >> 16; }
__device__ __forceinline__ unsigned pk2(float lo, float hi) { return f2bf(lo) | (f2bf(hi) << 16); }
__device__ __forceinline__ float bf2f(unsigned b) { return __builtin_bit_cast(float, b << 16); }
__device__ __forceinline__ float bflo(unsigned w) { return __builtin_bit_cast(float, w << 16); }
__device__ __forceinline__ float bfhi(unsigned w) { return __builtin_bit_cast(float, w & 0xffff0000u); }
__device__ __forceinline__ unsigned cvt_pk_bf16(float lo, float hi) { unsigned r; asm volatile("v_cvt_pk_bf16_f32 %0, %1, %2" : "=v"(r) : "v"(lo), "v"(hi)); return r; }
__device__ __forceinline__ float wave_sum(float v) {
#pragma unroll
    for (int o = 1; o < 64; o <<= 1) v += __shfl_xor(v, o);
    return v;
}
__device__ __forceinline__ int tid_opaque() { int t = threadIdx.x; asm volatile("" : "+v"(t)); return t; }
__device__ __forceinline__ float silu_f(float x) { return x / (1.f + __expf(-x)); }

#define XB_TMO      128
#define XB_XCNT(j)  (256  + 64 * (j))
#define XB_XSUB(j)  (1280 + 64 * (j))
#define XB_XGEN(j)  (2304 + 64 * (j))
#define XB_TOP      3328
#define XB_TOPGEN   3392
#define XCD_BAR_WORDS 3456
#define XB_SPIN_CAP (1u << 18)
__device__ __forceinline__ unsigned xb_ld(unsigned* p)              { return __hip_atomic_load(p, __ATOMIC_RELAXED, __HIP_MEMORY_SCOPE_AGENT); }
__device__ __forceinline__ unsigned xb_add(unsigned* p, unsigned v) { return __hip_atomic_fetch_add(p, v, __ATOMIC_RELAXED, __HIP_MEMORY_SCOPE_AGENT); }
__device__ __forceinline__ unsigned xb_xcc_id() { return (unsigned)__builtin_amdgcn_s_getreg((3 << 11) | 20) & 0xFu; }
#define XB_SPIN(cond, bar) do { unsigned _sp = 0; while (cond) { __builtin_amdgcn_s_sleep(1); \
    if ((++_sp & 255u) == 0u) { if (xb_ld(&(bar)[XB_TMO])) break; if (_sp > XB_SPIN_CAP) { atomicAdd(&(bar)[XB_TMO], 1u); break; } } } } while (0)
struct XcdBarrier { unsigned* bar; unsigned x; volatile LAS unsigned* st; };
__device__ __forceinline__ XcdBarrier xcd_barrier_post(unsigned* bar, volatile LAS unsigned* st) {
    XcdBarrier b; b.bar = bar; b.x = xb_xcc_id(); b.st = st;
    if (threadIdx.x == 0) (void)xb_add(&bar[XB_XCNT(b.x)], 1u);
    return b;
}
__device__ __forceinline__ void xcd_barrier_complete(unsigned* bar, unsigned x, unsigned& nloc, unsigned& nx) {
    const unsigned G = gridDim.x * gridDim.y * gridDim.z;
    unsigned sum, cnt, mine, sp = 0u;
    for (;;) {
        sum = 0u; cnt = 0u; mine = 0u;
#pragma unroll
        for (unsigned j = 0; j < 16; ++j) { const unsigned c = xb_ld(&bar[XB_XCNT(j)]); sum += c; cnt += (c > 0u) ? 1u : 0u; mine = (j == x) ? c : mine; }
        if (sum == G) break;
        __builtin_amdgcn_s_sleep(1);
        if ((++sp & 255u) == 0u) { if (xb_ld(&bar[XB_TMO])) break; if (sp > XB_SPIN_CAP) { atomicAdd(&bar[XB_TMO], 1u); break; } }
    }
    nloc = mine > 0u ? mine : 1u; nx = cnt > 0u ? cnt : 1u;
}
__device__ __forceinline__ void xcd_barrier(const XcdBarrier& b) {
    asm volatile("s_waitcnt vmcnt(0)" ::: "memory");
    __syncthreads();
    if (threadIdx.x == 0) {
        unsigned* bar = b.bar;
        __builtin_amdgcn_s_waitcnt(0);
        unsigned nloc = b.st[0], nx = b.st[1];
        if (nloc == 0u) { xcd_barrier_complete(bar, b.x, nloc, nx); b.st[0] = nloc; b.st[1] = nx; }
        const unsigned old = xb_add(&bar[XB_XSUB(b.x)], 1u);
        const unsigned gen = old / nloc;
        if (old + 1u == (gen + 1u) * nloc) {
            __builtin_amdgcn_fence(__ATOMIC_RELEASE, "agent");
            asm volatile("s_waitcnt vmcnt(0)" ::: "memory");
            const unsigned og = xb_add(&bar[XB_TOP], 1u);
            const unsigned tg = og / nx;
            if (og + 1u == (tg + 1u) * nx) xb_add(&bar[XB_TOPGEN], 1u);
            else XB_SPIN(xb_ld(&bar[XB_TOPGEN]) == tg, bar);
            __builtin_amdgcn_fence(__ATOMIC_ACQUIRE, "agent");
            xb_add(&bar[XB_XGEN(b.x)], 1u);
            asm volatile("s_waitcnt vmcnt(0)" ::: "memory");
        } else {
            XB_SPIN(xb_ld(&bar[XB_XGEN(b.x)]) == gen, bar);
            __builtin_amdgcn_fence(__ATOMIC_ACQUIRE, "agent");
            asm volatile("s_waitcnt vmcnt(0)" ::: "memory");
        }
    }
    __syncthreads();
}

namespace pg8 {
constexpr int BM = 256, BK = 64, HALF = 128, HTB = HALF * BK * 2, STAGE_BYTES = 8 * HTB;
__host__ __device__ __forceinline__ int lds_byte(int r, int c) { const int st = (r >> 4) * 2 + (c >> 5), rr = r & 15, cc = c & 31, ob = rr * 64 + cc * 2; return st * 1024 + (ob ^ (((ob >> 9) & 1) << 5)); }
__host__ __device__ __forceinline__ void stage_rc(int b, int& R, int& C) { const int st = b / 1024, sb = b % 1024, swz = sb ^ (((sb >> 9) & 1) << 5); R = (st >> 1) * 16 + swz / 64; C = (st & 1) * 32 + (swz % 64) / 2; }
__host__ __device__ __forceinline__ int perm32(int rho) { const int n = rho >> 4, i = rho & 15; return 8 * (i >> 2) + 4 * n + (i & 3); }

template <class Prob>
__device__ __forceinline__ void gemm_phase(LAS unsigned char* lds, const Prob& P, int u0, int ustride) {
    const int tid = tid_opaque(), wid = __builtin_amdgcn_readfirstlane(tid >> 6), lane = tid & 63, wr = wid >> 2, wc = wid & 3, fr = lane & 15, fq = lane >> 4;
    const int K = P.K, nt = K / BK;
    unsigned voffA[2], voffB[2];
#pragma unroll
    for (int i = 0; i < 2; ++i) { int R, C; stage_rc(tid * 16 + i * 8192, R, C); const int Rb = Prob::PERM ? ((R & ~31) + perm32(R & 31)) : R;
        voffA[i] = (unsigned)(R * P.lda + C) * 2u; voffB[i] = (unsigned)(Rb * P.ldb + C) * 2u; }
    const size_t kstep = (size_t)(BK * 2);
    const size_t hstepA = Prob::GATHER ? (size_t)0 : (size_t)HALF * P.lda * 2, hstepB = (size_t)HALF * P.ldb * 2;
    unsigned gvoC[2][2], gvoN[2][2];
    long voffBm[2]; long cBd = 0, nBd = 0;
    if constexpr (Prob::BMIRROR) {
#pragma unroll
        for (int i = 0; i < 2; ++i) { int R, C; stage_rc(tid * 16 + i * 8192, R, C); const int Rb = Prob::PERM ? ((R & ~31) + perm32(R & 31)) : R; voffBm[i] = ((long)C - (long)Rb * P.ldb) * 2; } }
    const unsigned ldsw = (unsigned)wid * 1024u;
    const int aoff = lds_byte(wr * 64 + fr, fq * 8), boff = lds_byte(wc * 32 + fr, fq * 8);
#define PG8_SA(b, h) (((b) * 2 + (h)) * HTB)
#define PG8_SB(b, h) ((4 + (b) * 2 + (h)) * HTB)
#define PG8_STAGE(bufoff, gbase, voff) do { _Pragma("unroll") for (int _i = 0; _i < 2; ++_i) \
        __builtin_amdgcn_global_load_lds((const unsigned*)((const char*)(gbase) + (voff)[_i]), (LAS unsigned*)(lds + (bufoff) + ldsw + _i * 8192), 16, 0, 0); } while (0)
#define PG8_STAGEA(bufoff, gbase, h, NX) do { if constexpr (Prob::GATHER) { if (NX) PG8_STAGE(bufoff, gbase, gvoN[h]); else PG8_STAGE(bufoff, gbase, gvoC[h]); } else PG8_STAGE(bufoff, (gbase) + (h) * hstepA, voffA); } while (0)
#define PG8_STAGEB1(bufoff, gbase, NX) do { if constexpr (Prob::BMIRROR) PG8_STAGE(bufoff, (gbase) + ((NX) ? nBd : cBd), voffBm); else PG8_STAGE(bufoff, (gbase) + hstepB, voffB); } while (0)
#define PG8_LDA(dst, b, h) do { _Pragma("unroll") for (int m = 0; m < 4; ++m) _Pragma("unroll") for (int k = 0; k < 2; ++k) dst[m][k] = *(const LAS bf16x8*)(lds + PG8_SA(b, h) + aoff + m * 2048 + k * 1024); } while (0)
#define PG8_LDB(dst, b, h) do { _Pragma("unroll") for (int n = 0; n < 2; ++n) _Pragma("unroll") for (int k = 0; k < 2; ++k) dst[n][k] = *(const LAS bf16x8*)(lds + PG8_SB(b, h) + boff + n * 2048 + k * 1024); } while (0)
#define PG8_MMA(ai, bj, At, Bt) do { __builtin_amdgcn_s_setprio(1); _Pragma("unroll") for (int m = 0; m < 4; ++m) _Pragma("unroll") for (int n = 0; n < 2; ++n) _Pragma("unroll") for (int k = 0; k < 2; ++k) \
        acc[ai][bj][m][n] = __builtin_amdgcn_mfma_f32_16x16x32_bf16(Bt[n][k], At[m][k], acc[ai][bj][m][n], 0, 0, 0); __builtin_amdgcn_s_setprio(0); } while (0)
#define PG8_WAIT_V(n) asm volatile("s_waitcnt vmcnt(" #n ")" ::: "memory")
#define PG8_WAIT_L(n) asm volatile("s_waitcnt lgkmcnt(" #n ")" ::: "memory")
#define PG8_BAR __builtin_amdgcn_s_barrier()
#define PG8_SCHED __builtin_amdgcn_sched_barrier(0)
    int u = u0;
    if (u >= P.nunits) return;
    f32x4 acc[2][2][4][2];
#pragma unroll
    for (int a = 0; a < 2; ++a)
#pragma unroll
        for (int b = 0; b < 2; ++b)
#pragma unroll
            for (int m = 0; m < 4; ++m)
#pragma unroll
                for (int n = 0; n < 2; ++n) acc[a][b][m][n] = (f32x4){0.f, 0.f, 0.f, 0.f};
    bf16x8 At[4][2], B0[2][2], B1[2][2];
    const char* cA; const char* cB; P.locate(u, cA, cB);
    if constexpr (Prob::BMIRROR) { cBd = P.bdelta(u); nBd = cBd; }
    if constexpr (Prob::GATHER) { P.aoffs(u, tid, gvoC);
#pragma unroll
        for (int h = 0; h < 2; ++h)
#pragma unroll
            for (int i = 0; i < 2; ++i) gvoN[h][i] = gvoC[h][i]; }
    PG8_STAGE(PG8_SB(0, 0), cB, voffB); PG8_STAGEB1(PG8_SB(0, 1), cB, false); PG8_STAGEA(PG8_SA(0, 0), cA, 0, false); PG8_STAGEA(PG8_SA(0, 1), cA, 1, false);
    if (wr == 1) PG8_BAR;
    PG8_WAIT_V(2); PG8_BAR;
    PG8_STAGE(PG8_SB(1, 0), cB + kstep, voffB); PG8_STAGEA(PG8_SA(1, 0), cA + kstep, 0, false); PG8_STAGEB1(PG8_SB(1, 1), cB + kstep, false);
    PG8_WAIT_V(6); PG8_BAR;
    for (;;) {
        const int un = u + ustride; const bool has_next = un < P.nunits;
        const char* nA = cA; const char* nB = cB; if (has_next) P.locate(un, nA, nB);
        if constexpr (Prob::GATHER) { if (has_next) P.aoffs(un, tid, gvoN); }
        if constexpr (Prob::BMIRROR) { nBd = has_next ? P.bdelta(un) : cBd; }
        for (int t = 0; t < nt; t += 2) {
            const bool last = (t == nt - 2);
            const char* a1 = cA + (size_t)(t + 1) * kstep;
            const char* a2 = last ? nA : cA + (size_t)(t + 2) * kstep; const char* b2 = last ? nB : cB + (size_t)(t + 2) * kstep;
            const char* a3 = a2 + kstep; const char* b3 = b2 + kstep;
            PG8_LDB(B0, 0, 0); PG8_LDB(B1, 0, 1); PG8_SCHED; PG8_LDA(At, 0, 0); PG8_STAGEA(PG8_SA(1, 1), a1, 1, false);
            PG8_WAIT_V(8); PG8_WAIT_L(0); PG8_BAR; PG8_MMA(0, 0, At, B0); PG8_MMA(0, 1, At, B1); PG8_BAR; PG8_SCHED;
            PG8_LDA(At, 0, 1); PG8_STAGE(PG8_SB(0, 0), b2, voffB); PG8_STAGEB1(PG8_SB(0, 1), b2, last); PG8_STAGEA(PG8_SA(0, 0), a2, 0, last);
            PG8_WAIT_V(8); PG8_WAIT_L(0); PG8_BAR; PG8_MMA(1, 0, At, B0); PG8_MMA(1, 1, At, B1); PG8_BAR; PG8_SCHED;
            PG8_LDB(B0, 1, 0); PG8_LDB(B1, 1, 1); PG8_SCHED; PG8_LDA(At, 1, 0); PG8_STAGEA(PG8_SA(0, 1), a2, 1, last);
            PG8_WAIT_V(8); PG8_WAIT_L(0); PG8_BAR; PG8_MMA(0, 0, At, B0); PG8_MMA(0, 1, At, B1); PG8_BAR; PG8_SCHED;
            PG8_LDA(At, 1, 1); PG8_STAGE(PG8_SB(1, 0), b3, voffB); PG8_STAGEB1(PG8_SB(1, 1), b3, last); PG8_STAGEA(PG8_SA(1, 0), a3, 0, last);
            PG8_WAIT_V(8); PG8_WAIT_L(0); PG8_BAR; PG8_MMA(1, 0, At, B0); PG8_MMA(1, 1, At, B1); PG8_BAR; PG8_SCHED;
        }
        if (wr == 0) PG8_BAR;
        P.epi(acc, u, wr, wc, fr, fq);
        if (!has_next) break;
#pragma unroll
        for (int a = 0; a < 2; ++a)
#pragma unroll
            for (int b = 0; b < 2; ++b)
#pragma unroll
                for (int m = 0; m < 4; ++m)
#pragma unroll
                    for (int n = 0; n < 2; ++n) acc[a][b][m][n] = (f32x4){0.f, 0.f, 0.f, 0.f};
        u = un; cA = nA; cB = nB; if constexpr (Prob::BMIRROR) cBd = nBd;
        if constexpr (Prob::GATHER) {
#pragma unroll
            for (int h = 0; h < 2; ++h)
#pragma unroll
                for (int i = 0; i < 2; ++i) gvoC[h][i] = gvoN[h][i]; }
        if (wr == 1) PG8_BAR;
    }
    PG8_WAIT_V(0);
    PG8_BAR;
#undef PG8_SA
#undef PG8_SB
#undef PG8_STAGE
#undef PG8_STAGEA
#undef PG8_STAGEB1
#undef PG8_LDA
#undef PG8_LDB
#undef PG8_MMA
#undef PG8_WAIT_V
#undef PG8_WAIT_L
#undef PG8_BAR
#undef PG8_SCHED
}
__device__ __forceinline__ void tile_of(int u, int nM, int nN, int& pm, int& pn) {
    const int nig = 8 * nN, g = u / nig, r = u % nig, fm = g * 8, gsz = (nM - fm) < 8 ? (nM - fm) : 8;
    pm = fm + r % gsz; pn = r / gsz;
}
__device__ __forceinline__ void st8(bf16* p, f32x4 v0, f32x4 v1) {
    u32x4 w; w.x = cvt_pk_bf16(v0[0], v0[1]); w.y = cvt_pk_bf16(v0[2], v0[3]); w.z = cvt_pk_bf16(v1[0], v1[1]); w.w = cvt_pk_bf16(v1[2], v1[3]);
    *(u32x4*)p = w;
}
}

typedef __bf16 bf16x2_t __attribute__((ext_vector_type(2)));
__device__ __forceinline__ unsigned cvtpk(float lo, float hi) { f32x2 v = {lo, hi}; bf16x2_t b = __builtin_convertvector(v, bf16x2_t); return __builtin_bit_cast(unsigned, b); }

struct ProbPlain {
    static constexpr bool GATHER = false; static constexpr bool BMIRROR = false; static constexpr bool PERM = true;
    int K, lda, ldb, nunits; const bf16* A; const bf16* Bt; bf16* O; int ldc, nM, nN;
    __device__ __forceinline__ void locate(int u, const char*& a, const char*& b) const { int pm, pn; pg8::tile_of(u, nM, nN, pm, pn); a = (const char*)(A + (size_t)pm * 256 * lda); b = (const char*)(Bt + (size_t)pn * 256 * ldb); }
    __device__ __forceinline__ void epi(const f32x4 (&acc)[2][2][4][2], int u, int wr, int wc, int fr, int fq) const {
        int pm, pn; pg8::tile_of(u, nM, nN, pm, pn);
        const int row0 = pm * 256 + wr * 64 + fr, col0 = pn * 256 + wc * 32 + 8 * fq;
#pragma unroll
        for (int ai = 0; ai < 2; ++ai)
#pragma unroll
            for (int m = 0; m < 4; ++m) { bf16* rowp = O + (size_t)(row0 + ai * 128 + m * 16) * ldc + col0;
#pragma unroll
                for (int bj = 0; bj < 2; ++bj) pg8::st8(rowp + bj * 128, acc[ai][bj][m][0], acc[ai][bj][m][1]); }
    }
};
struct ProbInAB {
    static constexpr bool GATHER = false; static constexpr bool BMIRROR = false; static constexpr bool PERM = true;
    int K, lda, ldb, nunits; const bf16* A; const bf16* Bt; bf16* O;
    __device__ __forceinline__ void map(int u, int& pm, int& pn) const {
        if (u < 32 * 21) pg8::tile_of(u, 32, 21, pm, pn);
        else { const int v = u - 32 * 21, q = v >> 2; pm = 32 + (v & 3); pn = q < 3 ? 6 + q : 9 + q; } }
    __device__ __forceinline__ void locate(int u, const char*& a, const char*& b) const { int pm, pn; map(u, pm, pn); a = (const char*)(A + (size_t)pm * 256 * lda); b = (const char*)(Bt + (size_t)pn * 256 * ldb); }
    __device__ __forceinline__ void epi(const f32x4 (&acc)[2][2][4][2], int u, int wr, int wc, int fr, int fq) const {
        int pm, pn; map(u, pm, pn);
        const int row0 = pm * 256 + wr * 64 + fr, col0 = pn * 256 + wc * 32 + 8 * fq;
#pragma unroll
        for (int ai = 0; ai < 2; ++ai)
#pragma unroll
            for (int m = 0; m < 4; ++m) { bf16* rowp = O + (size_t)(row0 + ai * 128 + m * 16) * IN_AB_PAD + col0;
#pragma unroll
                for (int bj = 0; bj < 2; ++bj) pg8::st8(rowp + bj * 128, acc[ai][bj][m][0], acc[ai][bj][m][1]); }
    }
};
template <bool HBF> struct ProbOut {
    static constexpr bool GATHER = false; static constexpr bool BMIRROR = false; static constexpr bool PERM = true;
    int K, lda, ldb, nunits; const bf16* A; const bf16* Bt; const void* h; const float* gate; bf16* pre;
    __device__ __forceinline__ void locate(int u, const char*& a, const char*& b) const { int pm, pn; pg8::tile_of(u, 32, 8, pm, pn); a = (const char*)(A + (size_t)pm * 256 * lda); b = (const char*)(Bt + (size_t)pn * 256 * ldb); }
    __device__ __forceinline__ void epi(const f32x4 (&acc)[2][2][4][2], int u, int wr, int wc, int fr, int fq) const {
        int pm, pn; pg8::tile_of(u, 32, 8, pm, pn);
        const int row0 = pm * 256 + wr * 64 + fr, col0 = pn * 256 + wc * 32 + 8 * fq;
        const float* g = gate + (size_t)(pm >> 3) * (6 * D);
        f32x4 gv[2][2];
#pragma unroll
        for (int bj = 0; bj < 2; ++bj)
#pragma unroll
            for (int n = 0; n < 2; ++n) gv[bj][n] = *(const f32x4*)(g + col0 + bj * 128 + n * 4);
#pragma unroll
        for (int ai = 0; ai < 2; ++ai) {
            u32x4 hb[4][2]; f32x4 hf[4][2][2];
#pragma unroll
            for (int m = 0; m < 4; ++m) { const size_t off = (size_t)(row0 + ai * 128 + m * 16) * D + col0;
#pragma unroll
                for (int bj = 0; bj < 2; ++bj) {
                    if (HBF) hb[m][bj] = *(const u32x4*)((const bf16*)h + off + bj * 128);
                    else { hf[m][bj][0] = *(const f32x4*)((const float*)h + off + bj * 128); hf[m][bj][1] = *(const f32x4*)((const float*)h + off + bj * 128 + 4); } } }
#pragma unroll
            for (int m = 0; m < 4; ++m) { const size_t off = (size_t)(row0 + ai * 128 + m * 16) * D + col0;
#pragma unroll
                for (int bj = 0; bj < 2; ++bj) { f32x4 h0, h1;
                    if (HBF) { const u32x4 w = hb[m][bj]; h0 = (f32x4){bflo(w.x), bfhi(w.x), bflo(w.y), bfhi(w.y)}; h1 = (f32x4){bflo(w.z), bfhi(w.z), bflo(w.w), bfhi(w.w)}; }
                    else { h0 = hf[m][bj][0]; h1 = hf[m][bj][1]; }
                    pg8::st8(pre + off + bj * 128, h0 * DN_ALPHA + gv[bj][0] * acc[ai][bj][m][0], h1 * DN_ALPHA + gv[bj][1] * acc[ai][bj][m][1]); } } }
    }
};
struct ProbMoe1 {
    static constexpr bool GATHER = true; static constexpr bool BMIRROR = false; static constexpr bool PERM = true;
    int K, lda, ldb, nunits; const bf16* U2; const int* IDX; const bf16* W13; bf16* HDN;
    const LAS int* tab; int u0, us;
    __device__ __forceinline__ void map(int u, int& rt, int& pn) const { const int b = u & 3, q = u >> 2; pn = q % 11; rt = (q / 11) * 4 + b; }
    __device__ __forceinline__ void locate(int u, const char*& a, const char*& b) const { int rt, pn; map(u, rt, pn); a = (const char*)U2; b = (const char*)(W13 + (size_t)(rt >> 2) * (2 * FF * D) + (size_t)pn * 256 * D); }
    __device__ __forceinline__ void aoffs(int u, int tid, unsigned (&vo)[2][2]) const { int rt, pn; map(u, rt, pn);
        const int tb = us ? ((u - u0) / us) * 256 : 0;
#pragma unroll
        for (int i = 0; i < 2; ++i) { int R, C; pg8::stage_rc(tid * 16 + i * 8192, R, C);
#pragma unroll
            for (int h = 0; h < 2; ++h) { const int row = us ? tab[tb + h * 128 + R] : (rt & 3) * SEQ + IDX[rt * CAP + h * 128 + R]; vo[h][i] = (unsigned)(row * D + C) * 2u; } } }
    __device__ __forceinline__ void epi(const f32x4 (&acc)[2][2][4][2], int u, int wr, int wc, int fr, int fq) const {
        int rt, pn; map(u, rt, pn);
        const int row0 = rt * 256 + wr * 64 + fr, col0 = pn * 128 + wc * 32 + 8 * fq;
#pragma unroll
        for (int ai = 0; ai < 2; ++ai)
#pragma unroll
            for (int m = 0; m < 4; ++m) { bf16* rowp = HDN + (size_t)(row0 + ai * 128 + m * 16) * FF + col0;
                f32x4 v[2];
#pragma unroll
                for (int n = 0; n < 2; ++n) { const f32x4 a = acc[ai][0][m][n], g = acc[ai][1][m][n];
#pragma unroll
                    for (int j = 0; j < 4; ++j) v[n][j] = a[j] * __builtin_amdgcn_rcpf(1.f + __expf(-a[j])) * g[j]; }
                pg8::st8(rowp, v[0], v[1]); }
    }
};
__device__ __forceinline__ void moe1_tab(LAS unsigned char* lds, ProbMoe1& P, int u0, int us) {
    const int tid = tid_opaque(); LAS int* tab = (LAS int*)(lds + pg8::STAGE_BYTES);
    const int nloc = u0 < P.nunits ? (P.nunits - u0 + us - 1) / us : 0;
    P.tab = tab; P.u0 = u0; P.us = nloc <= 20 ? us : 0;
    if (nloc <= 20) for (int j = tid; j < nloc * 256; j += NTHR) { const int u = u0 + (j >> 8) * us; int rt, pn; P.map(u, rt, pn); tab[j] = (rt & 3) * SEQ + P.IDX[rt * CAP + (j & 255)]; }
    __syncthreads();
}
struct ProbMoe2 {
    static constexpr bool GATHER = false; static constexpr bool BMIRROR = false; static constexpr bool PERM = true;
    int K, lda, ldb, nunits; const bf16* HDN; const bf16* W2; const float* gate; bf16* YE;
    __device__ __forceinline__ void map(int u, int& rt, int& pn) const { const int b = u & 3, q = u >> 2; pn = q & 7; rt = (q >> 3) * 4 + b; }
    __device__ __forceinline__ void locate(int u, const char*& a, const char*& b) const { int rt, pn; map(u, rt, pn); a = (const char*)(HDN + (size_t)rt * 256 * FF); b = (const char*)(W2 + (size_t)(rt >> 2) * (D * FF) + (size_t)pn * 256 * FF); }
    __device__ __forceinline__ void epi(const f32x4 (&acc)[2][2][4][2], int u, int wr, int wc, int fr, int fq) const {
        int rt, pn; map(u, rt, pn);
        const int row0 = rt * 256 + wr * 64 + fr, col0 = pn * 256 + wc * 32 + 8 * fq;
        float gts[2][4];
#pragma unroll
        for (int ai = 0; ai < 2; ++ai)
#pragma unroll
            for (int m = 0; m < 4; ++m) gts[ai][m] = gate[row0 + ai * 128 + m * 16];
#pragma unroll
        for (int ai = 0; ai < 2; ++ai)
#pragma unroll
            for (int m = 0; m < 4; ++m) { const int row = row0 + ai * 128 + m * 16; const float gt = gts[ai][m]; bf16* rowp = YE + (size_t)row * D + col0;
#pragma unroll
                for (int bj = 0; bj < 2; ++bj) pg8::st8(rowp + bj * 128, acc[ai][bj][m][0] * gt, acc[ai][bj][m][1] * gt); }
    }
};
struct ProbF1 {
    static constexpr bool GATHER = false; static constexpr bool BMIRROR = true; static constexpr bool PERM = true;
    int K, lda, ldb, nunits; const bf16* CS; const bf16* P1; bf16* T1;
    __device__ __forceinline__ void map(int u, int& bg, int& pm, int& jt) const { jt = u & 7; pm = (u >> 3) & 1; bg = u >> 4; }
    __device__ __forceinline__ void locate(int u, const char*& a, const char*& b) const { int bg, pm, jt; map(u, bg, pm, jt);
        a = (const char*)(CS + (size_t)pm * 256 * 256); b = (const char*)(P1 + ((size_t)(bg >> 2) * SEQ + (size_t)jt * 128) * IN_CD + HY3 + (bg & 3) * 256); }
    __device__ __forceinline__ long bdelta(int u) const { const int jt = u & 7; return (long)(SEQ - 256 * jt) * IN_CD * 2; }
    __device__ __forceinline__ void epi(const f32x4 (&acc)[2][2][4][2], int u, int wr, int wc, int fr, int fq) const {
        int bg, pm, jt; map(u, bg, pm, jt);
        const int k20 = wr * 64 + fr, t0 = jt * 128 + wc * 32 + 8 * fq;
#pragma unroll
        for (int ai = 0; ai < 2; ++ai)
#pragma unroll
            for (int m = 0; m < 4; ++m) { const int k2 = k20 + ai * 128 + m * 16; bf16* rowp = T1 + ((size_t)bg * 256 + k2) * SEQ;
                f32x4 v0, v1;
                if (pm == 0) { v0 = acc[ai][0][m][0] + acc[ai][1][m][0]; v1 = acc[ai][0][m][1] + acc[ai][1][m][1]; if (t0 == 0) v0[0] = acc[ai][0][m][0][0]; pg8::st8(rowp + t0, v0, v1); }
                else { v0 = acc[ai][0][m][0] - acc[ai][1][m][0]; v1 = acc[ai][0][m][1] - acc[ai][1][m][1];
                    if (t0 != 0) pg8::st8(rowp + 1024 + t0, v0, v1);
                    else { bf16* q = rowp + 1024; q[1] = (bf16)f2bf(v0[1]); q[2] = (bf16)f2bf(v0[2]); q[3] = (bf16)f2bf(v0[3]); q[4] = (bf16)f2bf(v1[0]); q[5] = (bf16)f2bf(v1[1]); q[6] = (bf16)f2bf(v1[2]); q[7] = (bf16)f2bf(v1[3]); } }
            }
    }
};
__device__ __forceinline__ void f1_mid(const bf16* CS, const bf16* P1, bf16* T1, int gt, int NGT) {
    for (int i = gt; i < 16 * 256; i += NGT) { const int bg = i >> 8, k2 = i & 255; const bf16* c = CS + (size_t)k2 * 256; const bf16* g = P1 + ((size_t)(bg >> 2) * SEQ + 1024) * IN_CD + HY3 + (bg & 3) * 256;
        float a = 0.f;
        for (int n = 0; n < 256; n += 8) { const u32x4 cw = *(const u32x4*)(c + n), gw = *(const u32x4*)(g + n);
            a += bflo(cw.x) * bflo(gw.x) + bfhi(cw.x) * bfhi(gw.x) + bflo(cw.y) * bflo(gw.y) + bfhi(cw.y) * bfhi(gw.y) + bflo(cw.z) * bflo(gw.z) + bfhi(cw.z) * bfhi(gw.z) + bflo(cw.w) * bflo(gw.w) + bfhi(cw.w) * bfhi(gw.w); }
        T1[((size_t)bg * 256 + k2) * SEQ + 1024] = (bf16)f2bf(a); }
}
struct ProbF2 {
    static constexpr bool GATHER = false; static constexpr bool BMIRROR = false; static constexpr bool PERM = true;
    int K, lda, ldb, nunits; const bf16* CSL; const bf16* T1; bf16* CAT;
    __device__ __forceinline__ void locate(int u, const char*& a, const char*& b) const { const int pm = u & 7, bg = u >> 3; a = (const char*)(CSL + (size_t)pm * 256 * 2048); b = (const char*)(T1 + (size_t)bg * 256 * 2048); }
    __device__ __forceinline__ void epi(const f32x4 (&acc)[2][2][4][2], int u, int wr, int wc, int fr, int fq) const {
        const int pm = u & 7, bg = u >> 3;
        const int row0 = (bg >> 2) * SEQ + pm * 256 + wr * 64 + fr, col0 = 1024 + (bg & 3) * 256 + wc * 32 + 8 * fq;
#pragma unroll
        for (int ai = 0; ai < 2; ++ai)
#pragma unroll
            for (int m = 0; m < 4; ++m) { bf16* rowp = CAT + (size_t)(row0 + ai * 128 + m * 16) * D + col0;
#pragma unroll
                for (int bj = 0; bj < 2; ++bj) pg8::st8(rowp + bj * 128, acc[ai][bj][m][0], acc[ai][bj][m][1]); }
    }
};

namespace att {
typedef short v4i16_t __attribute__((ext_vector_type(4)));
__device__ __forceinline__ s16x4 vtr(const LAS unsigned char* p) { return __builtin_bit_cast(s16x4, __builtin_amdgcn_ds_read_tr16_b64_v4i16((LAS v4i16_t*)p)); }
constexpr int VS = 320;
struct Tensors { const bf16* P; const bf16* KV; const bf16* KPE; const float* rpb; bf16* CAT; };

template <int MODE>
__device__ __forceinline__ void attn_unit(LAS unsigned char* lds, const Tensors& T, int unit) {
    constexpr int DK = MODE == 0 ? 192 : 128, NS = DK / 16, KCH = DK / 8, KS = DK * 2 + 16;
    constexpr int KBYTES = 64 * KS, VBYTES = 64 * VS, BUF = KBYTES + VBYTES;
    constexpr int NKC = (64 * KCH) / NTHR;
    const int tid = tid_opaque(), wave = __builtin_amdgcn_readfirstlane(tid >> 6), lane = tid & 63, l32 = lane & 31, hf = lane >> 5;
    const int b = unit >> 6, h = (unit >> 3) & 7, sub = unit & 7;
    LAS float* rpb_l = (LAS float*)(lds + 2 * BUF);
    int qrow, r = 0, qc = 0, krlo = 0, nkt, cbk = 0, ra = 0;
    if (MODE == 0) { qrow = b * SEQ + sub * 256 + wave * 32 + l32; nkt = 36; }
    else { ra = sub * 4 + 2 * (wave >> 2); const int m = wave & 3;
        r = ra + ((l32 >> 4) & 1); qc = 16 * m + (l32 & 15); qrow = b * SEQ + r * GW + qc;
        cbk = 16 * m - 8 < 0 ? 0 : (16 * m - 8 > 32 ? 32 : 16 * m - 8);
        const int r0 = sub * 4, r3 = r0 + 3; krlo = r0 - 4 < 0 ? 0 : (r0 - 4 > 24 ? 24 : r0 - 4); const int rs3 = r3 - 4 < 0 ? 0 : (r3 - 4 > 24 ? 24 : r3 - 4);
        nkt = 4 + (rs3 + 8 - krlo); }
    const int rs = r - 4 < 0 ? 0 : (r - 4 > 24 ? 24 : r - 4);
    const int rsa = ra - 4 < 0 ? 0 : (ra - 4 > 24 ? 24 : ra - 4), rsb = ra - 3 < 0 ? 0 : (ra - 3 > 24 ? 24 : ra - 3);
    const int cs = qc - 8 < 0 ? 0 : (qc - 8 > 48 ? 48 : qc - 8);
    bf16x8 qf[NS];
    { const bf16* qp = T.P + (size_t)qrow * IN_AB_PAD + (MODE == 0 ? h * 192 : OFF_QNA + h * 128) + 8 * hf;
#pragma unroll
      for (int s = 0; s < NS; ++s) qf[s] = *(const bf16x8*)(qp + 16 * s); }
    if (MODE == 1) { for (int i = tid; i < 15 * 31; i += NTHR) rpb_l[i] = T.rpb[h * 465 + i]; }
    u32x4 kreg[NKC], vreg[2];
    auto key_row = [&](int kt, int rr) -> int {
        if (MODE == 0) return kt < 32 ? b * SEQ + kt * 64 + rr : MLAT + b * LC + (kt - 32) * 64 + rr;
        return kt < 4 ? MLAT + b * LC + kt * 64 + rr : b * SEQ + (krlo + kt - 4) * GW + rr;
    };
    auto load_tile = [&](int kt) {
#pragma unroll
        for (int i = 0; i < NKC; ++i) { const int ci = tid + i * NTHR, rr = ci / KCH, c = ci % KCH; const int row = key_row(kt, rr);
            const bf16* src;
            if (MODE == 0) src = c < 16 ? T.KV + (size_t)row * D + h * 256 + c * 8 : T.KPE + (size_t)row * 64 + (c - 16) * 8;
            else src = T.P + (size_t)row * IN_AB_PAD + OFF_KNA + h * 128 + c * 8;
            kreg[i] = *(const u32x4*)src; }
#pragma unroll
        for (int i = 0; i < 2; ++i) { const int ci = tid + i * NTHR, rr = ci >> 4, c = ci & 15; const int row = key_row(kt, rr);
            const bf16* src = MODE == 0 ? T.KV + (size_t)row * D + h * 256 + 128 + c * 8 : T.P + (size_t)row * IN_AB_PAD + OFF_VNA + h * 128 + c * 8;
            vreg[i] = *(const u32x4*)src; }
    };
    auto store_tile = [&](int buf) {
        LAS unsigned char* kb = lds + buf * BUF; LAS unsigned char* vb = kb + KBYTES;
#pragma unroll
        for (int i = 0; i < NKC; ++i) { const int ci = tid + i * NTHR, rr = ci / KCH, c = ci % KCH; *(LAS u32x4*)(kb + rr * KS + c * 16) = kreg[i]; }
#pragma unroll
        for (int i = 0; i < 2; ++i) { const int ci = tid + i * NTHR, rr = ci >> 4, c = ci & 15; *(LAS u32x4*)(vb + rr * VS + c * 16) = vreg[i]; }
    };
    f32x16 o[4];
#pragma unroll
    for (int c = 0; c < 4; ++c)
#pragma unroll
        for (int i = 0; i < 16; ++i) o[c][i] = 0.f;
    float m_run = -1e30f, l_run = 0.f;
    const float sc2 = (MODE == 0 ? 0.07216878364870322f : 0.08838834764831845f) * 1.4426950408889634f;
    load_tile(0); store_tile(0); __syncthreads();
    for (int kt = 0; kt < nkt; ++kt) {
        if (kt + 1 < nkt) load_tile(kt + 1);
        const int kr = krlo + kt - 4;
        const bool win = MODE == 1 && kt >= 4;
        const bool active = MODE == 0 || kt < 4 || (kr >= rsa && kr < rsb + 8);
        if (active) {
            const LAS unsigned char* kb = lds + (kt & 1) * BUF; const LAS unsigned char* vb = kb + KBYTES;
            constexpr int NG = NS / 4;
            bf16x8 kf[2][4];
            auto ldk = [&](int kb2, int g, bf16x8 (&dst)[4]) {
#pragma unroll
                for (int i = 0; i < 4; ++i) dst[i] = *(const LAS bf16x8*)(kb + ((win ? cbk : 32 * kb2) + l32) * KS + (16 * (4 * g + i) + 8 * hf) * 2); };
            ldk(0, 0, kf[0]);
#pragma unroll
            for (int kb2 = 0; kb2 < 2; ++kb2) {
                if (kb2 == 1 && win) break;
                const int koff = win ? cbk : 32 * kb2;
                f32x16 sc;
#pragma unroll
                for (int i = 0; i < 16; ++i) sc[i] = 0.f;
#pragma unroll
                for (int g = 0; g < NG; ++g) {
                    const int cur = (kb2 * NG + g) & 1;
                    if (g + 1 < NG) ldk(kb2, g + 1, kf[cur ^ 1]); else if (kb2 == 0 && !win) ldk(1, 0, kf[cur ^ 1]);
                    __builtin_amdgcn_sched_barrier(0);
#pragma unroll
                    for (int i = 0; i < 4; ++i) sc = __builtin_amdgcn_mfma_f32_32x32x16_bf16(kf[cur][i], qf[4 * g + i], sc, 0, 0, 0);
                    __builtin_amdgcn_sched_barrier(0);
                }
                float mx = -1e30f;
                if (MODE == 1 && kt >= 4) {
#pragma unroll
                    for (int i = 0; i < 16; ++i) { const int kc = koff + 8 * (i >> 2) + 4 * hf + (i & 3); const bool ok = (unsigned)(kc - cs) < 16u && (unsigned)(kr - rs) < 8u;
                        int bi = (kr - r + 7) * 31 + (kc - qc + 15); bi = ok ? bi : 0;
                        const float v = ok ? sc[i] * sc2 + rpb_l[bi] * 1.4426950408889634f : -1e30f; sc[i] = v; mx = fmaxf(mx, v); }
                } else {
#pragma unroll
                    for (int i = 0; i < 16; ++i) mx = fmaxf(mx, sc[i]);
                    mx *= sc2;
                }
                mx = fmaxf(mx, __shfl_xor(mx, 32));
                const bool upd = mx > m_run + 8.f;
                const float m_new = upd ? mx : m_run, alpha = upd ? __builtin_amdgcn_exp2f(m_run - m_new) : 1.f;
                m_run = m_new;
                float ps = 0.f;
                if (MODE == 1 && kt >= 4) {
#pragma unroll
                    for (int i = 0; i < 16; ++i) { const float p = __builtin_amdgcn_exp2f(sc[i] - m_new); sc[i] = p; ps += p; }
                } else {
#pragma unroll
                    for (int i = 0; i < 16; ++i) { const float p = __builtin_amdgcn_exp2f(__builtin_fmaf(sc[i], sc2, -m_new)); sc[i] = p; ps += p; }
                }
                l_run = l_run * alpha + ps;
                if (__builtin_amdgcn_ballot_w64(alpha != 1.f) != 0ull) {
#pragma unroll
                    for (int c = 0; c < 4; ++c)
#pragma unroll
                        for (int i = 0; i < 16; ++i) o[c][i] *= alpha; }
                bf16x8 vf[2][4];
                auto ldv = [&](int s2, bf16x8 (&dst)[4]) {
                    const LAS unsigned char* vrow = vb + (koff + 16 * s2 + 4 * hf + ((lane & 15) >> 2)) * VS + (16 * ((lane >> 4) & 1) + 4 * (lane & 3)) * 2;
#pragma unroll
                    for (int c = 0; c < 4; ++c) { const s16x4 v0 = vtr(vrow + c * 64), v1 = vtr(vrow + 8 * VS + c * 64); dst[c] = (bf16x8){v0[0], v0[1], v0[2], v0[3], v1[0], v1[1], v1[2], v1[3]}; } };
                ldv(0, vf[0]);
#pragma unroll
                for (int s2 = 0; s2 < 2; ++s2) {
                    if (s2 == 0) ldv(1, vf[1]);
                    __builtin_amdgcn_sched_barrier(0);
                    u32x4 pw; pw.x = cvtpk(sc[8 * s2 + 0], sc[8 * s2 + 1]); pw.y = cvtpk(sc[8 * s2 + 2], sc[8 * s2 + 3]);
                    pw.z = cvtpk(sc[8 * s2 + 4], sc[8 * s2 + 5]); pw.w = cvtpk(sc[8 * s2 + 6], sc[8 * s2 + 7]);
                    const bf16x8 pf = __builtin_bit_cast(bf16x8, pw);
#pragma unroll
                    for (int c = 0; c < 4; ++c) o[c] = __builtin_amdgcn_mfma_f32_32x32x16_bf16(vf[s2][c], pf, o[c], 0, 0, 0);
                }
            }
        }
        if (kt + 1 < nkt) store_tile((kt + 1) & 1);
        __syncthreads();
    }
    const float linv = 1.f / (l_run + __shfl_xor(l_run, 32));
    bf16* op = T.CAT + (size_t)qrow * D + (MODE == 0 ? h * 128 : 1024 + h * 128) + 4 * hf;
#pragma unroll
    for (int c = 0; c < 4; ++c)
#pragma unroll
        for (int g = 0; g < 4; ++g) { u32x2 w; w.x = cvtpk(o[c][4 * g] * linv, o[c][4 * g + 1] * linv); w.y = cvtpk(o[c][4 * g + 2] * linv, o[c][4 * g + 3] * linv);
            *(u32x2*)(op + 32 * c + 8 * g) = w; }
}
}

namespace hy {
constexpr int ZROW = 4800;
constexpr int Z_BYTES = 16 * ZROW;
constexpr int HR_OFF = 76800;
constexpr int HR_CH = 16384 + 64, HR_C1 = 8192 + 64;
constexpr int XROW = 4096 + 16;
constexpr int HR_BYTES = 16 * XROW;
static_assert(HR_OFF + HR_BYTES <= LDS_MAIN && HR_OFF >= Z_BYTES && HR_BYTES >= 4 * HR_CH, "hyena LDS map");

__device__ __forceinline__ void load_rows(LAS unsigned char* lds, const bf16* ST, int part, int c0, bool zlayout) {
    const int tid = tid_opaque();
#pragma unroll
    for (int i = 0; i < 8; ++i) { const int ci = tid + i * NTHR, row = ci >> 8, cc = ci & 255, ch = row >> 2, b = row & 3;
        const u32x4 v = *(const u32x4*)(ST + ((size_t)(b * HY3 + part * HYW + c0 + ch) * SEQ + cc * 8));
        if (zlayout) *(LAS u32x4*)(lds + row * ZROW + (cc >> 3) * 144 + (cc & 7) * 16) = v;
        else *(LAS u32x4*)(lds + HR_OFF + row * XROW + cc * 16) = v; }
}
__device__ __forceinline__ void load_hr(LAS unsigned char* lds, const bf16* HRg, int o, int c0) {
    const int tid = tid_opaque();
#pragma unroll
    for (int i = 0; i < 4; ++i) { const int ci = tid + i * NTHR, ch = ci >> 9, cc = ci & 511;
        const unsigned* src = (const unsigned*)(HRg + ((size_t)(o * HYW + c0 + ch) * 4096 + cc * 8));
        const u32x4 v = *(const u32x4*)src; const unsigned nx = cc == 511 ? 0u : src[4];
        *(LAS u32x4*)(lds + HR_OFF + ch * HR_CH + cc * 16) = v;
        u32x4 s; s.x = (v.x >> 16) | (v.y << 16); s.y = (v.y >> 16) | (v.z << 16); s.z = (v.z >> 16) | (v.w << 16); s.w = (v.w >> 16) | (nx << 16);
        *(LAS u32x4*)(lds + HR_OFF + ch * HR_CH + HR_C1 + cc * 16) = s; }
}
struct ConvAddr { const LAS unsigned char* a; const LAS unsigned char* b[4]; };
__device__ __forceinline__ void conv_addr(ConvAddr& c, const LAS unsigned char* hrc, const LAS unsigned char* zl, int d, int xb, int il) {
    const int x0 = xb - 64 * d;
    c.a = hrc + (x0 & 1) * HR_C1 + (x0 >> 1) * 4;
    const int j0 = il - d;
#pragma unroll
    for (int n = 0; n < 4; ++n) { const int j = j0 + 8 * n; c.b[n] = zl + ((unsigned)j < 32u ? j : 32) * 144; }
}
template <int K4, int MASK>
__device__ __forceinline__ void conv_load(const ConvAddr& c, u32x4& a, u32x4 (&b)[4]) {
    const LAS unsigned* ap = (const LAS unsigned*)(c.a + K4 * 32);
    a.x = ap[0]; a.y = ap[1]; a.z = ap[2]; a.w = ap[3];
#pragma unroll
    for (int n = 0; n < 4; ++n) if ((MASK >> n) & 1) b[n] = *(const LAS u32x4*)(c.b[n] + K4 * 32);
}
template <int MASK>
__device__ __forceinline__ void conv_step(f32x16 (&acc)[4], const u32x4& a, const u32x4 (&b)[4]) {
    const bf16x8 af = __builtin_bit_cast(bf16x8, a);
#pragma unroll
    for (int n = 0; n < 4; ++n) if ((MASK >> n) & 1) acc[n] = __builtin_amdgcn_mfma_f32_32x32x16_bf16(af, __builtin_bit_cast(bf16x8, b[n]), acc[n], 0, 0, 0);
}
template <int MASK>
__device__ __forceinline__ void conv_seg(f32x16 (&acc)[4], const LAS unsigned char* hrc, const LAS unsigned char* zl, int xb, int il, int dlo, int dhi) {
    u32x4 fa0, fb0[4], fa1, fb1[4], fa2, fb2[4], fa3, fb3[4];
    ConvAddr ca; conv_addr(ca, hrc, zl, dlo, xb, il);
    conv_load<0, MASK>(ca, fa0, fb0); conv_load<1, MASK>(ca, fa1, fb1);
#pragma unroll 1
    for (int d = dlo; d <= dhi; ++d) {
        ConvAddr cn; conv_addr(cn, hrc, zl, d < dhi ? d + 1 : dhi, xb, il);
        conv_load<2, MASK>(ca, fa2, fb2); conv_step<MASK>(acc, fa0, fb0);
        conv_load<3, MASK>(ca, fa3, fb3); conv_step<MASK>(acc, fa1, fb1);
        conv_load<0, MASK>(cn, fa0, fb0); conv_step<MASK>(acc, fa2, fb2);
        conv_load<1, MASK>(cn, fa1, fb1); conv_step<MASK>(acc, fa3, fb3);
        ca = cn;
    }
}
__device__ __forceinline__ void conv_mma(LAS unsigned char* lds, f32x16 (&acc)[4], int wave, int lane) {
    const int ch = wave >> 1, a0 = (wave & 1) * 32, l32 = lane & 31, hf = lane >> 5, il = l32 >> 2, b = l32 & 3;
    const LAS unsigned char* hrc = lds + HR_OFF + ch * HR_CH;
    const LAS unsigned char* zl = lds + (ch * 4 + b) * ZROW + hf * 16;
    const int xb = 2048 - a0 - l32 + 8 * hf;
#pragma unroll
    for (int n = 0; n < 4; ++n)
#pragma unroll
        for (int i = 0; i < 16; ++i) acc[n][i] = 0.f;
    conv_seg<0x1>(acc, hrc, zl, xb, il, -31, -24);
    conv_seg<0x3>(acc, hrc, zl, xb, il, -23, -16);
    conv_seg<0x7>(acc, hrc, zl, xb, il, -15, -8);
    conv_seg<0xF>(acc, hrc, zl, xb, il, -7, 7);
    conv_seg<0xE>(acc, hrc, zl, xb, il, 8, 15);
    conv_seg<0xC>(acc, hrc, zl, xb, il, 16, 23);
    conv_seg<0x8>(acc, hrc, zl, xb, il, 24, 31);
}
__device__ __forceinline__ void gate_epi(LAS unsigned char* lds, f32x16 (&acc)[4], float skip, int wave, int lane) {
    const int ch = wave >> 1, a0 = (wave & 1) * 32, l32 = lane & 31, hf = lane >> 5, il = l32 >> 2, b = l32 & 3;
#pragma unroll
    for (int n = 0; n < 4; ++n)
#pragma unroll
        for (int g = 0; g < 4; ++g) { const int i = 8 * n + il, ao = a0 + 8 * g + 4 * hf;
            const u32x2 zw = *(const LAS u32x2*)(lds + (ch * 4 + b) * ZROW + i * 144 + ao * 2);
            const u32x2 xw = *(const LAS u32x2*)(lds + HR_OFF + (ch * 4 + b) * XROW + (64 * i + ao) * 2);
            acc[n][4 * g + 0] = bflo(xw.x) * (acc[n][4 * g + 0] + skip * bflo(zw.x));
            acc[n][4 * g + 1] = bfhi(xw.x) * (acc[n][4 * g + 1] + skip * bfhi(zw.x));
            acc[n][4 * g + 2] = bflo(xw.y) * (acc[n][4 * g + 2] + skip * bflo(zw.y));
            acc[n][4 * g + 3] = bfhi(xw.y) * (acc[n][4 * g + 3] + skip * bfhi(zw.y)); }
}
__device__ __forceinline__ void hyena_unit(LAS unsigned char* lds, const bf16* ST, const bf16* HRg, const float* skip, bf16* CAT, int unit) {
    const int tid = tid_opaque(), wave = __builtin_amdgcn_readfirstlane(tid >> 6), lane = tid & 63;
    const int c0 = unit * 4, ch = wave >> 1, a0 = (wave & 1) * 32, l32 = lane & 31, hf = lane >> 5, il = l32 >> 2, b = l32 & 3;
    f32x16 acc[4];
    load_rows(lds, ST, 0, c0, true); load_hr(lds, HRg, 0, c0);
    if (tid < 128) *(LAS u32x4*)(lds + (tid >> 3) * ZROW + 32 * 144 + (tid & 7) * 16) = (u32x4){0u, 0u, 0u, 0u};
    __syncthreads();
    conv_mma(lds, acc, wave, lane);
    __syncthreads();
    load_rows(lds, ST, 1, c0, false);
    __syncthreads();
    gate_epi(lds, acc, skip[c0 + ch], wave, lane);
    __syncthreads();
#pragma unroll
    for (int n = 0; n < 4; ++n)
#pragma unroll
        for (int g = 0; g < 4; ++g) { const int i = 8 * n + il, ao = a0 + 8 * g + 4 * hf;
            u32x2 w; w.x = cvtpk(acc[n][4 * g], acc[n][4 * g + 1]); w.y = cvtpk(acc[n][4 * g + 2], acc[n][4 * g + 3]);
            *(LAS u32x2*)(lds + (ch * 4 + b) * ZROW + i * 144 + ao * 2) = w; }
    load_hr(lds, HRg, 1, c0);
    __syncthreads();
    conv_mma(lds, acc, wave, lane);
    __syncthreads();
    load_rows(lds, ST, 2, c0, false);
    __syncthreads();
    gate_epi(lds, acc, skip[HYW + c0 + ch], wave, lane);
    __syncthreads();
    LAS bf16* Y = (LAS bf16*)lds;
#pragma unroll
    for (int n = 0; n < 4; ++n)
#pragma unroll
        for (int e = 0; e < 16; ++e) { const int t = 64 * (8 * n + il) + a0 + 8 * (e >> 2) + 4 * hf + (e & 3);
            Y[(b * SEQ + t) * 4 + ch] = (bf16)f2bf(acc[n][e]); }
    __syncthreads();
#pragma unroll 4
    for (int i = 0; i < 16; ++i) { const int it = tid + i * NTHR; const u32x2 v = *(const LAS u32x2*)(lds + it * 8);
        *(u32x2*)(CAT + (size_t)it * D + c0) = v; }
    __syncthreads();
}
}

__device__ __forceinline__ void prep_item(LAS unsigned char* scr, const bf16* P1, const float* cw, const float* cb, bf16* ST, int item, int lane) {
    const int ct = item % 48, tt = (item / 48) & 31, b = item / (48 * 32), t0 = tt * 64, c30 = ct * 64;
#pragma unroll
    for (int i = 0; i < 9; ++i) { const int ci = lane + i * 64; if (ci < 66 * 8) { const int rr = ci >> 3, cc = ci & 7, t = t0 - 1 + rr;
        u32x4 v = (u32x4){0u, 0u, 0u, 0u};
        if (t >= 0 && t < SEQ) v = *(const u32x4*)(P1 + ((size_t)(b * SEQ + t) * IN_CD + c30 + cc * 8));
        *(LAS u32x4*)(scr + rr * 144 + cc * 16) = v; } }
    LDS_WAIT(); asm volatile("" ::: "memory");
    const LAS bf16* tile = (const LAS bf16*)scr;
    for (int c = 0; c < 64; ++c) { const int c3 = c30 + c;
        const float w0 = cw[c3], w1 = cw[HY3 + c3], w2 = cw[2 * HY3 + c3], bb = cb[c3];
        const float v = bb + w0 * bf2f(tile[lane * 72 + c]) + w1 * bf2f(tile[(lane + 1) * 72 + c]) + w2 * bf2f(tile[(lane + 2) * 72 + c]);
        ST[(size_t)(b * HY3 + c3) * SEQ + t0 + lane] = (bf16)f2bf(v); }
    LDS_WAIT(); asm volatile("" ::: "memory");
}

__device__ __forceinline__ void transpose_load(f32x4 (&v)[16], const float* W, int N, int k0, int n0, int lane) {
    const int r = lane >> 4, c4 = lane & 15;
#pragma unroll
    for (int i = 0; i < 16; ++i) v[i] = __builtin_nontemporal_load((const f32x4*)(W + (size_t)(k0 + 4 * i + r) * N + n0 + 4 * c4));
}
__device__ __forceinline__ void transpose_store(const f32x4 (&v)[16], bf16* WT, int ldt, int k0, int drow0, LAS float* scr, int lane) {
    const int r = lane >> 4, c4 = lane & 15;
#pragma unroll
    for (int i = 0; i < 16; ++i) { LAS float* d = scr + (4 * i + r) * 65 + 4 * c4; d[0] = v[i][0]; d[1] = v[i][1]; d[2] = v[i][2]; d[3] = v[i][3]; }
    LDS_WAIT(); asm volatile("" ::: "memory");
    const int c = lane & 7;
#pragma unroll
    for (int j = 0; j < 8; ++j) { const int n = (lane >> 3) + 8 * j; const LAS float* s = scr + (8 * c) * 65 + n;
        u32x4 o; o.x = pk2(s[0 * 65], s[1 * 65]); o.y = pk2(s[2 * 65], s[3 * 65]); o.z = pk2(s[4 * 65], s[5 * 65]); o.w = pk2(s[6 * 65], s[7 * 65]);
        __builtin_nontemporal_store(o, (u32x4*)(WT + (size_t)(drow0 + n) * ldt + k0 + 8 * c)); }
    LDS_WAIT(); asm volatile("" ::: "memory");
}
__device__ __forceinline__ void transpose_item(const float* W, int N, bf16* WT, int ldt, int k0, int n0, int drow0, LAS float* scr, int lane) {
    f32x4 v[16]; transpose_load(v, W, N, k0, n0, lane); transpose_store(v, WT, ldt, k0, drow0, scr, lane);
}
struct Args { const float* in[31]; float* out; unsigned char* ws; int ph_lo, ph_hi; };
enum { I_X = 0, I_C, I_CTX, I_CCTX, I_ADAW, I_ADAB, I_LN1G, I_LN1B, I_LN2G, I_LN2B, I_ROUTER, I_W1, I_W3, I_W2, I_ABIN, I_KVNORM, I_UKV, I_RPB, I_ABOUT,
       I_CDIN, I_CONVW, I_CONVB, I_FW1, I_FB1, I_FF1, I_FW2, I_FB2, I_FF2, I_FW3, I_SKIP, I_CDOUT };
constexpr int NPHASE = 21;
typedef const char __attribute__((address_space(4)))* kptr_t;
__device__ __forceinline__ const float* kin(int i) { kptr_t ka = (kptr_t)__builtin_amdgcn_kernarg_segment_ptr(); int off = i * 8; asm volatile("" : "+s"(off)); return *(const float* const __attribute__((address_space(4)))*)(ka + off); }
__device__ __forceinline__ float* kout() { kptr_t ka = (kptr_t)__builtin_amdgcn_kernarg_segment_ptr(); int off = 31 * 8; asm volatile("" : "+s"(off)); return *(float* const __attribute__((address_space(4)))*)(ka + off); }
__device__ __forceinline__ unsigned char* kws() { kptr_t ka = (kptr_t)__builtin_amdgcn_kernarg_segment_ptr(); int off = 32 * 8; asm volatile("" : "+s"(off)); return *(unsigned char* const __attribute__((address_space(4)))*)(ka + off); }
static_assert(sizeof(Args) == 33 * 8 + 8, "Args layout");

__device__ __forceinline__ void ada_phase(LAS unsigned char* lds, const Args& A, int vcu, int G) {
    const int tid = tid_opaque();
    LAS float* sil = (LAS float*)lds; LAS float* part = sil + 5 * D;
    float* ADA = (float*)(kws() + WS_ADA);
    { const float* C = kin(I_C); const float* CC = kin(I_CCTX);
      float xs[5 * D / NTHR];
#pragma unroll
      for (int it = 0; it < 5 * D / NTHR; ++it) { const int i = tid + it * NTHR; xs[it] = it < 4 * D / NTHR ? C[i] : CC[i - 4 * D]; }
#pragma unroll
      for (int it = 0; it < 5 * D / NTHR; ++it) { const float x = xs[it]; sil[tid + it * NTHR] = x / (1.f + expf(-x)); } }
    __syncthreads();
    const int kg = tid >> 4, c4 = tid & 15;
    const float* AW = kin(I_ADAW); const float* AB = kin(I_ADAB);
    for (int unit = vcu; unit < 768; unit += G) {
        const int l = unit / 384, rest = unit % 384, col0 = (rest >> 1) * 64, kh = rest & 1;
        f32x4 acc[5];
#pragma unroll
        for (int r = 0; r < 5; ++r) acc[r] = (f32x4){0.f, 0.f, 0.f, 0.f};
        const float* W = AW + (size_t)l * D * (6 * D) + col0 + 4 * c4;
        const int rowb = kh * 1024 + kg * 32;
#pragma unroll 8
        for (int i = 0; i < 32; ++i) { const int row = rowb + i; const f32x4 w = __builtin_nontemporal_load((const f32x4*)(W + (size_t)row * (6 * D)));
#pragma unroll
            for (int r = 0; r < 5; ++r) acc[r] += w * sil[r * D + row]; }
#pragma unroll
        for (int r = 0; r < 5; ++r) *(LAS f32x4*)(part + ((kg * 16 + c4) * 5 + r) * 4) = acc[r];
        __syncthreads();
        if (tid < 320) { const int r = tid >> 6, col = tid & 63; float s = kh == 0 ? AB[l * 6 * D + col0 + col] : 0.f;
            for (int g = 0; g < 32; ++g) s += part[((g * 16 + (col >> 2)) * 5 + r) * 4 + (col & 3)];
            atomicAdd(ADA + (size_t)(l * 5 + r) * (6 * D) + col0 + col, s); }
        __syncthreads();
    }
}
__device__ __forceinline__ void filt_phase(LAS unsigned char* lds, const Args& A, int vcu, int G) {
    const int tid = tid_opaque(), wave = __builtin_amdgcn_readfirstlane(tid >> 6), lane = tid & 63, l32 = lane & 31, hf = lane >> 5;
    LAS float* zf = (LAS float*)lds;
    LAS float* h1 = zf + 64 * 33;
    LAS float* w1s = h1 + 64 * 65;
    LAS float* w2s = w1s + 33 * 64;
    LAS bf16* h2b = (LAS bf16*)(w2s + 64 * 64);
    LAS bf16* w3t = h2b + 64 * 72 + wave * (64 * 72);
    bf16* HRg = (bf16*)(kws() + WS_HR);
    const float* fw1 = kin(I_FW1); const float* fb1 = kin(I_FB1); const float* ff1 = kin(I_FF1);
    const float* fw2 = kin(I_FW2); const float* fb2 = kin(I_FB2); const float* ff2 = kin(I_FF2); const float* fw3 = kin(I_FW3);
    { float t1[5], t2[8];
#pragma unroll
      for (int it = 0; it < 5; ++it) { const int i = tid + it * NTHR; t1[it] = i < 33 * 64 ? fw1[i] : 0.f; }
#pragma unroll
      for (int it = 0; it < 8; ++it) t2[it] = fw2[tid + it * NTHR];
#pragma unroll
      for (int it = 0; it < 5; ++it) { const int i = tid + it * NTHR; if (i < 33 * 64) w1s[i] = t1[it]; }
#pragma unroll
      for (int it = 0; it < 8; ++it) w2s[tid + it * NTHR] = t2[it]; }
    for (int unit = vcu; unit < 256; unit += G) {
        const int lb = unit >> 3, cbk = unit & 7, l = lb * 64 + lane;
        const float t01 = (float)l / 2047.f, w = 6.283185307179586f * (float)l / 2048.f;
        for (int f = wave; f < 33; f += 8) { float v;
            if (f == 0) v = t01; else { const int j = (f - 1) & 15; const float band = 1e-4f + (float)j * ((15.f - 1e-4f) / 15.f); v = f <= 16 ? cosf(w * band) : -sinf(w * band); }
            zf[lane * 33 + f] = v; }
        const int col0 = cbk * 512 + wave * 64;
        { const f32x4* src = (const f32x4*)(fw3 + (size_t)lane * 4096 + col0);
#pragma unroll 4
          for (int c4 = 0; c4 < 16; ++c4) { const f32x4 v = src[c4];
#pragma unroll
              for (int k = 0; k < 4; ++k) w3t[(4 * c4 + k) * 72 + lane] = (bf16)f2bf(v[k]); } }
        __syncthreads();
        { f32x4 a0 = *(const f32x4*)(fb1 + wave * 8), a1 = *(const f32x4*)(fb1 + wave * 8 + 4);
#pragma unroll 3
          for (int f = 0; f < 33; ++f) { const float z = zf[lane * 33 + f]; a0 += *(const LAS f32x4*)(w1s + f * 64 + wave * 8) * z; a1 += *(const LAS f32x4*)(w1s + f * 64 + wave * 8 + 4) * z; }
          const f32x4 q0 = *(const f32x4*)(ff1 + wave * 8), q1 = *(const f32x4*)(ff1 + wave * 8 + 4);
#pragma unroll
          for (int i = 0; i < 4; ++i) { h1[lane * 65 + wave * 8 + i] = sinf(q0[i] * a0[i]); h1[lane * 65 + wave * 8 + 4 + i] = sinf(q1[i] * a1[i]); } }
        __syncthreads();
        { f32x4 a0 = *(const f32x4*)(fb2 + wave * 8), a1 = *(const f32x4*)(fb2 + wave * 8 + 4);
#pragma unroll 4
          for (int f = 0; f < 64; ++f) { const float z = h1[lane * 65 + f]; a0 += *(const LAS f32x4*)(w2s + f * 64 + wave * 8) * z; a1 += *(const LAS f32x4*)(w2s + f * 64 + wave * 8 + 4) * z; }
          const f32x4 q0 = *(const f32x4*)(ff2 + wave * 8), q1 = *(const f32x4*)(ff2 + wave * 8 + 4);
          u32x4 hw; hw.x = cvtpk(sinf(q0[0] * a0[0]), sinf(q0[1] * a0[1])); hw.y = cvtpk(sinf(q0[2] * a0[2]), sinf(q0[3] * a0[3]));
          hw.z = cvtpk(sinf(q1[0] * a1[0]), sinf(q1[1] * a1[1])); hw.w = cvtpk(sinf(q1[2] * a1[2]), sinf(q1[3] * a1[3]));
          *(LAS u32x4*)(h2b + lane * 72 + wave * 8) = hw; }
        __syncthreads();
        f32x16 acc[2][2];
#pragma unroll
        for (int x = 0; x < 2; ++x)
#pragma unroll
            for (int y = 0; y < 2; ++y)
#pragma unroll
                for (int i = 0; i < 16; ++i) acc[x][y][i] = 0.f;
#pragma unroll
        for (int ks = 0; ks < 4; ++ks) { bf16x8 af[2], bfr[2];
#pragma unroll
            for (int x = 0; x < 2; ++x) { af[x] = *(const LAS bf16x8*)(h2b + (32 * x + l32) * 72 + 16 * ks + 8 * hf); bfr[x] = *(const LAS bf16x8*)(w3t + (32 * x + l32) * 72 + 16 * ks + 8 * hf); }
#pragma unroll
            for (int x = 0; x < 2; ++x)
#pragma unroll
                for (int y = 0; y < 2; ++y) acc[x][y] = __builtin_amdgcn_mfma_f32_32x32x16_bf16(af[x], bfr[y], acc[x][y], 0, 0, 0); }
        LDS_WAIT(); asm volatile("" ::: "memory");
        const int o = col0 >> 11, dir = (col0 >> 10) & 1, cbase = col0 & 1023;
#pragma unroll
        for (int y = 0; y < 2; ++y) { const int c = cbase + 32 * y + l32;
            const float delta = fabsf(-3.0701134573253946f + (float)c * ((-15.350567286626973f + 3.0701134573253946f) / 1023.f));
#pragma unroll
            for (int x = 0; x < 2; ++x)
#pragma unroll
                for (int g = 0; g < 4; ++g) { const int ll = 32 * x + 8 * g + 4 * hf; float v[4];
#pragma unroll
                    for (int e = 0; e < 4; ++e) v[e] = acc[x][y][4 * g + e] * expf(-((float)(lb * 64 + ll + e) / 2047.f) * delta);
                    u32x2 pw; pw.x = cvtpk(v[0], v[1]); pw.y = cvtpk(v[2], v[3]);
                    *(LAS u32x2*)(w3t + (32 * y + l32) * 72 + ll) = pw; } }
        LDS_WAIT(); asm volatile("" ::: "memory");
        for (int cc = 0; cc < 64; ++cc) { const bf16 val = w3t[cc * 72 + lane]; bf16* row = HRg + (size_t)(o * HYW + cbase + cc) * 4096;
            if (dir == 0) row[2048 - l] = val; else row[l == 0 ? 0 : 2048 + l] = l == 0 ? (bf16)0 : val; }
        __syncthreads();
    }
}
__device__ __forceinline__ void convert_phase(LAS unsigned char* lds, const Args& A, int vcu, int G) {
    const int tid = tid_opaque(), wave = __builtin_amdgcn_readfirstlane(tid >> 6), lane = tid & 63;
    LAS float* scr = (LAS float*)(lds + wave * 16640);
    const int gw = vcu * NWAVES + wave, NGW = G * NWAVES;
    unsigned char* ws = kws();
    constexpr int N0 = 32 * 81, N1 = 8 * 32, N2 = 32 * 32, N3 = 32 * 64, N4 = 32 * 32;
    constexpr int NIT = N0 + N1 + N2 + N3 + N4;
    for (int it = gw; it < NIT; it += NGW) {
        int r = it;
        if (r < N0) { transpose_item(kin(I_ABIN), IN_AB, (bf16*)(ws + WS_WAB), D, (r / 81) * 64, (r % 81) * 64, (r % 81) * 64, scr, lane); continue; } r -= N0;
        if (r < N1) { transpose_item(kin(I_UKV), D, (bf16*)(ws + WS_WUKV), KVR, (r / 32) * 64, (r % 32) * 64, (r % 32) * 64, scr, lane); continue; } r -= N1;
        if (r < N2) { transpose_item(kin(I_ABOUT), D, (bf16*)(ws + WS_WABO), D, (r / 32) * 64, (r % 32) * 64, (r % 32) * 64, scr, lane); continue; } r -= N2;
        if (r < N3) { transpose_item(kin(I_CDIN), IN_CD, (bf16*)(ws + WS_WCD), D, (r / 64) * 64, (r % 64) * 64, (r % 64) * 64, scr, lane); continue; } r -= N3;
        transpose_item(kin(I_CDOUT), D, (bf16*)(ws + WS_WCDO), D, (r / 32) * 64, (r % 32) * 64, (r % 32) * 64, scr, lane);
    }
    const size_t gt = (size_t)vcu * NTHR + tid, NGT = (size_t)G * NTHR;
    { u32x4* z = (u32x4*)(ws + WS_WAB + (size_t)IN_AB * D * 2); for (size_t i = gt; i < (size_t)(IN_AB_PAD - IN_AB) * D * 2 / 16; i += NGT) z[i] = (u32x4){0u, 0u, 0u, 0u}; }
    { unsigned* cs = (unsigned*)(ws + WS_CS256);
      for (size_t i = gt; i < 512 * 128; i += NGT) { const int row = (int)(i >> 7), n = (int)(i & 127) * 2, k2 = row & 255; const bool sn = row >= 256;
          const float a0 = (float)((k2 * n) & 255) * (1.f / 256.f), a1 = (float)((k2 * (n + 1)) & 255) * (1.f / 256.f);
          cs[i] = pk2((sn ? __builtin_amdgcn_sinf(a0) : __builtin_amdgcn_cosf(a0)) * 0.0625f, (sn ? __builtin_amdgcn_sinf(a1) : __builtin_amdgcn_cosf(a1)) * 0.0625f); } }
    { unsigned* cl = (unsigned*)(ws + WS_CSL);
      const float nrm = 0.022097086912079608f;
      for (size_t i = gt; i < (size_t)2048 * 1024; i += NGT) { const int k1 = (int)(i >> 10), j = (int)(i & 1023) * 2; float v[2];
#pragma unroll
          for (int q = 0; q < 2; ++q) { const int jj = j + q; const bool sn = jj > 1024; const int t = sn ? jj - 1024 : jj; const float a = (float)((k1 * t) & 2047) * (1.f / 2048.f); v[q] = (sn ? -__builtin_amdgcn_sinf(a) : __builtin_amdgcn_cosf(a)) * nrm; }
          cl[i] = pk2(v[0], v[1]); } }
}
__device__ __forceinline__ void mod_row(const float* xrow, const float* shift, const float* scale, bf16* orow, int lane) {
#pragma unroll
    for (int j = 0; j < 8; ++j) { const int c = 4 * lane + 256 * j; const f32x4 x = __builtin_nontemporal_load((const f32x4*)(xrow + c)), sh = *(const f32x4*)(shift + c), sc = *(const f32x4*)(scale + c);
        const f32x4 u = x * (sc + 1.f) + sh; u32x2 w; w.x = pk2(u[0], u[1]); w.y = pk2(u[2], u[3]); *(u32x2*)(orow + c) = w; }
}
__device__ __forceinline__ void modulate_phase(const Args& A, int vcu, int G) {
    const int tid = tid_opaque(), lane = tid & 63, gw = vcu * NWAVES + __builtin_amdgcn_readfirstlane(tid >> 6), NGW = G * NWAVES;
    const float* ADA = (const float*)(kws() + WS_ADA); bf16* U = (bf16*)(kws() + WS_UALL); const float* X = kin(I_X); const float* CT = kin(I_CTX);
    for (int row = gw; row < MALL; row += NGW) {
        if (row < MLAT) { const int b = row >> 11; mod_row(X + (size_t)row * D, ADA + (size_t)b * 6 * D, ADA + (size_t)b * 6 * D + D, U + (size_t)row * D, lane); }
        else mod_row(CT + (size_t)(row - MLAT) * D, ADA + (size_t)4 * 6 * D, ADA + (size_t)4 * 6 * D + D, U + (size_t)row * D, lane);
    }
}
__device__ __forceinline__ void postproj_phase(const Args& A, int vcu, int G) {
    const int tid = tid_opaque(), lane = tid & 63, gw = vcu * NWAVES + __builtin_amdgcn_readfirstlane(tid >> 6), NGW = G * NWAVES;
    bf16* P = (bf16*)(kws() + WS_P); bf16* CK = (bf16*)(kws() + WS_CKVN); bf16* KPE = (bf16*)(kws() + WS_KPE); const float* kvn = kin(I_KVNORM);
    const int fi = lane & 31;
    const float inv = exp2f(-(float)(fi & 15) * (13.287712379549449f / 16.f));
    const f32x4 g0 = *(const f32x4*)(kvn + 8 * lane), g1 = *(const f32x4*)(kvn + 8 * lane + 4);
    for (int row = gw; row < MALL; row += NGW) {
        bf16* pr = P + (size_t)row * IN_AB_PAD;
        const u32x4 w = *(const u32x4*)(pr + OFF_CKV + 8 * lane);
        const bool lat = row < MLAT;
        bf16 k1 = 0, k2 = 0, kc = 0, q1[4], q2[4];
        if (lat) { if (lane < 32) { k1 = pr[OFF_KPE + fi]; k2 = pr[OFF_KPE + 32 + fi]; }
#pragma unroll
            for (int q = 0; q < 4; ++q) { const int h = 2 * q + (lane >> 5); const bf16* qp = pr + h * 192 + 128; q1[q] = qp[fi]; q2[q] = qp[32 + fi]; } }
        else kc = pr[OFF_KPE + lane];
        { float x[8] = {bflo(w.x), bfhi(w.x), bflo(w.y), bfhi(w.y), bflo(w.z), bfhi(w.z), bflo(w.w), bfhi(w.w)};
          float ss = 0.f;
#pragma unroll
          for (int i = 0; i < 8; ++i) ss += x[i] * x[i];
          const float rstd = 1.f / sqrtf(wave_sum(ss) * (1.f / KVR) + LN_EPS);
          u32x4 o; o.x = pk2(x[0] * rstd * g0[0], x[1] * rstd * g0[1]); o.y = pk2(x[2] * rstd * g0[2], x[3] * rstd * g0[3]);
          o.z = pk2(x[4] * rstd * g1[0], x[5] * rstd * g1[1]); o.w = pk2(x[6] * rstd * g1[2], x[7] * rstd * g1[3]);
          *(u32x4*)(CK + (size_t)row * KVR + 8 * lane) = o; }
        if (lat) {
            const int t = row & 2047; const float pos = (float)(fi < 16 ? (t >> 6) : (t & 63)); float sn, cs; sincosf(pos * inv, &sn, &cs);
            if (lane < 32) { const float t1 = bf2f(k1), t2 = bf2f(k2);
                KPE[(size_t)row * 64 + fi] = (bf16)f2bf(t1 * cs - t2 * sn); KPE[(size_t)row * 64 + 32 + fi] = (bf16)f2bf(t2 * cs + t1 * sn); }
#pragma unroll
            for (int q = 0; q < 4; ++q) { const int h = 2 * q + (lane >> 5); bf16* qp = pr + h * 192 + 128;
                const float t1 = bf2f(q1[q]), t2 = bf2f(q2[q]); qp[fi] = (bf16)f2bf(t1 * cs - t2 * sn); qp[32 + fi] = (bf16)f2bf(t2 * cs + t1 * sn); }
        } else KPE[(size_t)row * 64 + lane] = kc;
    }
}
__device__ __forceinline__ void ln1_phase(LAS unsigned char* lds, int l, int vcu, int G) {
    const int tid = tid_opaque(), lane = tid & 63, gw = vcu * NWAVES + __builtin_amdgcn_readfirstlane(tid >> 6), NGW = G * NWAVES;
    LAS float* rt = (LAS float*)lds;
    unsigned char* ws = kws();
    const bf16* PRE = (const bf16*)(ws + WS_PRE);
    u32x2 pw[2][8];
    if (gw < MLAT / 2) {
#pragma unroll
        for (int rr = 0; rr < 2; ++rr)
#pragma unroll
            for (int j = 0; j < 8; ++j) pw[rr][j] = *(const u32x2*)(PRE + (size_t)(gw * 2 + rr) * D + 4 * lane + 256 * j); }
    { const float* router = kin(I_ROUTER) + (size_t)l * D * NE;
#pragma unroll
      for (int it = 0; it < 4 * D / NTHR; ++it) { const int i = tid + it * NTHR; const int c = i & (D - 1), q = i >> 11;     const f32x4 v = *(const f32x4*)(router + (size_t)c * NE + 4 * q);
          rt[(4 * q + 0) * D + c] = v[0]; rt[(4 * q + 1) * D + c] = v[1]; rt[(4 * q + 2) * D + c] = v[2]; rt[(4 * q + 3) * D + c] = v[3]; } }
    __syncthreads();
    bf16* H1 = (bf16*)(ws + WS_H1); bf16* U2 = (bf16*)(ws + WS_U2); float* AFF = (float*)(ws + WS_AFF);
    const float* g = kin(I_LN1G) + l * D; const float* bb = kin(I_LN1B) + l * D; const float* ADA = (const float*)(ws + WS_ADA) + (size_t)l * 5 * 6 * D;
    for (int rp = gw; rp < MLAT / 2; rp += NGW) {
        const int row0 = rp * 2, b = row0 >> 11;
        const float* ada = ADA + (size_t)b * 6 * D;
        f32x4 v[2][8];
#pragma unroll
        for (int rr = 0; rr < 2; ++rr)
#pragma unroll
            for (int j = 0; j < 8; ++j) v[rr][j] = (f32x4){bflo(pw[rr][j].x), bfhi(pw[rr][j].x), bflo(pw[rr][j].y), bfhi(pw[rr][j].y)};
        if (rp + NGW < MLAT / 2) {
#pragma unroll
            for (int rr = 0; rr < 2; ++rr)
#pragma unroll
                for (int j = 0; j < 8; ++j) pw[rr][j] = *(const u32x2*)(PRE + (size_t)((rp + NGW) * 2 + rr) * D + 4 * lane + 256 * j); }
        float rstd2[2];
#pragma unroll
        for (int rr = 0; rr < 2; ++rr) { float s = 0.f;
#pragma unroll
            for (int j = 0; j < 8; ++j) s += (v[rr][j][0] + v[rr][j][1]) + (v[rr][j][2] + v[rr][j][3]);
            const float mean = wave_sum(s) * (1.f / D); float q = 0.f;
#pragma unroll
            for (int j = 0; j < 8; ++j) { v[rr][j] = v[rr][j] - mean; q += (v[rr][j][0] * v[rr][j][0] + v[rr][j][1] * v[rr][j][1]) + (v[rr][j][2] * v[rr][j][2] + v[rr][j][3] * v[rr][j][3]); }
            rstd2[rr] = 1.f / sqrtf(wave_sum(q) * (1.f / D) + LN_EPS); }
#pragma unroll
        for (int jc = 0; jc < 8; jc += 1) { f32x4 gq[1], bq[1], sq[1], hq[1];
#pragma unroll
            for (int jj = 0; jj < 1; ++jj) { const int c = 4 * lane + 256 * (jc + jj); gq[jj] = *(const f32x4*)(g + c); bq[jj] = *(const f32x4*)(bb + c); sq[jj] = *(const f32x4*)(ada + 4 * D + c); hq[jj] = *(const f32x4*)(ada + 3 * D + c); }
#pragma unroll
            for (int rr = 0; rr < 2; ++rr)
#pragma unroll
                for (int jj = 0; jj < 1; ++jj) { const int j = jc + jj, c = 4 * lane + 256 * j;
                    const f32x4 hv = v[rr][j] * rstd2[rr] * gq[jj] + bq[jj];
                    { u32x2 hw; hw.x = pk2(hv[0], hv[1]); hw.y = pk2(hv[2], hv[3]); *(u32x2*)(H1 + (size_t)(row0 + rr) * D + c) = hw; }
                    const f32x4 u = hv * (sq[jj] + 1.f) + hq[jj];
                    u32x2 w; w.x = pk2(u[0], u[1]); w.y = pk2(u[2], u[3]); *(u32x2*)(U2 + (size_t)(row0 + rr) * D + c) = w;
                    v[rr][j] = u; } }
        float a[32];
#pragma unroll
        for (int e = 0; e < NE; ++e) { float a0 = 0.f, a1 = 0.f;
#pragma unroll
            for (int j = 0; j < 8; ++j) { const f32x4 r4 = *(const LAS f32x4*)(rt + e * D + 4 * lane + 256 * j);
                a0 += (v[0][j][0] * r4[0] + v[0][j][1] * r4[1]) + (v[0][j][2] * r4[2] + v[0][j][3] * r4[3]);
                a1 += (v[1][j][0] * r4[0] + v[1][j][1] * r4[1]) + (v[1][j][2] * r4[2] + v[1][j][3] * r4[3]); }
            a[e] = a0; a[16 + e] = a1; __builtin_amdgcn_sched_barrier(0); }
#pragma unroll
        for (int i = 0; i < 16; ++i) { const bool up = (lane & 32) != 0; const float snd = up ? a[i] : a[i + 16], kp = up ? a[i + 16] : a[i]; a[i] = kp + __shfl_xor(snd, 32); }
#pragma unroll
        for (int i = 0; i < 8; ++i) { const bool up = (lane & 16) != 0; const float snd = up ? a[i] : a[i + 8], kp = up ? a[i + 8] : a[i]; a[i] = kp + __shfl_xor(snd, 16); }
#pragma unroll
        for (int i = 0; i < 4; ++i) { const bool up = (lane & 8) != 0; const float snd = up ? a[i] : a[i + 4], kp = up ? a[i + 4] : a[i]; a[i] = kp + __shfl_xor(snd, 8); }
#pragma unroll
        for (int i = 0; i < 2; ++i) { const bool up = (lane & 4) != 0; const float snd = up ? a[i] : a[i + 2], kp = up ? a[i + 2] : a[i]; a[i] = kp + __shfl_xor(snd, 4); }
        { const bool up = (lane & 2) != 0; const float snd = up ? a[0] : a[1], kp = up ? a[1] : a[0]; a[0] = kp + __shfl_xor(snd, 2); }
        float lg = a[0] + __shfl_xor(a[0], 1);
        float mx = lg;
#pragma unroll
        for (int o = 2; o < 32; o <<= 1) mx = fmaxf(mx, __shfl_xor(mx, o));
        const float ex = expf(lg - mx); float den = ex;
#pragma unroll
        for (int o = 2; o < 32; o <<= 1) den += __shfl_xor(den, o);
        if ((lane & 1) == 0) { const int rr = lane >> 5, e = (lane >> 1) & 15, t = (row0 + rr) & 2047; AFF[(size_t)(b * NE + e) * SEQ + t] = ex / den; }
    }
}
__device__ __forceinline__ void topk_phase(LAS unsigned char* lds, const Args& A, int u0, int ustride) {
    const int tid = tid_opaque(), wave = __builtin_amdgcn_readfirstlane(tid >> 6), lane = tid & 63;
    LAS unsigned* hist = (LAS unsigned*)lds;
    LAS unsigned* ctl = hist + 512;
    LAS unsigned* wt = ctl + 8;
    const float* AFF = (const float*)(kws() + WS_AFF); int* IDX = (int*)(kws() + WS_IDX); float* GATE = (float*)(kws() + WS_GATE); int* INV = (int*)(kws() + WS_INV);
    for (int unit = u0; unit < NRT; unit += ustride) {
        const int e = unit >> 2, b = unit & 3;
        unsigned long long key[4]; float val[4];
#pragma unroll
        for (int q = 0; q < 4; ++q) { val[q] = AFF[(size_t)(b * NE + e) * SEQ + tid + 512 * q];
            key[q] = ((unsigned long long)__builtin_bit_cast(unsigned, val[q]) << 11) | (unsigned)(2047 - (tid + 512 * q)); }
        hist[tid] = 0u;
        unsigned long long prefix = 0ull; unsigned need = CAP;
        __syncthreads();
#pragma unroll 1
        for (int pass = 0; pass < 6; ++pass) { const int shift = 40 - 8 * pass; LAS unsigned* h = hist + (pass & 1) * 256;
#pragma unroll
            for (int q = 0; q < 4; ++q) if ((key[q] >> (shift + 8)) == prefix) (void)__hip_atomic_fetch_add(h + (unsigned)((key[q] >> shift) & 255ull), 1u, __ATOMIC_RELAXED, __HIP_MEMORY_SCOPE_WORKGROUP);
            __syncthreads();
            if (wave == 0) { const u32x4 c = *(const LAS u32x4*)(h + 4 * lane); const unsigned mine = (c.x + c.y) + (c.z + c.w);
                unsigned suf = mine;
#pragma unroll
                for (int o = 1; o < 64; o <<= 1) { const unsigned t = __shfl_down(suf, o); if (lane + o < 64) suf += t; }
                const unsigned above = suf - mine;
                const unsigned a3 = above, a2 = a3 + c.w, a1 = a2 + c.z, a0 = a1 + c.y;
                if (a3 < need && need <= a3 + c.w) { ctl[0] = 4 * lane + 3; ctl[1] = need - a3; }
                else if (a2 < need && need <= a2 + c.z) { ctl[0] = 4 * lane + 2; ctl[1] = need - a2; }
                else if (a1 < need && need <= a1 + c.y) { ctl[0] = 4 * lane + 1; ctl[1] = need - a1; }
                else if (a0 < need && need <= a0 + c.x) { ctl[0] = 4 * lane; ctl[1] = need - a0; }
                *(LAS u32x4*)(hist + ((pass & 1) ^ 1) * 256 + 4 * lane) = (u32x4){0u, 0u, 0u, 0u}; }
            __syncthreads();
            prefix = (prefix << 8) | (unsigned long long)ctl[0]; need = ctl[1];
        }
        unsigned cnt[4];
#pragma unroll
        for (int q = 0; q < 4; ++q) { const bool sel = key[q] >= prefix; const unsigned long long m = __builtin_amdgcn_ballot_w64(sel);
            cnt[q] = (unsigned)__builtin_popcountll(m & ((1ull << lane) - 1ull)); if (lane == 0) wt[q * 8 + wave] = (unsigned)__builtin_popcountll(m); }
        __syncthreads();
        unsigned base = 0u;
#pragma unroll
        for (int q = 0; q < 4; ++q) { unsigned before = 0u, tot = 0u;
#pragma unroll
            for (int w = 0; w < 8; ++w) { const unsigned x = wt[q * 8 + w]; tot += x; if (w < wave) before += x; }
            const bool sel = key[q] >= prefix; const int idx = tid + 512 * q; const int slot = (int)(base + before + cnt[q]);
            INV[(size_t)(b * SEQ + idx) * NE + e] = sel ? slot : -1;
            if (sel) { IDX[unit * CAP + slot] = idx; GATE[unit * CAP + slot] = val[q]; }
            base += tot; }
        __syncthreads();
    }
}
struct Ln2Pre { u32x2 h[8], y0[8], y1[8]; unsigned rest; float f0, f1; };
__device__ __forceinline__ void ln2_fetch(Ln2Pre& P, const bf16* H1, const bf16* YE, int row, int inv, int lane) {
    const int b = row >> 11;
    unsigned mask = (unsigned)__builtin_amdgcn_ballot_w64(inv >= 0) & 0xffffu;
    const bool any = mask != 0u; const int e0 = any ? __builtin_ctz(mask) : 0; mask &= mask - 1u;
    const bool two = mask != 0u; const int e1 = two ? __builtin_ctz(mask) : e0; if (two) mask &= mask - 1u;
    P.rest = mask; P.f0 = any ? 1.f : 0.f; P.f1 = two ? 1.f : 0.f;
    const int s0 = any ? __builtin_amdgcn_readlane(inv, e0) : 0, s1 = two ? __builtin_amdgcn_readlane(inv, e1) : s0;
    const bf16* y0 = YE + (size_t)((e0 * 4 + b) * CAP + s0) * D + 4 * lane; const bf16* y1 = YE + (size_t)((e1 * 4 + b) * CAP + s1) * D + 4 * lane;
#pragma unroll
    for (int j = 0; j < 8; ++j) { P.h[j] = *(const u32x2*)(H1 + (size_t)row * D + 4 * lane + 256 * j); P.y0[j] = *(const u32x2*)(y0 + 256 * j); P.y1[j] = *(const u32x2*)(y1 + 256 * j); }
}
__device__ __forceinline__ void ln2_phase(int l, int vcu, int G) {
    const int tid = tid_opaque(), lane = tid & 63, gw = vcu * NWAVES + __builtin_amdgcn_readfirstlane(tid >> 6), NGW = G * NWAVES;
    unsigned char* ws = kws();
    const bf16* H1 = (const bf16*)(ws + WS_H1); const bf16* YE = (const bf16*)(ws + WS_YE); const int* INV = (const int*)(ws + WS_INV);
    float* out = kout(); bf16* H2 = (bf16*)(ws + WS_H2); bf16* U = (bf16*)(ws + WS_UALL);
    const float* g = kin(I_LN2G) + l * D; const float* bb = kin(I_LN2B) + l * D; const float* ADA = (const float*)(ws + WS_ADA);
    if (gw >= MLAT) return;
    int inv_c = lane < NE ? INV[(size_t)gw * NE + lane] : -1;
    int inv_n = (gw + NGW < MLAT && lane < NE) ? INV[(size_t)(gw + NGW) * NE + lane] : -1;
    Ln2Pre cur; ln2_fetch(cur, H1, YE, gw, inv_c, lane);
    for (int row = gw; row < MLAT; row += NGW) {
        const int b = row >> 11; const int inv = inv_c; const bool has_n = row + NGW < MLAT;
        int inv_nn = -1; if (row + 2 * NGW < MLAT && lane < NE) inv_nn = INV[(size_t)(row + 2 * NGW) * NE + lane];
        Ln2Pre nxt; if (has_n) ln2_fetch(nxt, H1, YE, row + NGW, inv_n, lane); else nxt = cur;
        const float* ada = ADA + (size_t)(l * 5 + b) * 6 * D;
        f32x4 v[8], m[8];
#pragma unroll
        for (int j = 0; j < 8; ++j) { v[j] = (f32x4){bflo(cur.h[j].x), bfhi(cur.h[j].x), bflo(cur.h[j].y), bfhi(cur.h[j].y)};
            m[j][0] = cur.f0 * bflo(cur.y0[j].x) + cur.f1 * bflo(cur.y1[j].x); m[j][1] = cur.f0 * bfhi(cur.y0[j].x) + cur.f1 * bfhi(cur.y1[j].x);
            m[j][2] = cur.f0 * bflo(cur.y0[j].y) + cur.f1 * bflo(cur.y1[j].y); m[j][3] = cur.f0 * bfhi(cur.y0[j].y) + cur.f1 * bfhi(cur.y1[j].y); }
        unsigned mask = cur.rest;
        while (mask) {
            const int e0 = __builtin_ctz(mask); mask &= mask - 1u; const int s0 = __builtin_amdgcn_readlane(inv, e0);
            const bf16* y0 = YE + (size_t)((e0 * 4 + b) * CAP + s0) * D + 4 * lane;
            u32x2 w0[8];
#pragma unroll
            for (int j = 0; j < 8; ++j) w0[j] = *(const u32x2*)(y0 + 256 * j);
#pragma unroll
            for (int j = 0; j < 8; ++j) { m[j][0] += bflo(w0[j].x); m[j][1] += bfhi(w0[j].x); m[j][2] += bflo(w0[j].y); m[j][3] += bfhi(w0[j].y); }
        }
        float s = 0.f;
#pragma unroll
        for (int j = 0; j < 8; ++j) { const int c = 4 * lane + 256 * j; v[j] = v[j] * DN_ALPHA + *(const f32x4*)(ada + 5 * D + c) * m[j]; s += (v[j][0] + v[j][1]) + (v[j][2] + v[j][3]); }
        const float mean = wave_sum(s) * (1.f / D); float q = 0.f;
#pragma unroll
        for (int j = 0; j < 8; ++j) { v[j] = v[j] - mean; q += (v[j][0] * v[j][0] + v[j][1] * v[j][1]) + (v[j][2] * v[j][2] + v[j][3] * v[j][3]); }
        const float rstd = 1.f / sqrtf(wave_sum(q) * (1.f / D) + LN_EPS);
        const float* ada1 = ADA + (size_t)(5 + b) * 6 * D;
#pragma unroll
        for (int jc = 0; jc < 8; jc += 4) { f32x4 gq[4], bq[4], sq[4], hq[4];
#pragma unroll
            for (int jj = 0; jj < 4; ++jj) { const int c = 4 * lane + 256 * (jc + jj); gq[jj] = *(const f32x4*)(g + c); bq[jj] = *(const f32x4*)(bb + c);
                if (l == 0) { sq[jj] = *(const f32x4*)(ada1 + D + c); hq[jj] = *(const f32x4*)(ada1 + c); } }
#pragma unroll
            for (int jj = 0; jj < 4; ++jj) { const int j = jc + jj, c = 4 * lane + 256 * j;
                const f32x4 hv = v[j] * rstd * gq[jj] + bq[jj];
                if (l == 0) { u32x2 hw; hw.x = pk2(hv[0], hv[1]); hw.y = pk2(hv[2], hv[3]); *(u32x2*)(H2 + (size_t)row * D + c) = hw;
                    const f32x4 u = hv * (sq[jj] + 1.f) + hq[jj]; u32x2 w; w.x = pk2(u[0], u[1]); w.y = pk2(u[2], u[3]); *(u32x2*)(U + (size_t)row * D + c) = w; }
                else __builtin_nontemporal_store(hv, (f32x4*)(out + (size_t)row * D + c)); } }
        cur = nxt; inv_c = inv_n; inv_n = inv_nn;
    }
}

constexpr int CW_QHEAD = 64, CW_DONE0 = 256;
constexpr int XW_L = 3 * 16 * 704;
constexpr unsigned XT_L = XW_L / 8, XT_ALL = 2 * XT_L;
struct TrA { const float* W; int N; bf16* WT; int ldt, k0, n0, drow0; };
__device__ __forceinline__ TrA expert_args(int w) {
    const int l = w / XW_L, r = w % XW_L, kind = r / 11264, q = r % 11264, e = q / 704, qq = q % 704, le = l * 16 + e;
    unsigned char* ws = kws();
    const int tq = qq >> 3, sub = qq & 7;
    TrA a;
    if (kind < 2) { const int kb = (tq / 11) * 4 + (sub >> 1), nb = (tq % 11) * 2 + (sub & 1), f0 = nb * 64;
        a.W = kin(kind == 0 ? I_W1 : I_W3) + (size_t)le * D * FF; a.N = FF; a.WT = (bf16*)(ws + WS_W13) + (size_t)le * (2 * FF * D); a.ldt = D; a.k0 = kb * 64; a.n0 = f0; a.drow0 = (f0 >> 7) * 256 + kind * 128 + (f0 & 127); }
    else { const int kb = (tq >> 3) * 2 + (sub & 1), nb = (tq & 7) * 4 + (sub >> 1);
        a.W = kin(I_W2) + (size_t)le * FF * D; a.N = D; a.WT = (bf16*)(ws + WS_W2) + (size_t)le * (D * FF); a.ldt = FF; a.k0 = kb * 64; a.n0 = nb * 64; a.drow0 = nb * 64; }
    return a;
}
__device__ __forceinline__ void expert_item(int w, LAS float* scr, int lane) {
    const TrA a = expert_args(w); transpose_item(a.W, a.N, a.WT, a.ldt, a.k0, a.n0, a.drow0, scr, lane);
}
__device__ __forceinline__ void expert_item2(int w0, int w1, LAS float* scr, int lane) {
    const TrA a = expert_args(w0), b = expert_args(w1);
    f32x4 va[16], vb[16]; transpose_load(va, a.W, a.N, a.k0, a.n0, lane); transpose_load(vb, b.W, b.N, b.k0, b.n0, lane);
    transpose_store(va, a.WT, a.ldt, a.k0, a.drow0, scr, lane); transpose_store(vb, b.WT, b.ldt, b.k0, b.drow0, scr, lane);
}
__device__ __forceinline__ void steal(LAS unsigned char* lds, volatile LAS unsigned* MISC, int k, unsigned must, int G, int early = 0, int batch = 1) {
    const int tid = tid_opaque(), wave = __builtin_amdgcn_readfirstlane(tid >> 6), lane = tid & 63;
    unsigned* ctl = (unsigned*)(kws() + WS_CTL);
    __syncthreads();
    if (tid == 0) (void)xb_add(ctl + CW_DONE0 + 64 * k, 1u);
    for (;;) {
        if (tid == 0) { unsigned it = 0xffffffffu, n = 1u;
            const unsigned d = xb_ld(ctl + CW_DONE0 + 64 * k), h = xb_ld(ctl + CW_QHEAD);
            if (h < XT_ALL && (d + (unsigned)early < (unsigned)G || h < must)) { n = (d + (unsigned)early < (unsigned)G) ? (unsigned)batch : (h + 2048u < must ? 4u : h + 512u < must ? 2u : 1u); it = xb_add(ctl + CW_QHEAD, n); if (it >= XT_ALL) it = 0xffffffffu; }
            MISC[4] = it; MISC[5] = n; }
        __syncthreads();
        const unsigned it = MISC[4], n = MISC[5];
        __syncthreads();
        if (it == 0xffffffffu) break;
#pragma unroll 1
        for (unsigned i = 0; i < n; i += 2) {
            if (i + 1u < n && it + i + 1u < XT_ALL) expert_item2((int)(it + i) * 8 + wave, (int)(it + i + 1u) * 8 + wave, (LAS float*)(lds + wave * 16640), lane);
            else if (it + i < XT_ALL) expert_item((int)(it + i) * 8 + wave, (LAS float*)(lds + wave * 16640), lane); }
    }
}

__global__ void __launch_bounds__(NTHR, 2) mk_fwd(Args A) {
    extern __shared__ __attribute__((aligned(16))) unsigned char lds_raw[];
    LAS unsigned char* lds = (LAS unsigned char*)lds_raw;
    volatile LAS unsigned* MISC = (volatile LAS unsigned*)(lds + LDS_MISC);
    const int G = gridDim.x; const int bx = blockIdx.x; const int vcu = (G % 8 == 0) ? (bx % 8) * (G / 8) + bx / 8 : bx;
    if (threadIdx.x < 16) MISC[threadIdx.x] = 0u;
    __syncthreads();
#if MK_LAUNCH_PER_PHASE
#define GRID_BAR() do { } while (0)
#else
    XcdBarrier bar = xcd_barrier_post((unsigned*)(kws() + WS_CTL) + 4096, MISC + 8);
#define GRID_BAR() xcd_barrier(bar)
#endif
    const int lo = A.ph_lo, hi = A.ph_hi;
#ifndef PH_MASK
#define PH_MASK 0xFFFFFFFFu
#endif
#define IN(k) ((((PH_MASK) >> (k)) & 1u) && lo <= (k) && (k) < hi)
#ifndef PROBE_SA
#define PROBE_SA -1
#define PROBE_SB -1
#endif
#ifndef PROBE_SCALE
#define PROBE_SCALE 4
#endif
#define STAMP(i) do { if (PROBE_SA >= 0 && blockIdx.x == 0 && threadIdx.x == 0) ((volatile LAS unsigned*)(lds + LDS_STAMP))[(i)] = (unsigned)__builtin_amdgcn_s_memrealtime(); } while (0)
#define SEAM(k) do { if ((k) + 1 < hi) GRID_BAR(); STAMP((k) + 1); } while (0)
    STAMP(0);
#ifndef PROBE_DUP
#define PROBE_DUP 0u
#endif
#define REP(k) for (int rep_ = 0; rep_ < (int)(((PROBE_DUP) >> (k)) & 1u) + 1; ++rep_)

    #ifndef PX_PARTS
#define PX_PARTS 3
#endif
#ifndef P0_PARTS
#define P0_PARTS 7
#endif
    if (IN(0)) REP(0) { if (P0_PARTS & 1) ada_phase(lds, A, vcu, G); if (P0_PARTS & 2) filt_phase(lds, A, vcu, G); if (P0_PARTS & 4) convert_phase(lds, A, vcu, G); SEAM(0); }

    {

            if (IN(1)) REP(1) { modulate_phase(A, vcu, G); SEAM(1); }
            if (IN(2)) REP(2) { ProbInAB P{2048, 2048, 2048, 720, (const bf16*)(kws() + WS_UALL), (const bf16*)(kws() + WS_WAB), (bf16*)(kws() + WS_P)};
                if (G == 256) { if ((vcu & 31) < 30) pg8::gemm_phase(lds, P, (vcu >> 5) * 30 + (vcu & 31), 240); } else pg8::gemm_phase(lds, P, vcu, G);
                steal(lds, MISC, 2, 0u, G, 0, 4); SEAM(2); }
            if (IN(3)) REP(3) { postproj_phase(A, vcu, G); SEAM(3); }
            if (IN(4)) REP(4) { ProbPlain P{512, 512, 512, 36 * 8, (const bf16*)(kws() + WS_CKVN), (const bf16*)(kws() + WS_WUKV), (bf16*)(kws() + WS_KV), D, 36, 8};
                if (G == 256) { if ((vcu & 31) < 18) pg8::gemm_phase(lds, P, (vcu >> 5) * 18 + (vcu & 31), 144); }
                else pg8::gemm_phase(lds, P, vcu, G);
                steal(lds, MISC, 4, 0u, G, 0, 2); SEAM(4); }
            if (IN(5)) REP(5) { const att::Tensors T{(const bf16*)(kws() + WS_P), (const bf16*)(kws() + WS_KV), (const bf16*)(kws() + WS_KPE), kin(I_RPB), (bf16*)(kws() + WS_CAT)};
                if (vcu & 8) { for (int u = vcu; u < 256; u += G) att::attn_unit<1>(lds, T, u); }
                for (int u = vcu; u < 256; u += G) att::attn_unit<0>(lds, T, u);
                if (!(vcu & 8)) { for (int u = vcu; u < 256; u += G) att::attn_unit<1>(lds, T, u); }
                steal(lds, MISC, 5, 0u, G, 64); SEAM(5); }
    }
#define COMMON_PHASES(l, cb) \
        if (IN(cb)) REP(cb) { ProbOut<(l != 0)> P{2048, 2048, 2048, 256, (const bf16*)(kws() + WS_CAT), (const bf16*)(kws() + (l == 0 ? WS_WABO : WS_WCDO)), l == 0 ? (const void*)kin(I_X) : (const void*)(kws() + WS_H2), \
                               (const float*)(kws() + WS_ADA) + (size_t)l * 5 * 6 * D + 2 * D, (bf16*)(kws() + WS_PRE)}; \
            pg8::gemm_phase(lds, P, vcu, G); SEAM(cb); } \
        if (IN(cb + 1)) REP(cb + 1) { ln1_phase(lds, l, vcu, G); SEAM(cb + 1); } \
        if (IN(cb + 2)) REP(cb + 2) { if (G == 256) topk_phase(lds, A, (vcu & 31) < 8 ? (vcu >> 5) * 8 + (vcu & 31) : NRT, NRT); else topk_phase(lds, A, vcu, G); \
            steal(lds, MISC, cb + 2, (unsigned)l * XT_L + (XT_L / 3) * 2, G, 0, 2); SEAM(cb + 2); } \
        if (IN(cb + 3)) REP(cb + 3) { ProbMoe1 P{2048, 2048, 2048, 704, (const bf16*)(kws() + WS_U2), (const int*)(kws() + WS_IDX), (const bf16*)(kws() + WS_W13) + (size_t)l * 16 * (2 * FF * D), (bf16*)(kws() + WS_HDN), nullptr, 0, 0}; \
            if (G == 256) { const int xc_ = vcu >> 5, nc_ = 29 + (xc_ < 3 ? 1 : 0);     \
                if ((vcu & 31) < nc_) { const int cid_ = xc_ * 29 + (xc_ < 3 ? xc_ : 3) + (vcu & 31); moe1_tab(lds, P, cid_, 235); pg8::gemm_phase(lds, P, cid_, 235); } } else { moe1_tab(lds, P, vcu, G); pg8::gemm_phase(lds, P, vcu, G); } \
            steal(lds, MISC, cb + 3, (unsigned)(l + 1) * XT_L, G, 0, 4); SEAM(cb + 3); } \
        if (IN(cb + 4)) REP(cb + 4) { ProbMoe2 P{FF, FF, FF, 512, (const bf16*)(kws() + WS_HDN), (const bf16*)(kws() + WS_W2) + (size_t)l * 16 * (D * FF), (const float*)(kws() + WS_GATE), (bf16*)(kws() + WS_YE)}; \
            pg8::gemm_phase(lds, P, vcu, G); SEAM(cb + 4); } \
        if (IN(cb + 5)) REP(cb + 5) { ln2_phase(l, vcu, G); SEAM(cb + 5); }
    COMMON_PHASES(0, 6)
    {

            if (IN(12)) REP(12) { ProbPlain P{2048, 2048, 2048, 32 * 16, (const bf16*)(kws() + WS_UALL), (const bf16*)(kws() + WS_WCD), (bf16*)(kws() + WS_P), IN_CD, 32, 16};
                pg8::gemm_phase(lds, P, vcu, G); SEAM(12); }
            if (IN(13)) REP(13) {
                if (PX_PARTS & 1) { const int tid = tid_opaque(), lane = tid & 63, wave = __builtin_amdgcn_readfirstlane(tid >> 6);
                    for (int it = vcu * NWAVES + wave; it < NB * 32 * 48; it += G * NWAVES) prep_item(lds + wave * 9600, (const bf16*)(kws() + WS_P), kin(I_CONVW), kin(I_CONVB), (bf16*)(kws() + WS_ST), it, lane); }
                __syncthreads();
                ProbF1 P{256, 256, IN_CD, 256, (const bf16*)(kws() + WS_CS256), (const bf16*)(kws() + WS_P), (bf16*)(kws() + WS_T1)};
                if (PX_PARTS & 2) pg8::gemm_phase(lds, P, vcu, G);
                f1_mid((const bf16*)(kws() + WS_CS256), (const bf16*)(kws() + WS_P), (bf16*)(kws() + WS_T1), vcu * NTHR + (int)threadIdx.x, G * NTHR); SEAM(13); }
            if (IN(14)) REP(14) {
                if (G == 256) { if ((vcu & 31) < 16) { ProbF2 P{2048, 2048, 2048, 128, (const bf16*)(kws() + WS_CSL), (const bf16*)(kws() + WS_T1), (bf16*)(kws() + WS_CAT)}; pg8::gemm_phase(lds, P, (vcu >> 5) * 16 + (vcu & 31), 128); } }
                else { ProbF2 P{2048, 2048, 2048, 128, (const bf16*)(kws() + WS_CSL), (const bf16*)(kws() + WS_T1), (bf16*)(kws() + WS_CAT)}; pg8::gemm_phase(lds, P, vcu, G); }
                for (int u = vcu; u < 256; u += G) hy::hyena_unit(lds, (const bf16*)(kws() + WS_ST), (const bf16*)(kws() + WS_HR), kin(I_SKIP), (bf16*)(kws() + WS_CAT), u);
                steal(lds, MISC, 14, 0u, G, 0, 2); SEAM(14); }
    }
    COMMON_PHASES(1, 15)
#undef COMMON_PHASES
    if (PROBE_SA >= 0 && blockIdx.x == 0 && threadIdx.x == 0) { volatile LAS unsigned* st = (volatile LAS unsigned*)(lds + LDS_STAMP);
        const unsigned v = (st[PROBE_SB >= 0 ? PROBE_SB : 0] - st[PROBE_SA >= 0 ? PROBE_SA : 0]) * PROBE_SCALE; const unsigned long long t0 = __builtin_amdgcn_s_memrealtime();
        while (__builtin_amdgcn_s_memrealtime() - t0 < (unsigned long long)v) __builtin_amdgcn_s_sleep(8); }
#undef IN
#undef SEAM
}

extern "C" void kernel_launch(void* const* d_in, const int* in_sizes, int n_in, void* d_out, int out_size, void* d_ws, size_t ws_size, hipStream_t stream) {
    static int grid = 0;
    if (grid == 0) {
        if (n_in != 31 || out_size != MLAT * D || ws_size < WS_END) { fprintf(stderr, "kernel_launch: unexpected shapes (n_in %d, out %d, ws %zu < %zu)\n", n_in, out_size, ws_size, (size_t)WS_END); grid = -1; return; }
        int dev = 0, cus = 0, per_cu = 0;
        if (hipGetDevice(&dev) != hipSuccess || hipDeviceGetAttribute(&cus, hipDeviceAttributeMultiprocessorCount, dev) != hipSuccess) { grid = -1; return; }
        if (hipFuncSetAttribute((const void*)mk_fwd, hipFuncAttributeMaxDynamicSharedMemorySize, LDS_BYTES) != hipSuccess) { fprintf(stderr, "kernel_launch: hipFuncSetAttribute failed\n"); grid = -1; return; }
        if (hipOccupancyMaxActiveBlocksPerMultiprocessor(&per_cu, (const void*)mk_fwd, NTHR, LDS_BYTES) != hipSuccess || per_cu < 1) { fprintf(stderr, "kernel_launch: occupancy query says %d\n", per_cu); }
        (void)hipGetLastError();
        grid = cus;
    }
    if (grid < 0) return;
    (void)hipMemsetAsync((char*)d_ws + WS_CTL, 0, CTL_ZERO_BYTES, stream);
    Args a{};
    for (int i = 0; i < 31; ++i) a.in[i] = (const float*)d_in[i];
    a.out = (float*)d_out; a.ws = (unsigned char*)d_ws;
#if MK_LAUNCH_PER_PHASE
    for (int ph = 0; ph < NPHASE; ++ph) { a.ph_lo = ph; a.ph_hi = ph + 1; hipLaunchKernelGGL(mk_fwd, dim3(grid), dim3(NTHR), LDS_BYTES, stream, a); }
#else
    a.ph_lo = 0; a.ph_hi = NPHASE;
    hipLaunchKernelGGL(mk_fwd, dim3(grid), dim3(NTHR), LDS_BYTES, stream, a);
#endif
}
```
